# Optimizing an MI355X kernel written in HIP

```python
import math
import jax, jax.numpy as jnp
from jax import lax
import numpy as np

D_MODEL = 1024
BATCH = 16
SEQ = 4096
DEPTH = 1

HG_HEADS = 4
HG_HEAD_K = 128
HG_HEAD_V = 128
HG_K_DIM = HG_HEADS * HG_HEAD_K
HG_V_DIM = HG_HEADS * HG_HEAD_V
GDN_HEADS = 4
GDN_HEAD_K = 128
GDN_HEAD_V = 128
GDN_QK_DIM = GDN_HEADS * GDN_HEAD_K
GDN_V_DIM = GDN_HEADS * GDN_HEAD_V
GDN_QKV = 2 * GDN_QK_DIM + GDN_V_DIM
MIX_DIM = HG_V_DIM + GDN_V_DIM
CONV_K = 4
CHUNK = 64
IN_COLS = 2 * HG_K_DIM + 2 * HG_V_DIM + GDN_QKV + GDN_V_DIM + 2 * GDN_HEADS
N_GROUPS = 8
EXPERTS_PER_GROUP = 8
N_EXPERTS = N_GROUPS * EXPERTS_PER_GROUP
TOP_K = 2
EXPERT_FF = 256
MOE_BLOCK = 256
NORM_EPS = 1e-6

kernel_name = 'hybrid_hgrn2_gdn_hier_moe'


def rmsnorm(x, w):
    xf = x.astype(jnp.float32)
    y = xf * lax.rsqrt(jnp.mean(xf * xf, axis=-1, keepdims=True) + NORM_EPS)
    return (y * w.astype(jnp.float32)).astype(x.dtype)


def gated_head_rmsnorm(o, z, w, n_heads):
    b, s, _ = o.shape
    oh = o.astype(jnp.float32).reshape(b, s, n_heads, -1)
    y = oh * lax.rsqrt(jnp.mean(oh * oh, axis=-1, keepdims=True) + NORM_EPS) * w.astype(jnp.float32)
    zh = z.astype(jnp.float32).reshape(b, s, n_heads, -1)
    return (y * jax.nn.silu(zh)).reshape(b, s, -1)


def l2norm(t):
    return t * lax.rsqrt(jnp.sum(t * t, axis=-1, keepdims=True) + 1e-6)


def to_chunks(t):
    b, s, h = t.shape[:3]
    t = t.reshape((b, s // CHUNK, CHUNK, h) + t.shape[3:])
    return jnp.transpose(t, (1, 0, 3, 2) + tuple(range(4, t.ndim)))


def from_chunks(o):
    n, b, h, c, d = o.shape
    return jnp.transpose(o, (1, 0, 3, 2, 4)).reshape(b, n * c, h * d)


def causal_conv_silu(u, w):
    s = u.shape[1]
    up = jnp.pad(u, ((0, 0), (CONV_K - 1, 0), (0, 0)))
    y = up[:, 0:s] * w[0]
    for j in range(1, CONV_K):
        y = y + up[:, j:j + s] * w[j]
    return jax.nn.silu(y)


def hgrn2_mixer(q, f_logit, i, lb):
    f32 = jnp.float32
    b, s, _ = q.shape
    q = jax.nn.silu(q.astype(f32)) * HG_HEAD_K ** -0.5
    f = lb + (1.0 - lb) * jax.nn.sigmoid(f_logit.astype(f32))
    k = 1.0 - f
    log_f = jnp.log(f)
    qc = to_chunks(q.reshape(b, s, HG_HEADS, HG_HEAD_K))
    kc = to_chunks(k.reshape(b, s, HG_HEADS, HG_HEAD_K))
    lfc = to_chunks(log_f.reshape(b, s, HG_HEADS, HG_HEAD_K))
    vc = to_chunks(i.astype(f32).reshape(b, s, HG_HEADS, HG_HEAD_V))
    tri = jnp.tril(jnp.ones((CHUNK, CHUNK), dtype=bool))[:, :, None]

    def step(state, inp):
        qb, kb, vb, lfb = inp
        cum = jnp.cumsum(lfb, axis=2)
        diff = cum[:, :, :, None, :] - cum[:, :, None, :, :]
        dec = jnp.where(tri, jnp.exp(jnp.where(tri, diff, 0.0)), 0.0)
        att = jnp.einsum('bhtk,bhsk,bhtsk->bhts', qb, kb, dec)
        o = jnp.einsum('bhtk,bhkv->bhtv', qb * jnp.exp(cum), state) + jnp.einsum('bhts,bhsv->bhtv', att, vb)
        last = cum[:, :, -1:, :]
        state = jnp.exp(last)[:, :, 0, :, None] * state + jnp.einsum('bhsk,bhsv->bhkv', kb * jnp.exp(last - cum), vb)
        return state, o

    state0 = jnp.zeros((b, HG_HEADS, HG_HEAD_K, HG_HEAD_V), f32)
    _, o = lax.scan(step, state0, (qc, kc, vc, lfc))
    return from_chunks(o)


def gated_deltanet_mixer(q, k, v, a, b_logit, a_log, dt_bias):
    f32 = jnp.float32
    bsz, s, _ = q.shape
    q = l2norm(q.astype(f32).reshape(bsz, s, GDN_HEADS, GDN_HEAD_K)) * GDN_HEAD_K ** -0.5
    k = l2norm(k.astype(f32).reshape(bsz, s, GDN_HEADS, GDN_HEAD_K))
    v = v.astype(f32).reshape(bsz, s, GDN_HEADS, GDN_HEAD_V)
    beta = jax.nn.sigmoid(b_logit.astype(f32))
    g = -jnp.exp(a_log.astype(f32)) * jax.nn.softplus(a.astype(f32) + dt_bias.astype(f32))
    qc, kc, vc = to_chunks(q), to_chunks(k), to_chunks(v)
    bc = to_chunks(beta)
    gc = jnp.cumsum(to_chunks(g), axis=-1)
    incl = jnp.tril(jnp.ones((CHUNK, CHUNK), dtype=bool))
    strict = jnp.tril(jnp.ones((CHUNK, CHUNK), dtype=bool), k=-1)
    diff = gc[..., :, None] - gc[..., None, :]
    dec = jnp.where(incl, jnp.exp(jnp.where(incl, diff, 0.0)), 0.0)
    kk = jnp.einsum('nbhtk,nbhsk->nbhts', kc, kc)
    a_mat = jnp.where(strict, bc[..., :, None] * kk * dec, 0.0)
    rhs = jnp.concatenate([kc * (bc * jnp.exp(gc))[..., None], vc * bc[..., None]], axis=-1)
    sol = lax.linalg.triangular_solve(a_mat, rhs, left_side=True, lower=True, unit_diagonal=True)
    w_c, u_c = sol[..., :GDN_HEAD_K], sol[..., GDN_HEAD_K:]
    qk = jnp.einsum('nbhtk,nbhsk->nbhts', qc, kc) * dec
    qg = qc * jnp.exp(gc)[..., None]
    glast = gc[..., -1:]
    kdec = kc * jnp.exp(glast - gc)[..., None]
    gend = jnp.exp(glast[..., 0])

    def step(state, inp):
        qg_n, qk_n, w_n, u_n, kdec_n, gend_n = inp
        v_new = u_n - jnp.einsum('bhck,bhkv->bhcv', w_n, state)
        o = jnp.einsum('bhck,bhkv->bhcv', qg_n, state) + jnp.einsum('bhts,bhsv->bhtv', qk_n, v_new)
        state = gend_n[..., None, None] * state + jnp.einsum('bhck,bhcv->bhkv', kdec_n, v_new)
        return state, o

    state0 = jnp.zeros((bsz, GDN_HEADS, GDN_HEAD_K, GDN_HEAD_V), f32)
    _, o = lax.scan(step, state0, (qg, qk, w_c, u_c, kdec, gend))
    return from_chunks(o)


def hier_moe(xn, w_group, w_expert, w_gate, w_up, w_down):
    f32 = jnp.float32
    bsz, s, d = xn.shape
    t = bsz * s
    xt = xn.reshape(t, d)
    g_logits = (xt @ w_group).astype(f32)
    g_prob = jax.nn.softmax(g_logits, axis=-1)
    _, g_idx = lax.top_k(g_logits, 1)
    p_group = jnp.take_along_axis(g_prob, g_idx, axis=-1)
    e_logits = (xt @ w_expert).astype(f32).reshape(t, N_GROUPS, EXPERTS_PER_GROUP)
    e_sel = jnp.take_along_axis(e_logits, g_idx[:, :, None], axis=1)[:, 0]
    top_v, top_i = lax.top_k(e_sel, TOP_K)
    gate = (jax.nn.softmax(top_v, axis=-1) * p_group).reshape(-1)
    expert_id = (g_idx * EXPERTS_PER_GROUP + top_i).reshape(-1).astype(jnp.int32)
    tok = jnp.broadcast_to(jnp.arange(t, dtype=jnp.int32)[:, None], (t, TOP_K)).reshape(-1)
    n_assign = t * TOP_K
    n_blocks = n_assign // MOE_BLOCK + N_EXPERTS
    order = jnp.argsort(expert_id)
    se, stok, sgate = expert_id[order], tok[order], gate[order]
    counts = jax.ops.segment_sum(jnp.ones((n_assign,), jnp.int32), expert_id, num_segments=N_EXPERTS)
    starts = jnp.cumsum(counts) - counts
    padded = (counts + MOE_BLOCK - 1) // MOE_BLOCK * MOE_BLOCK
    pend = jnp.cumsum(padded)
    pstart = pend - padded
    dest = pstart[se] + jnp.arange(n_assign, dtype=jnp.int32) - starts[se]
    buf_tok = jnp.full((n_blocks * MOE_BLOCK,), t, jnp.int32).at[dest].set(stok)
    buf_gate = jnp.zeros((n_blocks * MOE_BLOCK,), f32).at[dest].set(sgate)
    block_start = jnp.arange(n_blocks, dtype=jnp.int32) * MOE_BLOCK
    block_expert = jnp.minimum(jnp.searchsorted(pend, block_start, side='right'), N_EXPERTS - 1).astype(jnp.int32)
    x_pad = jnp.concatenate([xt, jnp.zeros((1, d), xt.dtype)], axis=0)

    def block_fn(args):
        idx, gw, e = args
        xb = x_pad[idx]
        hb = jax.nn.silu(xb @ w_gate[e]) * (xb @ w_up[e])
        return (hb @ w_down[e]) * gw[:, None].astype(xb.dtype)

    yb = lax.map(block_fn, (buf_tok.reshape(n_blocks, MOE_BLOCK), buf_gate.reshape(n_blocks, MOE_BLOCK), block_expert))
    y = jax.ops.segment_sum(yb.reshape(-1, d), buf_tok, num_segments=t + 1)[:t]
    return y.reshape(bsz, s, d)


def setup_inputs(seed: int = 0) -> dict:
    key = jax.random.key(seed)
    ks = jax.random.split(key, 17)
    nrm = jax.random.normal
    dt = jnp.exp(jax.random.uniform(ks[7], (DEPTH, GDN_HEADS), minval=math.log(1e-3), maxval=math.log(1e-1)))
    return {
        'x': nrm(ks[0], (BATCH, SEQ, D_MODEL), jnp.float32),
        'norm_mix_w': 1.0 + 0.02 * nrm(ks[1], (DEPTH, D_MODEL), jnp.float32),
        'w_in': nrm(ks[2], (DEPTH, D_MODEL, IN_COLS), jnp.float32) * D_MODEL ** -0.5,
        'hgrn_lb_logits': 0.1 * nrm(ks[3], (DEPTH + 1, HG_K_DIM), jnp.float32),
        'hgrn_onorm_w': 1.0 + 0.02 * nrm(ks[4], (DEPTH, HG_HEAD_V), jnp.float32),
        'gdn_conv_w': nrm(ks[5], (DEPTH, CONV_K, GDN_QKV), jnp.float32) * CONV_K ** -0.5,
        'gdn_a_log': jnp.log(jax.random.uniform(ks[6], (DEPTH, GDN_HEADS), minval=1.0, maxval=16.0)),
        'gdn_dt_bias': dt + jnp.log(-jnp.expm1(-dt)),
        'gdn_onorm_w': 1.0 + 0.02 * nrm(ks[8], (DEPTH, GDN_HEAD_V), jnp.float32),
        'w_out': nrm(ks[9], (DEPTH, MIX_DIM, D_MODEL), jnp.float32) * MIX_DIM ** -0.5,
        'norm_moe_w': 1.0 + 0.02 * nrm(ks[10], (DEPTH, D_MODEL), jnp.float32),
        'router_group_w': nrm(ks[11], (DEPTH, D_MODEL, N_GROUPS), jnp.float32) * D_MODEL ** -0.5,
        'router_expert_w': nrm(ks[12], (DEPTH, D_MODEL, N_EXPERTS), jnp.float32) * D_MODEL ** -0.5,
        'expert_w_gate': nrm(ks[13], (DEPTH, N_EXPERTS, D_MODEL, EXPERT_FF), jnp.float32) * D_MODEL ** -0.5,
        'expert_w_up': nrm(ks[14], (DEPTH, N_EXPERTS, D_MODEL, EXPERT_FF), jnp.float32) * D_MODEL ** -0.5,
        'expert_w_down': nrm(ks[15], (DEPTH, N_EXPERTS, EXPERT_FF, D_MODEL), jnp.float32) * EXPERT_FF ** -0.5,
        'final_norm_w': 1.0 + 0.02 * nrm(ks[16], (D_MODEL,), jnp.float32),
    }


def reference(x, norm_mix_w, w_in, hgrn_lb_logits, hgrn_onorm_w, gdn_conv_w, gdn_a_log, gdn_dt_bias,
              gdn_onorm_w, w_out, norm_moe_w, router_group_w, router_expert_w, expert_w_gate,
              expert_w_up, expert_w_down, final_norm_w):
    sizes = (HG_K_DIM, HG_K_DIM, HG_V_DIM, HG_V_DIM, GDN_QKV, GDN_V_DIM, GDN_HEADS, GDN_HEADS)
    offsets = tuple(int(v) for v in np.cumsum(sizes)[:-1])
    lower_bounds = jnp.cumsum(jax.nn.softmax(hgrn_lb_logits.astype(jnp.float32), axis=0), axis=0)
    h = x
    for l in range(DEPTH):
        hn = rmsnorm(h, norm_mix_w[l])
        proj = hn @ w_in[l]
        hq, hf, hi, hg, gqkv, gz, ga, gb = jnp.split(proj, offsets, axis=-1)
        o_hg = hgrn2_mixer(hq, hf, hi, lower_bounds[l])
        o_hg = gated_head_rmsnorm(o_hg, hg, hgrn_onorm_w[l], HG_HEADS)
        qkv = causal_conv_silu(gqkv, gdn_conv_w[l])
        gq, gk, gv = jnp.split(qkv, (GDN_QK_DIM, 2 * GDN_QK_DIM), axis=-1)
        o_gd = gated_deltanet_mixer(gq, gk, gv, ga, gb, gdn_a_log[l], gdn_dt_bias[l])
        o_gd = gated_head_rmsnorm(o_gd, gz, gdn_onorm_w[l], GDN_HEADS)
        mix = jnp.concatenate([o_hg, o_gd], axis=-1).astype(h.dtype) @ w_out[l]
        h = h + mix
        h = h + hier_moe(rmsnorm(h, norm_moe_w[l]), router_group_w[l], router_expert_w[l],
                         expert_w_gate[l], expert_w_up[l], expert_w_down[l])
    return rmsnorm(h, final_norm_w)
```

```cpp
#include <hip/hip_runtime.h>
#include <cstdio>
#include <cstdint>

#ifndef MK_PER_PHASE
#define MK_PER_PHASE 0
#endif

#ifndef PROBE_PH
#define PROBE_PH -1
#endif
#define REPS(k) ((PROBE_PH == (k)) ? 2 : 1)
#define DI __device__ __forceinline__
#define GAS __attribute__((address_space(1)))
#define LAS __attribute__((address_space(3)))
typedef unsigned short bf16;
typedef unsigned v4u __attribute__((ext_vector_type(4)));
typedef unsigned v2u __attribute__((ext_vector_type(2)));
typedef float f32x4 __attribute__((ext_vector_type(4)));
typedef float f32x2 __attribute__((ext_vector_type(2)));
typedef short bf16x8 __attribute__((ext_vector_type(8)));

constexpr int T = 65536, D = 1024, SEQ = 4096, NB = 16, NCH = 64  , CH = 64;
constexpr int NP = 4096;
constexpr int INC = 4104;
constexpr int NE = 64, FF = 256, MAXTILES = 576;
constexpr int OG_NF = 6;
constexpr int OG_PITCH = OG_NF * 128 + (8 - OG_NF) * 256;
constexpr float EPS = 1e-6f;
constexpr int NWAVES = 8, NTHR = 512;

constexpr size_t MiB = 1u << 20;
constexpr size_t WS_CTL = 0, CTL_ZERO_BYTES = 1 * MiB;
constexpr size_t WS_WIN = 2 * MiB;
constexpr size_t WS_WOUT = 10 * MiB;
constexpr size_t WS_WR = 12 * MiB;
constexpr size_t WS_AB = 13 * MiB;
constexpr size_t WS_DLAST = 15 * MiB;
constexpr size_t WS_GEND = 17 * MiB;
constexpr size_t WS_LB = 18 * MiB;
constexpr size_t WS_R1 = 20 * MiB;
constexpr size_t WS_R2 = 148 * MiB;
constexpr size_t WS_LOGITS = WS_R2;
constexpr size_t WS_H = WS_R2 + 64 * MiB;
constexpr size_t WS_Y2 = WS_R2 + 140 * MiB;
constexpr size_t WS_RXI = 948 * MiB;
constexpr size_t WS_SSQ = WS_R2 + 270 * MiB;
constexpr size_t WS_XN8 = WS_R2 + 396 * MiB;
constexpr size_t WS_R3 = 660 * MiB;
constexpr size_t WS_GW = WS_R3, WS_GU = WS_R3 + 64 * MiB, WS_GQG = WS_R3 + 128 * MiB, WS_GKD = WS_R3 + 192 * MiB;
constexpr size_t WS_ROWTOK = WS_R3;
constexpr size_t WS_ROWGATE = WS_R3 + 16 * MiB;
constexpr size_t WS_ROWSCALE = WS_R3 + 32 * MiB;
constexpr size_t WS_HB = WS_R3 + 64 * MiB;
constexpr size_t WS_WGU = 916 * MiB;
constexpr size_t WS_WD = 980 * MiB;
constexpr size_t WS_END = 1012 * MiB;
constexpr int CW_BAR = 4096;
constexpr int CW_CNT = 16384;
constexpr int CW_PROG = 49152;
constexpr int CW_WORK = 16512;

constexpr int LDS_BYTES = 147456;
constexpr int MISC_OFF = 131072;
constexpr int TILETAB_OFF = MISC_OFF + 256;
constexpr int CNT_OFF = TILETAB_OFF + MAXTILES * 4;

typedef __bf16 hbf2 __attribute__((ext_vector_type(2)));
DI unsigned pk2(float lo, float hi) { return __builtin_bit_cast(unsigned, __builtin_convertvector((f32x2){lo, hi}, hbf2)); }
DI unsigned f2bf(float f) { return pk2(f, 0.f) & 0xffffu; }
DI float bf2f(unsigned b) { return __builtin_bit_cast(float, b << 16); }
DI float bflo(unsigned w) { return __builtin_bit_cast(float, w << 16); }
DI float bfhi(unsigned w) { return __builtin_bit_cast(float, w & 0xffff0000u); }
DI unsigned pk4_fp8(float a, float b, float c, float d) { int p = 0; p = __builtin_amdgcn_cvt_pk_fp8_f32(a, b, p, false); p = __builtin_amdgcn_cvt_pk_fp8_f32(c, d, p, true); return (unsigned)p; }
DI float frcp(float x) { return __builtin_amdgcn_rcpf(x); }
DI float frsq(float x) { return __builtin_amdgcn_rsqf(x); }
DI float sigm(float x) { return frcp(1.f + __expf(-x)); }
DI float silu(float x) { return x * frcp(1.f + __expf(-x)); }
DI float wave_sum(float v) {
#pragma unroll
    for (int o = 1; o < 64; o <<= 1) v += __shfl_xor(v, o);
    return v;
}
#define LDS_WAIT() asm volatile("s_waitcnt lgkmcnt(0)" ::: "memory")
#define VM_WAIT() asm volatile("s_waitcnt vmcnt(0)" ::: "memory")
#define LSYNC() do { asm volatile("s_waitcnt lgkmcnt(0)" ::: "memory"); __builtin_amdgcn_s_barrier(); asm volatile("" ::: "memory"); } while (0)

namespace pg8 {
#define PG8_LAS __attribute__((address_space(3)))
typedef unsigned short bf16_t;
typedef unsigned u32x4 __attribute__((ext_vector_type(4)));
typedef int v8i __attribute__((ext_vector_type(8)));
typedef int v4i __attribute__((ext_vector_type(4)));
constexpr int BM = 256, BK = 64, HALF = 128, HTB = HALF * BK * 2, STAGE_BYTES = 8 * HTB, NXCD = 8, WGM = 8;

__host__ __device__ __forceinline__ int lds_byte(int r, int c) { const int st = (r >> 4) * 2 + (c >> 5), rr = r & 15, cc = c & 31, ob = rr * 64 + cc * 2; return st * 1024 + (ob ^ (((ob >> 9) & 1) << 5)); }
__host__ __device__ __forceinline__ void stage_rc(int b, int& R, int& C) { const int st = b / 1024, sb = b % 1024, swz = sb ^ (((sb >> 9) & 1) << 5); R = (st >> 1) * 16 + swz / 64; C = (st & 1) * 32 + (swz % 64) / 2; }
__host__ __device__ __forceinline__ int perm32(int rho) { const int n = rho >> 4, i = rho & 15; return 8 * (i >> 2) + 4 * n + (i & 3); }

struct Unit { int pm, pn, e, j; };
struct Gemm { const bf16_t* A; const bf16_t* Bt; int M, N, K; };

struct StaticOrder {
    static constexpr bool GATHER = false;
    int nM, nN, nwg, G, c;
    __host__ __device__ void init(int M, int N, int G_, int c_) { nM = M / BM; nN = N / BM; nwg = nM * nN; G = G_; c = c_; }
    __device__ __forceinline__ bool next(int i, Unit& u) const {
        const long L = (long)i * G + c; if (L >= nwg) return false;
        int wgid = (int)L; { const int q = nwg / NXCD, r = nwg % NXCD, xcd = wgid % NXCD, off = wgid / NXCD; wgid = (xcd < r ? xcd * (q + 1) : r * (q + 1) + (xcd - r) * q) + off; }
        const int nig = WGM * nN, gid = wgid / nig, fm = gid * WGM, gsz = (nM - fm) < WGM ? (nM - fm) : WGM;
        u.pm = fm + ((wgid % nig) % gsz); u.pn = (wgid % nig) / gsz; u.e = 0; u.j = 0; return true;
    }
    __device__ __forceinline__ const char* a_tile(const Gemm& g, const Unit& u) const { return (const char*)g.A + (size_t)u.pm * (size_t)BM * g.K * 2; }
    __device__ __forceinline__ const char* b_tile(const Gemm& g, const Unit& u) const { return (const char*)g.Bt + (size_t)u.pn * (size_t)BM * g.K * 2; }
    __device__ __forceinline__ int row_of(const Unit&, int) const { return 0; }
};

__device__ __forceinline__ unsigned cvt_pk_bf16(float lo, float hi) { unsigned r; asm volatile("v_cvt_pk_bf16_f32 %0, %1, %2" : "=v"(r) : "v"(lo), "v"(hi)); return r; }

struct EpiBf16 {
    static constexpr bool PERM = true, FP8 = false;
    static constexpr int NF8T = -1;
    static constexpr int NVM = 16;
    __device__ __forceinline__ void pre(PG8_LAS unsigned char*, const Unit&, int, int, int) const {}
    bf16_t* O; int ldc;
    __device__ __forceinline__ void operator()(const f32x4 (&acc)[2][2][4][2], const Unit& u, int wr, int wc, int fr, int fq, PG8_LAS unsigned char* lds, int ui) const {
        const int row0 = u.pm * BM + wr * 64 + fr, col0 = u.pn * BM + wc * 32 + 8 * fq;
#pragma unroll
        for (int ai = 0; ai < 2; ++ai)
#pragma unroll
            for (int m = 0; m < 4; ++m) { bf16_t* rowp = O + (size_t)(row0 + ai * HALF + m * 16) * ldc + col0;
#pragma unroll
                for (int bj = 0; bj < 2; ++bj) { const f32x4 v0 = acc[ai][bj][m][0], v1 = acc[ai][bj][m][1];
                    u32x4 w; w.x = cvt_pk_bf16(v0[0], v0[1]); w.y = cvt_pk_bf16(v0[2], v0[3]); w.z = cvt_pk_bf16(v1[0], v1[1]); w.w = cvt_pk_bf16(v1[2], v1[3]);
                    *(u32x4*)(rowp + bj * HALF) = w; } }
    }
};
struct EpiProjBlocked {
    static constexpr bool PERM = true, FP8 = false;
    static constexpr int NF8T = -1;
    static constexpr int NVM = 16;
    __device__ __forceinline__ void pre(PG8_LAS unsigned char*, const Unit&, int, int, int) const {}
    bf16_t* O;
    __device__ __forceinline__ void operator()(const f32x4 (&acc)[2][2][4][2], const Unit& u, int wr, int wc, int fr, int fq, PG8_LAS unsigned char* lds, int ui) const {
#pragma unroll
        for (int ai = 0; ai < 2; ++ai)
#pragma unroll
            for (int m = 0; m < 4; ++m) { const int chunk = u.pm * 4 + ai * 2 + wr;
#pragma unroll
                for (int bj = 0; bj < 2; ++bj) { const f32x4 v0 = acc[ai][bj][m][0], v1 = acc[ai][bj][m][1];
                    u32x4 w; w.x = cvt_pk_bf16(v0[0], v0[1]); w.y = cvt_pk_bf16(v0[2], v0[3]); w.z = cvt_pk_bf16(v1[0], v1[1]); w.w = cvt_pk_bf16(v1[2], v1[3]);
                    *(u32x4*)(O + (((size_t)chunk * 32 + u.pn * 2 + bj) * 64 + m * 16 + fr) * 128 + wc * 32 + 8 * fq) = w; } }
    }
};
struct EpiF32 {
    static constexpr bool PERM = false, FP8 = false;
    static constexpr int NF8T = -1;
    static constexpr int NVM = 32;
    __device__ __forceinline__ void pre(PG8_LAS unsigned char*, const Unit&, int, int, int) const {}
    float* C; int ldc; const float* R;
    __device__ __forceinline__ void operator()(const f32x4 (&acc)[2][2][4][2], const Unit& u, int wr, int wc, int fr, int fq, PG8_LAS unsigned char* lds, int ui) const {
        const int row0 = u.pm * BM + wr * 64 + fr, col0 = u.pn * BM + wc * 32 + 4 * fq;
#pragma unroll
        for (int ai = 0; ai < 2; ++ai)
#pragma unroll
            for (int m = 0; m < 4; ++m) { const size_t ro = (size_t)(row0 + ai * HALF + m * 16) * ldc + col0;
#pragma unroll
                for (int bj = 0; bj < 2; ++bj)
#pragma unroll
                    for (int n = 0; n < 2; ++n) { f32x4 v = acc[ai][bj][m][n]; if (R) v = v + *(const f32x4*)(R + ro + bj * HALF + n * 16); *(f32x4*)(C + ro + bj * HALF + n * 16) = v; } }
    }
};
struct EpiResBf16 {
    static constexpr bool PERM = true, FP8 = false;
    static constexpr int NF8T = -1;
    static constexpr int NVM = 16;
    __device__ __forceinline__ void pre(PG8_LAS unsigned char*, const Unit&, int, int, int) const {}
    bf16_t* O; int ldc; const float* R;
    __device__ __forceinline__ void operator()(const f32x4 (&acc)[2][2][4][2], const Unit& u, int wr, int wc, int fr, int fq, PG8_LAS unsigned char* lds, int ui) const {
        const int row0 = u.pm * BM + wr * 64 + fr, col0 = u.pn * BM + wc * 32 + 8 * fq;
#pragma unroll
        for (int ai = 0; ai < 2; ++ai)
#pragma unroll
            for (int m = 0; m < 4; ++m) { const size_t ro = (size_t)(row0 + ai * HALF + m * 16) * ldc + col0;
#pragma unroll
                for (int bj = 0; bj < 2; ++bj) { const f32x4 v0 = acc[ai][bj][m][0] + *(const f32x4*)(R + ro + bj * HALF), v1 = acc[ai][bj][m][1] + *(const f32x4*)(R + ro + bj * HALF + 4);
                    u32x4 w; w.x = cvt_pk_bf16(v0[0], v0[1]); w.y = cvt_pk_bf16(v0[2], v0[3]); w.z = cvt_pk_bf16(v1[0], v1[1]); w.w = cvt_pk_bf16(v1[2], v1[3]);
                    *(u32x4*)(O + ro + bj * HALF) = w; } }
    }
};
template <int NF8T_>
struct EpiRes3 {
    static constexpr bool PERM = true, FP8 = false; static constexpr int NF8T = NF8T_;
    static constexpr int NVM = 32;
    __device__ __forceinline__ void pre(PG8_LAS unsigned char*, const Unit&, int, int, int) const {}
    bf16_t* O; unsigned char* O8; float* SSQ; const bf16_t* HN; const float* RXI; const float* W;
    __device__ __forceinline__ void operator()(const f32x4 (&acc)[2][2][4][2], const Unit& u, int wr, int wc, int fr, int fq, PG8_LAS unsigned char* lds, int ui) const {
        const int row0 = u.pm * BM + wr * 64 + fr, col0 = u.pn * BM + wc * 32 + 8 * fq;
        constexpr float as = 0.03125f;
        float wi[2][8];
#pragma unroll
        for (int bj = 0; bj < 2; ++bj) { const f32x4 a = *(const f32x4*)(W + col0 + bj * HALF), b = *(const f32x4*)(W + col0 + bj * HALF + 4);
            wi[bj][0] = __builtin_amdgcn_rcpf(a.x); wi[bj][1] = __builtin_amdgcn_rcpf(a.y); wi[bj][2] = __builtin_amdgcn_rcpf(a.z); wi[bj][3] = __builtin_amdgcn_rcpf(a.w);
            wi[bj][4] = __builtin_amdgcn_rcpf(b.x); wi[bj][5] = __builtin_amdgcn_rcpf(b.y); wi[bj][6] = __builtin_amdgcn_rcpf(b.z); wi[bj][7] = __builtin_amdgcn_rcpf(b.w); }
#pragma unroll
        for (int ai = 0; ai < 2; ++ai) {
            u32x4 rv[4][2]; float rx[4];
#pragma unroll
            for (int m = 0; m < 4; ++m) { const int row = row0 + ai * HALF + m * 16; rx[m] = RXI[row];
#pragma unroll
                for (int bj = 0; bj < 2; ++bj) rv[m][bj] = *(const u32x4*)(HN + (size_t)row * 1024 + col0 + bj * HALF); }
            __builtin_amdgcn_sched_barrier(0);
#pragma unroll
            for (int m = 0; m < 4; ++m) { const int row = row0 + ai * HALF + m * 16; const size_t ro = (size_t)row * 1024 + col0; float ss = 0.f;
#pragma unroll
                for (int bj = 0; bj < 2; ++bj) { const u32x4 q = rv[m][bj]; f32x4 v0, v1;
                    v0[0] = acc[ai][bj][m][0][0] * as + __uint_as_float(q.x << 16) * rx[m] * wi[bj][0]; v0[1] = acc[ai][bj][m][0][1] * as + __uint_as_float(q.x & 0xffff0000u) * rx[m] * wi[bj][1];
                    v0[2] = acc[ai][bj][m][0][2] * as + __uint_as_float(q.y << 16) * rx[m] * wi[bj][2]; v0[3] = acc[ai][bj][m][0][3] * as + __uint_as_float(q.y & 0xffff0000u) * rx[m] * wi[bj][3];
                    v1[0] = acc[ai][bj][m][1][0] * as + __uint_as_float(q.z << 16) * rx[m] * wi[bj][4]; v1[1] = acc[ai][bj][m][1][1] * as + __uint_as_float(q.z & 0xffff0000u) * rx[m] * wi[bj][5];
                    v1[2] = acc[ai][bj][m][1][2] * as + __uint_as_float(q.w << 16) * rx[m] * wi[bj][6]; v1[3] = acc[ai][bj][m][1][3] * as + __uint_as_float(q.w & 0xffff0000u) * rx[m] * wi[bj][7];
                    u32x4 w; w.x = cvt_pk_bf16(v0[0], v0[1]); w.y = cvt_pk_bf16(v0[2], v0[3]); w.z = cvt_pk_bf16(v1[0], v1[1]); w.w = cvt_pk_bf16(v1[2], v1[3]);
                    *(u32x4*)(O + ro + bj * HALF) = w;
                    int w0 = 0, w1 = 0; w0 = __builtin_amdgcn_cvt_pk_fp8_f32(v0[0], v0[1], w0, false); w0 = __builtin_amdgcn_cvt_pk_fp8_f32(v0[2], v0[3], w0, true); w1 = __builtin_amdgcn_cvt_pk_fp8_f32(v1[0], v1[1], w1, false); w1 = __builtin_amdgcn_cvt_pk_fp8_f32(v1[2], v1[3], w1, true);
                    *(unsigned long long*)(O8 + ro + bj * HALF) = (unsigned long long)(unsigned)w0 | ((unsigned long long)(unsigned)w1 << 32);
                    ss += v0[0] * v0[0] + v0[1] * v0[1] + v0[2] * v0[2] + v0[3] * v0[3] + v1[0] * v1[0] + v1[1] * v1[1] + v1[2] * v1[2] + v1[3] * v1[3]; }
                ss += __shfl_xor(ss, 16); ss += __shfl_xor(ss, 32);
                if (fq == 0) SSQ[(size_t)row * 16 + u.pn * 4 + wc] = ss; }
            __builtin_amdgcn_sched_barrier(0);
        }
    }
};
struct EpiSwiGLU {
    static constexpr bool PERM = true, FP8 = false;
    static constexpr int NF8T = -1;
    static constexpr int NVM = 0;
    __device__ __forceinline__ void pre(PG8_LAS unsigned char*, const Unit&, int, int, int) const {}
    bf16_t* H;
    __device__ __forceinline__ void operator()(const f32x4 (&acc)[2][2][4][2], const Unit& u, int wr, int wc, int fr, int fq, PG8_LAS unsigned char* lds, int ui) const {
        const int row0 = u.pm * BM + wr * 64 + fr, col0 = u.pn * HALF + wc * 32 + 8 * fq;
#pragma unroll
        for (int ai = 0; ai < 2; ++ai)
#pragma unroll
            for (int m = 0; m < 4; ++m) { bf16_t* rowp = H + (size_t)(row0 + ai * HALF + m * 16) * 256 + col0;
                float h[8];
#pragma unroll
                for (int n = 0; n < 2; ++n)
#pragma unroll
                    for (int j = 0; j < 4; ++j) { const float g = acc[ai][0][m][n][j], up = acc[ai][1][m][n][j]; h[n * 4 + j] = g * __builtin_amdgcn_rcpf(1.f + __expf(-g)) * up; }
                u32x4 w; w.x = cvt_pk_bf16(h[0], h[1]); w.y = cvt_pk_bf16(h[2], h[3]); w.z = cvt_pk_bf16(h[4], h[5]); w.w = cvt_pk_bf16(h[6], h[7]);
                *(u32x4*)rowp = w; }
    }
};
struct EpiScatter {
    static constexpr bool PERM = true, FP8 = false;
    static constexpr int NF8T = -1;
    static constexpr int NVM = 0;
    __device__ __forceinline__ void pre(PG8_LAS unsigned char*, const Unit&, int, int, int) const {}
    bf16_t* Y; const int* rowtok; const float* rowgate; const PG8_LAS int* cnt;
    __device__ __forceinline__ void operator()(const f32x4 (&acc)[2][2][4][2], const Unit& u, int wr, int wc, int fr, int fq, PG8_LAS unsigned char* lds, int ui) const {
        const int col0 = u.pn * BM + wc * 32 + 8 * fq, n_e = cnt[u.e];
        int tk[8]; float gt[8];
#pragma unroll
        for (int i = 0; i < 8; ++i) { int slot = u.j * BM + (i >> 2) * HALF + wr * 64 + (i & 3) * 16 + fr; const bool ok = slot < n_e; slot = ok ? slot : 0;
            tk[i] = rowtok[u.e * 65536 + slot]; gt[i] = rowgate[u.e * 65536 + slot]; tk[i] = ok ? tk[i] : -1; }
#pragma unroll
        for (int ai = 0; ai < 2; ++ai)
#pragma unroll
            for (int m = 0; m < 4; ++m) { const int i = ai * 4 + m;
                if (tk[i] >= 0) { bf16_t* rowp = Y + (size_t)tk[i] * 1024 + col0;
#pragma unroll
                    for (int bj = 0; bj < 2; ++bj) { const f32x4 v0 = acc[ai][bj][m][0] * gt[i], v1 = acc[ai][bj][m][1] * gt[i];
                        u32x4 w; w.x = cvt_pk_bf16(v0[0], v0[1]); w.y = cvt_pk_bf16(v0[2], v0[3]); w.z = cvt_pk_bf16(v1[0], v1[1]); w.w = cvt_pk_bf16(v1[2], v1[3]);
                        *(u32x4*)(rowp + bj * HALF) = w; } } }
    }
};

struct EpiSwiGLU8 {
    static constexpr bool PERM = true, FP8 = true;
    static constexpr int NF8T = -1;
    static constexpr int NVM = 8;
    static constexpr int LOOK_OFF = 131072 + 4096;
    unsigned char* H; const float* rowscale;
    __device__ __forceinline__ void pre(PG8_LAS unsigned char* lds, const Unit& u, int ui, int wid, int lane) const {
        if (wid < 4) __builtin_amdgcn_global_load_lds((const unsigned*)rowscale + u.e * 65536 + u.j * BM + 64 * wid + lane, (PG8_LAS unsigned*)(lds + LOOK_OFF + (ui & 1) * 1024 + wid * 256), 4, 0, 0);
    }
    __device__ __forceinline__ void operator()(const f32x4 (&acc)[2][2][4][2], const Unit& u, int wr, int wc, int fr, int fq, PG8_LAS unsigned char* lds, int ui) const {
        const int row0 = u.pm * BM + wr * 64 + fr, col0 = u.pn * HALF + wc * 32 + 8 * fq;
        const PG8_LAS float* ls = (const PG8_LAS float*)(lds + LOOK_OFF + (ui & 1) * 1024);
#pragma unroll
        for (int ai = 0; ai < 2; ++ai)
#pragma unroll
            for (int m = 0; m < 4; ++m) { unsigned char* rowp = H + (size_t)(row0 + ai * HALF + m * 16) * 256 + col0;
                const float sc = ls[ai * HALF + wr * 64 + m * 16 + fr] * 0.03125f;
                float h[8];
#pragma unroll
                for (int n = 0; n < 2; ++n)
#pragma unroll
                    for (int j = 0; j < 4; ++j) { const float g = acc[ai][0][m][n][j] * sc, up = acc[ai][1][m][n][j] * sc; h[n * 4 + j] = g * __builtin_amdgcn_rcpf(1.f + __expf(-g)) * up; }
                int w0 = 0, w1 = 0; w0 = __builtin_amdgcn_cvt_pk_fp8_f32(h[0], h[1], w0, false); w0 = __builtin_amdgcn_cvt_pk_fp8_f32(h[2], h[3], w0, true); w1 = __builtin_amdgcn_cvt_pk_fp8_f32(h[4], h[5], w1, false); w1 = __builtin_amdgcn_cvt_pk_fp8_f32(h[6], h[7], w1, true);
                *(unsigned long long*)rowp = (unsigned long long)(unsigned)w0 | ((unsigned long long)(unsigned)w1 << 32); }
    }
};
struct EpiScatter8 {
    static constexpr bool PERM = true, FP8 = true;
    static constexpr int NF8T = -1;
    static constexpr int NVM = 16;
    static constexpr int LOOK_OFF = 131072 + 4096;
    unsigned char* Y; const int* rowtok; const float* rowgate; const PG8_LAS int* cnt;
    __device__ __forceinline__ void pre(PG8_LAS unsigned char* lds, const Unit& u, int ui, int wid, int lane) const {
        const unsigned* src = (wid < 4 ? (const unsigned*)rowtok : (const unsigned*)rowgate) + u.e * 65536 + u.j * BM + 64 * (wid & 3) + lane;
        __builtin_amdgcn_global_load_lds(src, (PG8_LAS unsigned*)(lds + LOOK_OFF + (ui & 1) * 2048 + wid * 256), 4, 0, 0);
    }
    __device__ __forceinline__ void operator()(const f32x4 (&acc)[2][2][4][2], const Unit& u, int wr, int wc, int fr, int fq, PG8_LAS unsigned char* lds, int ui) const {
        const int col0 = u.pn * BM + wc * 32 + 8 * fq, n_e = cnt[u.e];
        const PG8_LAS int* ltok = (const PG8_LAS int*)(lds + LOOK_OFF + (ui & 1) * 2048); const PG8_LAS float* lgate = (const PG8_LAS float*)(lds + LOOK_OFF + (ui & 1) * 2048 + 1024);
        int tk[8]; float gt[8];
#pragma unroll
        for (int i = 0; i < 8; ++i) { const int r = (i >> 2) * HALF + wr * 64 + (i & 3) * 16 + fr; const bool ok = u.j * BM + r < n_e;
            tk[i] = ok ? ltok[r] : 2 * 65536; gt[i] = lgate[r] * 2.f; }
#pragma unroll
        for (int ai = 0; ai < 2; ++ai)
#pragma unroll
            for (int m = 0; m < 4; ++m) { const int i = ai * 4 + m;
                unsigned char* rowp = Y + (size_t)tk[i] * 1024 + col0;
#pragma unroll
                for (int bj = 0; bj < 2; ++bj) { const f32x4 v0 = acc[ai][bj][m][0] * gt[i], v1 = acc[ai][bj][m][1] * gt[i];
                    int w0 = 0, w1 = 0; w0 = __builtin_amdgcn_cvt_pk_fp8_f32(v0[0], v0[1], w0, false); w0 = __builtin_amdgcn_cvt_pk_fp8_f32(v0[2], v0[3], w0, true); w1 = __builtin_amdgcn_cvt_pk_fp8_f32(v1[0], v1[1], w1, false); w1 = __builtin_amdgcn_cvt_pk_fp8_f32(v1[2], v1[3], w1, true);
                    *(unsigned long long*)(rowp + bj * HALF) = (unsigned long long)(unsigned)w0 | ((unsigned long long)(unsigned)w1 << 32); } }
    }
};

template <class Epi, class Sched>
__device__ __forceinline__ void gemm_phase(PG8_LAS unsigned char* lds, const Gemm g, const Sched& S, const Epi& E) {
    constexpr bool GA = Sched::GATHER;
    const int tid = threadIdx.x, wid = __builtin_amdgcn_readfirstlane(tid >> 6), lane = tid & 63, wr = wid >> 2, wc = wid & 3, fr = lane & 15, fq = lane >> 4;
    int Kq = g.K; asm volatile("" : "+s"(Kq));
    const int K = Kq, nt = K / BK;
    unsigned voffA[2], voffB[2]; int RA[2], CA[2];
#pragma unroll
    for (int i = 0; i < 2; ++i) { int R, C; stage_rc(tid * 16 + i * 8192, R, C); const int Rb = Epi::PERM ? ((R & ~31) + perm32(R & 31)) : R;
        voffA[i] = (unsigned)(R * K + C) * 2u; voffB[i] = (unsigned)(Rb * K + C) * 2u; RA[i] = R; CA[i] = C; }
    const size_t kstep = (size_t)(BK * 2);
    const size_t hstep = (size_t)HALF * K * 2;
    const size_t hstepA = GA ? 0 : hstep;
    const unsigned ldsw = (unsigned)wid * 1024u;
    const int aoff = lds_byte(wr * 64 + fr, fq * 8), boff = lds_byte(wc * 32 + fr, fq * 8);
    constexpr bool MIXED = Epi::NF8T >= 0;
    constexpr bool F8 = Epi::FP8;
#define PG8_SA(b, h) (((b) * 2 + (h)) * HTB)
#define PG8_SB(b, h) ((4 + (b) * 2 + (h)) * HTB)
#define PG8_STAGE(bufoff, gbase, voff) do { _Pragma("unroll") for (int _i = 0; _i < 2; ++_i) \
        __builtin_amdgcn_global_load_lds((const unsigned*)((const char*)(gbase) + (voff)[_i]), (PG8_LAS unsigned*)(lds + (bufoff) + ldsw + _i * 8192), 16, 0, 0); } while (0)
#define PG8_LD2(p) __builtin_shufflevector(*(const PG8_LAS v4i*)(p), *(const PG8_LAS v4i*)((p) + 1024), 0, 1, 2, 3, 4, 5, 6, 7)
#define PG8_LDA(dst, b, h) do { _Pragma("unroll") for (int m = 0; m < 4; ++m) dst[m] = PG8_LD2(lds + PG8_SA(b, h) + aoff + m * 2048); } while (0)
#define PG8_LDB(dst, b, h) do { _Pragma("unroll") for (int n = 0; n < 2; ++n) dst[n] = PG8_LD2(lds + PG8_SB(b, h) + boff + n * 2048); } while (0)
#define PG8_LO(x) __builtin_shufflevector(x, x, 0, 1, 2, 3)
#define PG8_HI(x) __builtin_shufflevector(x, x, 4, 5, 6, 7)
#define PG8_MMA8(ai, bj, At, Bt) do { _Pragma("unroll") for (int m = 0; m < 4; ++m) _Pragma("unroll") for (int n = 0; n < 2; ++n) \
            asm volatile("v_mfma_f32_16x16x128_f8f6f4 %0, %1, %2, %0" : "+v"(acc[ai][bj][m][n]) : "v"(Bt[n]), "v"(At[m])); } while (0)
#define PG8_MMA16(ai, bj, At, Bt) do { _Pragma("unroll") for (int m = 0; m < 4; ++m) _Pragma("unroll") for (int n = 0; n < 2; ++n) { \
            asm volatile("v_mfma_f32_16x16x32_bf16 %0, %1, %2, %0" : "+v"(acc[ai][bj][m][n]) : "v"(PG8_LO(Bt[n])), "v"(PG8_LO(At[m]))); \
            asm volatile("v_mfma_f32_16x16x32_bf16 %0, %1, %2, %0" : "+v"(acc[ai][bj][m][n]) : "v"(PG8_HI(Bt[n])), "v"(PG8_HI(At[m]))); } } while (0)
#define PG8_MMA8P(ai, bj, At, Bt) do { __builtin_amdgcn_s_setprio(1); PG8_MMA8(ai, bj, At, Bt); __builtin_amdgcn_s_setprio(0); } while (0)
#define PG8_MMA16P(ai, bj, At, Bt) do { __builtin_amdgcn_s_setprio(1); PG8_MMA16(ai, bj, At, Bt); __builtin_amdgcn_s_setprio(0); } while (0)
#define PG8_MMA(ai, bj, At, Bt) do { __builtin_amdgcn_s_setprio(1); \
        if constexpr (F8) PG8_MMA8(ai, bj, At, Bt); else PG8_MMA16(ai, bj, At, Bt); \
        __builtin_amdgcn_s_setprio(0); } while (0)
#define PG8_WAIT_V(n) asm volatile("s_waitcnt vmcnt(" #n ")" ::: "memory")
#define PG8_WAIT_VN(n) asm volatile("s_waitcnt vmcnt(%0)" :: "n"(n) : "memory")
#define PG8_WAIT_L(n) asm volatile("s_waitcnt lgkmcnt(" #n ")" ::: "memory")
#define PG8_BAR __builtin_amdgcn_s_barrier()
#define PG8_SCHED __builtin_amdgcn_sched_barrier(0)
    Unit cur, nxt; int ui = 0;
    if (!S.next(0, cur)) return;
    f32x4 acc[2][2][4][2];
#pragma unroll
    for (int a = 0; a < 2; ++a)
#pragma unroll
        for (int b = 0; b < 2; ++b)
#pragma unroll
            for (int m = 0; m < 4; ++m)
#pragma unroll
                for (int n = 0; n < 2; ++n) { acc[a][b][m][n] = (f32x4){0.f, 0.f, 0.f, 0.f}; asm volatile("" : "+v"(acc[a][b][m][n])); }
    v8i At[4], B0[2], B1[2];
    const char* cA = S.a_tile(g, cur); const char* cB = S.b_tile(g, cur);
    unsigned cg0[2], cg1[2], ng0[2], ng1[2];
#pragma unroll
    for (int i = 0; i < 2; ++i) { cg0[i] = voffA[i]; cg1[i] = voffA[i]; ng0[i] = voffA[i]; ng1[i] = voffA[i]; }
    if constexpr (GA) {
#pragma unroll
        for (int i = 0; i < 2; ++i) { cg0[i] = (unsigned)(S.row_of(cur, RA[i]) * K + CA[i]) * 2u; cg1[i] = (unsigned)(S.row_of(cur, HALF + RA[i]) * K + CA[i]) * 2u; }
    }
    E.pre(lds, cur, 0, wid, lane);
    PG8_STAGE(PG8_SB(0, 0), cB, voffB); PG8_STAGE(PG8_SB(0, 1), cB + hstep, voffB); PG8_STAGE(PG8_SA(0, 0), cA, cg0); PG8_STAGE(PG8_SA(0, 1), cA + hstepA, cg1);
    if (wr == 1) PG8_BAR;
    PG8_WAIT_V(2); PG8_BAR;
    PG8_STAGE(PG8_SB(1, 0), cB + kstep, voffB); PG8_STAGE(PG8_SA(1, 0), cA + kstep, cg0); PG8_STAGE(PG8_SB(1, 1), cB + hstep + kstep, voffB);
    PG8_WAIT_V(6); PG8_BAR;
    for (;;) {
        const bool has_next = S.next(ui + 1, nxt);
        const char* nA = has_next ? S.a_tile(g, nxt) : cA; const char* nB = has_next ? S.b_tile(g, nxt) : cB;
        if constexpr (GA) {
            if (has_next) {
#pragma unroll
                for (int i = 0; i < 2; ++i) { ng0[i] = (unsigned)(S.row_of(nxt, RA[i]) * K + CA[i]) * 2u; ng1[i] = (unsigned)(S.row_of(nxt, HALF + RA[i]) * K + CA[i]) * 2u; }
            } else {
#pragma unroll
                for (int i = 0; i < 2; ++i) { ng0[i] = cg0[i]; ng1[i] = cg1[i]; }
            }
        }
#define PG8_BODY(MM) { \
            const bool last = (t == nt - 2); \
            const char* a1 = cA + (size_t)(t + 1) * kstep; \
            const char* a2 = last ? nA : cA + (size_t)(t + 2) * kstep; const char* b2 = last ? nB : cB + (size_t)(t + 2) * kstep; \
            const char* a3 = a2 + kstep; const char* b3 = b2 + kstep; \
            unsigned x0[2], x1[2]; \
            _Pragma("unroll") for (int i = 0; i < 2; ++i) { x0[i] = (GA && last) ? ng0[i] : cg0[i]; x1[i] = (GA && last) ? ng1[i] : cg1[i]; } \
              \
            const bool relaxed = Epi::NVM > 0 && t == 0 && ui > 0; \
              \
            PG8_LDB(B0, 0, 0); PG8_LDB(B1, 0, 1); PG8_SCHED; PG8_LDA(At, 0, 0); if (!(t == 0 && ui > 0)) PG8_STAGE(PG8_SA(1, 1), a1 + hstepA, cg1);     \
            PG8_WAIT_FIRST; PG8_WAIT_L(0); PG8_BAR; MM(0, 0, At, B0); MM(0, 1, At, B1); PG8_BAR; PG8_SCHED; \
              \
            PG8_LDA(At, 0, 1); PG8_STAGE(PG8_SB(0, 0), b2, voffB); PG8_STAGE(PG8_SB(0, 1), b2 + hstep, voffB); PG8_STAGE(PG8_SA(0, 0), a2, x0); \
            PG8_WAIT_FIRST; PG8_WAIT_L(0); PG8_BAR; MM(1, 0, At, B0); MM(1, 1, At, B1); PG8_BAR; PG8_SCHED; \
              \
            PG8_LDB(B0, 1, 0); PG8_LDB(B1, 1, 1); PG8_SCHED; PG8_LDA(At, 1, 0); PG8_STAGE(PG8_SA(0, 1), a2 + hstepA, x1); \
            PG8_WAIT_FIRST; PG8_WAIT_L(0); PG8_BAR; MM(0, 0, At, B0); MM(0, 1, At, B1); PG8_BAR; PG8_SCHED; \
              \
            PG8_LDA(At, 1, 1); PG8_STAGE(PG8_SB(1, 0), b3, voffB); PG8_STAGE(PG8_SB(1, 1), b3 + hstep, voffB); PG8_STAGE(PG8_SA(1, 0), a3, x0); \
            PG8_WAIT_V(8); PG8_WAIT_L(0); PG8_BAR; MM(1, 0, At, B0); MM(1, 1, At, B1); PG8_BAR; PG8_SCHED; }
#define PG8_WAIT_FIRST do { if (relaxed) PG8_WAIT_VN(8 + Epi::NVM); else PG8_WAIT_V(8); } while (0)
        if constexpr (MIXED) {
            int t = 0;
            for (; t < Epi::NF8T; t += 2) PG8_BODY(PG8_MMA8P)
            for (; t < nt; t += 2) PG8_BODY(PG8_MMA16P)
        } else {
            for (int t = 0; t < nt; t += 2) PG8_BODY(PG8_MMA)
        }
#undef PG8_WAIT_FIRST
#undef PG8_BODY
        if (has_next) PG8_STAGE(PG8_SA(1, 1), nA + kstep + hstepA, ng1);
        asm volatile("s_nop 15");
        if (wr == 0) PG8_BAR;
        E(acc, cur, wr, wc, fr, fq, lds, ui);
        if (!has_next) break;
#pragma unroll
        for (int a = 0; a < 2; ++a)
#pragma unroll
            for (int b = 0; b < 2; ++b)
#pragma unroll
                for (int m = 0; m < 4; ++m)
#pragma unroll
                    for (int n = 0; n < 2; ++n) { acc[a][b][m][n] = (f32x4){0.f, 0.f, 0.f, 0.f}; asm volatile("" : "+v"(acc[a][b][m][n])); }
        cur = nxt; cA = nA; cB = nB; ++ui;
        E.pre(lds, cur, ui, wid, lane);
        if constexpr (GA) {
#pragma unroll
            for (int i = 0; i < 2; ++i) { cg0[i] = ng0[i]; cg1[i] = ng1[i]; }
        }
        if (wr == 1) PG8_BAR;
    }
    PG8_WAIT_V(0);
    PG8_BAR;
#undef PG8_SA
#undef PG8_SB
#undef PG8_STAGE
#undef PG8_LDA
#undef PG8_LDB
#undef PG8_MMA
#undef PG8_MMA8
#undef PG8_MMA16
#undef PG8_MMA8P
#undef PG8_MMA16P
#undef PG8_LD2
#undef PG8_LO
#undef PG8_HI
#undef PG8_WAIT_V
#undef PG8_WAIT_VN
#undef PG8_WAIT_L
#undef PG8_BAR
#undef PG8_SCHED
}
}

#define XB_TMO      128
#define XB_XCNT(j)  (256  + 64 * (j))
#define XB_XSUB(j)  (1280 + 64 * (j))
#define XB_XGEN(j)  (2304 + 64 * (j))
#define XB_TOP      3328
#define XB_TOPGEN   3392
#define XCD_BAR_WORDS 3456
#define XB_SPIN_CAP (1u << 20)

__device__ __forceinline__ unsigned xb_ld(unsigned* p)              { return __hip_atomic_load(p, __ATOMIC_RELAXED, __HIP_MEMORY_SCOPE_AGENT); }
__device__ __forceinline__ unsigned xb_add(unsigned* p, unsigned v) { return __hip_atomic_fetch_add(p, v, __ATOMIC_RELAXED, __HIP_MEMORY_SCOPE_AGENT); }
__device__ __forceinline__ unsigned xb_xcc_id() { return (unsigned)__builtin_amdgcn_s_getreg((3 << 11) | 20) & 0xFu; }
#define XB_SPIN(cond, bar) do { unsigned _sp = 0; while (cond) { __builtin_amdgcn_s_sleep(1); \
    if ((++_sp & 255u) == 0u) { if (xb_ld(&(bar)[XB_TMO])) break; if (_sp > XB_SPIN_CAP) { atomicAdd(&(bar)[XB_TMO], 1u); break; } } } } while (0)

struct XcdBarrier { unsigned* bar; unsigned x; volatile LAS unsigned* st; };

__device__ __forceinline__ XcdBarrier xcd_barrier_post(unsigned* bar, volatile LAS unsigned* st) {
    XcdBarrier b; b.bar = bar; b.x = xb_xcc_id(); b.st = st;
    if (threadIdx.x == 0) (void)xb_add(&bar[XB_XCNT(b.x)], 1u);
    return b;
}
__device__ __forceinline__ void xcd_barrier_complete(unsigned* bar, unsigned x, unsigned& nloc, unsigned& nx) {
    const unsigned G = gridDim.x * gridDim.y * gridDim.z;
    unsigned sum, cnt, mine, sp = 0u;
    for (;;) {
        sum = 0u; cnt = 0u; mine = 0u;
#pragma unroll
        for (unsigned j = 0; j < 16; ++j) { const unsigned c = xb_ld(&bar[XB_XCNT(j)]); sum += c; cnt += (c > 0u) ? 1u : 0u; mine = (j == x) ? c : mine; }
        if (sum == G) break;
        __builtin_amdgcn_s_sleep(1);
        if ((++sp & 255u) == 0u) { if (xb_ld(&bar[XB_TMO])) break; if (sp > XB_SPIN_CAP) { atomicAdd(&bar[XB_TMO], 1u); break; } }
    }
    nloc = mine > 0u ? mine : 1u; nx = cnt > 0u ? cnt : 1u;
}
__device__ __forceinline__ void xcd_barrier(const XcdBarrier& b) {
    asm volatile("s_waitcnt vmcnt(0)" ::: "memory");
    __syncthreads();
    if (threadIdx.x == 0) {
        unsigned* bar = b.bar;
        __builtin_amdgcn_s_waitcnt(0);
        unsigned nloc = b.st[0], nx = b.st[1];
        if (nloc == 0u) { xcd_barrier_complete(bar, b.x, nloc, nx); b.st[0] = nloc; b.st[1] = nx; }
        const unsigned old = xb_add(&bar[XB_XSUB(b.x)], 1u);
        const unsigned gen = old / nloc;
        if (old + 1u == (gen + 1u) * nloc) {
            __builtin_amdgcn_fence(__ATOMIC_RELEASE, "agent");
            asm volatile("s_waitcnt vmcnt(0)" ::: "memory");
            const unsigned og = xb_add(&bar[XB_TOP], 1u);
            const unsigned tg = og / nx;
            if (og + 1u == (tg + 1u) * nx) xb_add(&bar[XB_TOPGEN], 1u);
            else XB_SPIN(xb_ld(&bar[XB_TOPGEN]) == tg, bar);
            __builtin_amdgcn_fence(__ATOMIC_ACQUIRE, "agent");
            xb_add(&bar[XB_XGEN(b.x)], 1u);
            asm volatile("s_waitcnt vmcnt(0)" ::: "memory");
        } else {
            XB_SPIN(xb_ld(&bar[XB_XGEN(b.x)]) == gen, bar);
            __builtin_amdgcn_fence(__ATOMIC_ACQUIRE, "agent");
            asm volatile("s_waitcnt vmcnt(0)" ::: "memory");
        }
    }
    __syncthreads();
}

struct Frame {
    LAS unsigned char* lds;
    unsigned* ctl;
    int tid, lane, wave, G, vcu;
    const float *x, *norm_mix_w, *w_in, *lb_logits, *hg_onorm_w, *conv_w, *a_log, *dt_bias, *gd_onorm_w, *w_out, *norm_moe_w, *wr_group, *wr_expert, *w_gate, *w_up, *w_down, *final_w;
    float* out;
    unsigned char* ws;
};

DI void transpose_item(const float* W, int K, int ldw, int nblk, bf16* WT, int row_off, LAS float* scr, int item, int lane) {
    const int kb = item / nblk, nb = item % nblk, k0 = 64 * kb, n0 = 32 * nb;
    f32x4 v[8];
#pragma unroll
    for (int i = 0; i < 8; ++i) v[i] = *(const f32x4*)(W + (size_t)(k0 + 8 * i + (lane >> 3)) * ldw + n0 + 4 * (lane & 7));
#pragma unroll
    for (int i = 0; i < 8; ++i) { LAS float* d = scr + (8 * i + (lane >> 3)) * 33 + 4 * (lane & 7); d[0] = v[i].x; d[1] = v[i].y; d[2] = v[i].z; d[3] = v[i].w; }
    LDS_WAIT(); asm volatile("" ::: "memory");
    const int c = lane & 7;
#pragma unroll
    for (int j = 0; j < 4; ++j) { const int n = (lane >> 3) + 8 * j; const LAS float* s = scr + (8 * c) * 33 + n;
        v4u o; o.x = pk2(s[0 * 33], s[1 * 33]); o.y = pk2(s[2 * 33], s[3 * 33]); o.z = pk2(s[4 * 33], s[5 * 33]); o.w = pk2(s[6 * 33], s[7 * 33]);
        *(v4u*)(WT + (size_t)(row_off + n0 + n) * K + k0 + 8 * c) = o; }
    LDS_WAIT(); asm volatile("" ::: "memory");
}

DI void transpose_item8(const float* W, int K, int ldw, int nblk, unsigned char* WT, int row_off, float scale, const float* kscale, LAS float* scr, int item, int lane) {
    const int kb = item / nblk, nb = item % nblk, k0 = 64 * kb, n0 = 32 * nb;
    f32x4 v[8];
#pragma unroll
    for (int i = 0; i < 8; ++i) v[i] = *(const f32x4*)(W + (size_t)(k0 + 8 * i + (lane >> 3)) * ldw + n0 + 4 * (lane & 7));
#pragma unroll
    for (int i = 0; i < 8; ++i) { LAS float* d = scr + (8 * i + (lane >> 3)) * 33 + 4 * (lane & 7); d[0] = v[i].x; d[1] = v[i].y; d[2] = v[i].z; d[3] = v[i].w; }
    LDS_WAIT(); asm volatile("" ::: "memory");
    const int c = lane & 7;
    float ks[8];
    if (kscale) { const f32x4 a = *(const f32x4*)(kscale + k0 + 8 * c), b = *(const f32x4*)(kscale + k0 + 8 * c + 4); ks[0] = a.x * scale; ks[1] = a.y * scale; ks[2] = a.z * scale; ks[3] = a.w * scale; ks[4] = b.x * scale; ks[5] = b.y * scale; ks[6] = b.z * scale; ks[7] = b.w * scale; }
    else {
#pragma unroll
        for (int i = 0; i < 8; ++i) ks[i] = scale; }
#pragma unroll
    for (int j = 0; j < 4; ++j) { const int n = (lane >> 3) + 8 * j; const LAS float* sp = scr + (8 * c) * 33 + n;
        const unsigned lo = pk4_fp8(sp[0 * 33] * ks[0], sp[1 * 33] * ks[1], sp[2 * 33] * ks[2], sp[3 * 33] * ks[3]), hi = pk4_fp8(sp[4 * 33] * ks[4], sp[5 * 33] * ks[5], sp[6 * 33] * ks[6], sp[7 * 33] * ks[7]);
        *(v2u*)(WT + (size_t)(row_off + n0 + n) * K + k0 + 8 * c) = (v2u){lo, hi}; }
    LDS_WAIT(); asm volatile("" ::: "memory");
}

DI void transpose_wout(const float* W, unsigned char* WT, LAS float* scr, int item, int lane) {
    const int kb = item / 32, nb = item % 32, k0 = 64 * kb, n0 = 32 * nb, hh = kb >> 1;
    f32x4 v[8];
#pragma unroll
    for (int i = 0; i < 8; ++i) v[i] = *(const f32x4*)(W + (size_t)(k0 + 8 * i + (lane >> 3)) * D + n0 + 4 * (lane & 7));
#pragma unroll
    for (int i = 0; i < 8; ++i) { LAS float* d = scr + (8 * i + (lane >> 3)) * 33 + 4 * (lane & 7); d[0] = v[i].x; d[1] = v[i].y; d[2] = v[i].z; d[3] = v[i].w; }
    LDS_WAIT(); asm volatile("" ::: "memory");
    const int c = lane & 7;
#pragma unroll
    for (int j = 0; j < 4; ++j) { const int n = (lane >> 3) + 8 * j; const LAS float* sp = scr + (8 * c) * 33 + n;
        unsigned char* row = WT + (size_t)(n0 + n) * OG_PITCH;
        if (hh < OG_NF) { const unsigned lo = pk4_fp8(sp[0 * 33] * 32.f, sp[1 * 33] * 32.f, sp[2 * 33] * 32.f, sp[3 * 33] * 32.f), hi = pk4_fp8(sp[4 * 33] * 32.f, sp[5 * 33] * 32.f, sp[6 * 33] * 32.f, sp[7 * 33] * 32.f);
            *(v2u*)(row + k0 + 8 * c) = (v2u){lo, hi}; }
        else { v4u o; o.x = pk2(sp[0 * 33] * 32.f, sp[1 * 33] * 32.f); o.y = pk2(sp[2 * 33] * 32.f, sp[3 * 33] * 32.f); o.z = pk2(sp[4 * 33] * 32.f, sp[5 * 33] * 32.f); o.w = pk2(sp[6 * 33] * 32.f, sp[7 * 33] * 32.f);
            *(v4u*)(row + OG_NF * 128 + (k0 - OG_NF * 128 + 8 * c) * 2) = o; }
    }
    LDS_WAIT(); asm volatile("" ::: "memory");
}

DI void p0_prologue(Frame& F) {
    LAS float* scr = (LAS float*)(F.lds + F.wave * 16384);
    const int gw = F.vcu * NWAVES + F.wave, NGW = F.G * NWAVES;
    constexpr int I_IN = (D / 64) * (NP / 32), I_OUT = (D / 64) * (D / 32);
    for (int it = gw; it < I_IN + I_OUT; it += NGW) {
        if (it < I_IN) transpose_item(F.w_in, D, INC, NP / 32, (bf16*)(F.ws + WS_WIN), 0, scr, it, F.lane);
        else transpose_wout(F.w_out, F.ws + WS_WOUT, scr, it - I_IN, F.lane);
    }
    {
        bf16* WR = (bf16*)(F.ws + WS_WR);
        const int gt = F.vcu * NTHR + F.tid, NGT = F.G * NTHR;
        for (int i = gt; i < 256 * D; i += NGT) { const int n = i >> 10, k = i & 1023;
            const float v = n < 8 ? F.wr_group[k * 8 + n] : (n < 72 ? F.wr_expert[k * 64 + (n - 8)] : 0.f);
            WR[i] = (bf16)f2bf(v * F.norm_moe_w[k]); }
        float* LB = (float*)(F.ws + WS_LB);
        if (gt < 512) { const float l0 = F.lb_logits[gt], l1 = F.lb_logits[512 + gt]; LB[gt] = 1.f / (1.f + __expf(l1 - l0)); }
    }
    float wn[16]; f32x4 wab[16][2];
#pragma unroll
    for (int j = 0; j < 4; ++j) { const f32x4 t = *(const f32x4*)(F.norm_mix_w + 4 * F.lane + 256 * j); wn[4 * j] = t.x; wn[4 * j + 1] = t.y; wn[4 * j + 2] = t.z; wn[4 * j + 3] = t.w; }
#pragma unroll
    for (int j = 0; j < 4; ++j)
#pragma unroll
        for (int e = 0; e < 4; ++e) { const int k = 4 * F.lane + 256 * j + e; const float* p = F.w_in + (size_t)k * INC + NP; wab[4 * j + e][0] = *(const f32x4*)p; wab[4 * j + e][1] = *(const f32x4*)(p + 4); }
    bf16* HN = (bf16*)F.out; float* AB = (float*)(F.ws + WS_AB); float* RXI = (float*)(F.ws + WS_RXI);
    f32x4 nx[4];
    if (gw < T) {
#pragma unroll
        for (int j = 0; j < 4; ++j) nx[j] = ((const f32x4*)(F.x + (size_t)gw * D) + F.lane)[64 * j]; }
    for (int m = gw; m < T; m += NGW) {
        f32x4 cx[4];
#pragma unroll
        for (int j = 0; j < 4; ++j) cx[j] = nx[j];
        if (m + NGW < T) {
#pragma unroll
            for (int j = 0; j < 4; ++j) nx[j] = ((const f32x4*)(F.x + (size_t)(m + NGW) * D) + F.lane)[64 * j]; }
        float v[16]; float s = 0.f;
#pragma unroll
        for (int j = 0; j < 4; ++j) { const f32x4 t = cx[j]; v[4 * j] = t.x; v[4 * j + 1] = t.y; v[4 * j + 2] = t.z; v[4 * j + 3] = t.w; s += (t.x * t.x + t.y * t.y) + (t.z * t.z + t.w * t.w); }
        const float ms = wave_sum(s) * (1.f / D) + EPS; const float r = frsq(ms);
        if (F.lane == 0) RXI[m] = ms * r;
        float p[8];
#pragma unroll
        for (int c = 0; c < 8; ++c) p[c] = 0.f;
#pragma unroll
        for (int i = 0; i < 16; ++i) { v[i] = v[i] * r * wn[i];
#pragma unroll
            for (int c = 0; c < 4; ++c) { p[c] += v[i] * wab[i][0][c]; p[4 + c] += v[i] * wab[i][1][c]; } }
        unsigned long long* o8 = (unsigned long long*)(HN + (size_t)m * D) + F.lane;
#pragma unroll
        for (int j = 0; j < 4; ++j) o8[64 * j] = (unsigned long long)pk2(v[4 * j], v[4 * j + 1]) | ((unsigned long long)pk2(v[4 * j + 2], v[4 * j + 3]) << 32);
        float mine = 0.f;
#pragma unroll
        for (int c = 0; c < 8; ++c) { const float t = wave_sum(p[c]); mine = (F.lane == c) ? t : mine; }
        if (F.lane < 8) AB[(size_t)m * 8 + F.lane] = mine;
    }
}

DI bf16x8 ldfrag(const LAS bf16* base, int ld, int lane) { return *(const LAS bf16x8*)(base + (lane & 15) * ld + 8 * (lane >> 4)); }
#define MFMA16(a, b, c) __builtin_amdgcn_mfma_f32_16x16x32_bf16((a), (b), (c), 0, 0, 0)
constexpr float QSCALE = 0.08838834764831845f;
DI size_t prb(int bn, int cb) { return ((size_t)bn * 32 + cb) * 8192; }

DI void hg_raw_load(Frame& F, int item, unsigned (&nq)[16], unsigned (&nf)[16], unsigned (&ni)[16], float& nlb) {
    const int h = item & 3, bn = item >> 2, ch = F.tid & 127, tg = F.tid >> 7;
    const bf16* pbase = (const bf16*)(F.ws + WS_R2) + prb(bn, h) + (tg * 16) * 128 + ch;
#pragma unroll
    for (int i = 0; i < 16; ++i) { const bf16* p = pbase + i * 128; nq[i] = p[0]; nf[i] = p[4 * 8192]; ni[i] = p[8 * 8192]; }
    nlb = ((const float*)(F.ws + WS_LB))[h * 128 + ch];
}
DI void hg_pre_item(Frame& F, int item, bf16* PRo, int ldo, bf16* OGo, float* DL, unsigned (&nq)[16], unsigned (&nf)[16], unsigned (&ni)[16], float& nlb, int next_item) {
    const int h = item & 3, bn = item >> 2, tok0 = bn * 64;
    LAS bf16* Aq = (LAS bf16*)F.lds; LAS bf16* Ak = Aq + 64 * 136; LAS bf16* Vt = Ak + 64 * 136; LAS bf16* Att = Vt + 128 * 72; LAS float* part = (LAS float*)(Att + 64 * 72);
    bf16* PR = (bf16*)(F.ws + WS_R2); bf16* R1 = (bf16*)(F.ws + WS_R1);
    const float* LB = (const float*)(F.ws + WS_LB);
    const int ch = F.tid & 127, tg = F.tid >> 7, lane = F.lane, wave = F.wave;
    const float lbv = nlb, olb = 1.f - lbv;
    float qv[16], kk[16], cum[16]; unsigned iv[16], cq[16], cf[16];
#pragma unroll
    for (int i = 0; i < 16; ++i) { cq[i] = nq[i]; cf[i] = nf[i]; iv[i] = ni[i]; }
    if (next_item >= 0) hg_raw_load(F, next_item, nq, nf, ni, nlb);
    float run = 0.f;
    bf16* pbase = PR + prb(bn, h) + (tg * 16) * 128 + ch; bf16* pobase = PRo + prb(bn, h) + (tg * 16) * 128 + ch;
#pragma unroll
    for (int i = 0; i < 16; ++i) {
        const float q = bf2f(cq[i]), fl = bf2f(cf[i]);
        const float e = __expf(-fl), sg = frcp(1.f + e);
        const float f = lbv + olb * sg; run += __logf(f); cum[i] = run; kk[i] = olb * (e * sg); qv[i] = silu(q) * QSCALE; }
    part[tg * 128 + ch] = run;
    LSYNC();
    const float p0 = part[ch], p1 = part[128 + ch], p2 = part[256 + ch], p3 = part[384 + ch];
    const float prefix = (tg > 0 ? p0 : 0.f) + (tg > 1 ? p1 : 0.f) + (tg > 2 ? p2 : 0.f), last = ((p0 + p1) + p2) + p3, cref = p0 + p1;
    unsigned kd[8], ivp[8];
    const float ecref = __expf(cref), elc = __expf(last - cref);
#pragma unroll
    for (int i = 0; i < 16; i += 2) {
        const float c0 = cum[i] + prefix, c1 = cum[i + 1] + prefix; const int t = tg * 16 + i;
        const float e0 = __expf(c0 - cref), e1 = __expf(c1 - cref), r0 = __expf(cref - c0), r1 = __expf(cref - c1);
        Aq[t * 136 + ch] = (bf16)f2bf(qv[i] * e0); Aq[(t + 1) * 136 + ch] = (bf16)f2bf(qv[i + 1] * e1);
        Ak[t * 136 + ch] = (bf16)f2bf(kk[i] * r0); Ak[(t + 1) * 136 + ch] = (bf16)f2bf(kk[i + 1] * r1);
        pobase[i * 128] = (bf16)f2bf(qv[i] * e0 * ecref); pobase[(i + 1) * 128] = (bf16)f2bf(qv[i + 1] * e1 * ecref);
        kd[i >> 1] = pk2(kk[i] * r0 * elc, kk[i + 1] * r1 * elc); ivp[i >> 1] = iv[i] | (iv[i + 1] << 16); }
    {
        bf16* kp = PRo + prb(bn, 4 + h) + ch * 64 + tg * 16;
        *(v4u*)kp = (v4u){kd[0], kd[1], kd[2], kd[3]}; *(v4u*)(kp + 8) = (v4u){kd[4], kd[5], kd[6], kd[7]};
        *(v4u*)(kp + 4 * 8192) = (v4u){ivp[0], ivp[1], ivp[2], ivp[3]}; *(v4u*)(kp + 4 * 8192 + 8) = (v4u){ivp[4], ivp[5], ivp[6], ivp[7]};
        LAS bf16* vp = Vt + ch * 72 + tg * 16;
        *(LAS v4u*)vp = (v4u){ivp[0], ivp[1], ivp[2], ivp[3]}; *(LAS v4u*)(vp + 8) = (v4u){ivp[4], ivp[5], ivp[6], ivp[7]};
        if (tg == 0) DL[(size_t)item * 128 + ch] = __expf(last);
    }
    LSYNC();
#pragma unroll
    for (int j = 0; j < 2; ++j) { const int id = wave * 2 + j, tt = id >> 2, st = id & 3; const int c = lane & 15, q = lane >> 4;
        f32x4 acc = (f32x4){0.f, 0.f, 0.f, 0.f};
        if (st <= tt) {
#pragma unroll
            for (int kc = 0; kc < 4; ++kc) acc = MFMA16(ldfrag(Ak + st * 16 * 136 + kc * 32, 136, lane), ldfrag(Aq + tt * 16 * 136 + kc * 32, 136, lane), acc);
        }
        const int t = tt * 16 + c, s0 = st * 16 + 4 * q;
        const float a0 = (s0 <= t) ? acc[0] : 0.f, a1 = (s0 + 1 <= t) ? acc[1] : 0.f, a2 = (s0 + 2 <= t) ? acc[2] : 0.f, a3 = (s0 + 3 <= t) ? acc[3] : 0.f;
        *(LAS v2u*)(Att + t * 72 + s0) = (v2u){pk2(a0, a1), pk2(a2, a3)}; }
    LSYNC();
#pragma unroll
    for (int j = 0; j < 4; ++j) { const int id = wave * 4 + j, tt = id >> 3, vt = id & 7; const int c = lane & 15, q = lane >> 4;
        f32x4 acc = (f32x4){0.f, 0.f, 0.f, 0.f};
#pragma unroll
        for (int sc = 0; sc < 2; ++sc) acc = MFMA16(ldfrag(Vt + vt * 16 * 72 + sc * 32, 72, lane), ldfrag(Att + tt * 16 * 72 + sc * 32, 72, lane), acc);
        *(v2u*)(OGo + (size_t)(tok0 + tt * 16 + c) * D + h * 128 + vt * 16 + 4 * q) = (v2u){pk2(acc[0], acc[1]), pk2(acc[2], acc[3])}; }
    LSYNC();
}

#define DPP_ADD(v, ctrl) (v) += __builtin_bit_cast(float, __builtin_amdgcn_mov_dpp(__builtin_bit_cast(int, (v)), (ctrl), 0xF, 0xF, true))
DI float row16_sum(float v) { DPP_ADD(v, 0xB1); DPP_ADD(v, 0x4E); DPP_ADD(v, 0x141); DPP_ADD(v, 0x140); return v; }
DI v4u pack8(const float (&y)[8]) { return (v4u){pk2(y[0], y[1]), pk2(y[2], y[3]), pk2(y[4], y[5]), pk2(y[6], y[7])}; }
DI void gd_raw_load(Frame& F, int item, v4u (&raw)[11], f32x4 (&cw)[4][2]) {
    const int h = item & 3, bn = item >> 2, n = bn & 63; const int X = F.wave >> 1, rg = (F.tid >> 4) & 7, c16 = F.tid & 15;
    const bf16* p = (const bf16*)(F.ws + WS_R2) + prb(bn, 16 + 4 * X + h) + 8 * c16;
#pragma unroll
    for (int i = 0; i < 11; ++i) { const int rr = 8 * rg - 3 + i; raw[i] = (v4u){0u, 0u, 0u, 0u};
        if (rr >= 0) raw[i] = *(const v4u*)(p + rr * 128); else if (n > 0) raw[i] = *(const v4u*)(p - (long)32 * 8192 + (64 + rr) * 128); }
#pragma unroll
    for (int j = 0; j < 4; ++j) { const float* wp = F.conv_w + j * 1536 + 512 * X + h * 128 + 8 * c16; cw[j][0] = *(const f32x4*)wp; cw[j][1] = *(const f32x4*)(wp + 4); }
}
DI void gd_pre_item(Frame& F, int item, v4u (&raw)[11], f32x4 (&cw)[4][2], float (&pab)[2], int next_item) {
    const int h = item & 3, bn = item >> 2, n = bn & 63, tok0 = bn * 64;
    LAS bf16* Qs = (LAS bf16*)F.lds; LAS bf16* Ks = Qs + 64 * 136; LAS bf16* Ab = Ks + 64 * 136; LAS bf16* Tm = Ab + 64 * 72; LAS bf16* TT = Tm + 64 * 72; LAS bf16* RHST = TT + 64 * 72;
    LAS float* A16 = (LAS float*)(RHST + 256 * 72); LAS bf16* MT16 = (LAS bf16*)(A16 + 1024); LAS float* gcS = (LAS float*)(MT16 + 16 * 24); LAS float* egcS = gcS + 64; LAS float* betaS = gcS + 128;
    const bf16* PR = (const bf16*)(F.ws + WS_R2); bf16* R1 = (bf16*)(F.ws + WS_R1); const float* AB = (const float*)(F.ws + WS_AB);
    bf16* GW = (bf16*)(F.ws + WS_GW) + (size_t)item * 8192; bf16* GU = (bf16*)(F.ws + WS_GU) + (size_t)item * 8192;
    bf16* GQG = (bf16*)(F.ws + WS_GQG) + (size_t)item * 8192; bf16* GKD = (bf16*)(F.ws + WS_GKD) + (size_t)item * 8192;
    int tidv = F.tid; asm volatile("" : "+v"(tidv));
    const int lane = tidv & 63, wave = F.wave, c = lane & 15, q = lane >> 4;
    float y[8][8];
    const int X = wave >> 1, rg = (tidv >> 4) & 7, c16 = tidv & 15;
    if (wave < 6) {
        const int ccol = 512 * X + h * 128 + 8 * c16;
#pragma unroll
        for (int ep = 0; ep < 4; ++ep) {
            float w0[4], w1[4];
#pragma unroll
            for (int j = 0; j < 4; ++j) { w0[j] = cw[j][ep >> 1][(2 * ep) & 3]; w1[j] = cw[j][ep >> 1][((2 * ep) & 3) + 1]; }
            float u0[11], u1[11];
#pragma unroll
            for (int i = 0; i < 11; ++i) { u0[i] = bflo(raw[i][ep]); u1[i] = bfhi(raw[i][ep]); }
#pragma unroll
            for (int t = 0; t < 8; ++t) { float a = u0[t] * w0[0]; a += u0[t + 1] * w0[1]; a += u0[t + 2] * w0[2]; a += u0[t + 3] * w0[3];
                float b = u1[t] * w1[0]; b += u1[t + 1] * w1[1]; b += u1[t + 2] * w1[2]; b += u1[t + 3] * w1[3];
                y[t][2 * ep] = silu(a); y[t][2 * ep + 1] = silu(b); }
        }
        if (next_item >= 0) gd_raw_load(F, next_item, raw, cw);
        if (X < 2) {
#pragma unroll
            for (int t = 0; t < 8; ++t) { float s = 0.f;
#pragma unroll
                for (int e = 0; e < 8; ++e) s += y[t][e] * y[t][e];
                s = row16_sum(s); const float r = (X == 0 ? QSCALE : 1.f) * frsq(s + 1e-6f);
#pragma unroll
                for (int e = 0; e < 8; ++e) y[t][e] *= r; }
        }
    } else if (wave == 6) {
        const float a = pab[0], b = pab[1];
        if (next_item >= 0) { const int nh = next_item & 3, ntok = (next_item >> 2) * 64 + lane; pab[0] = AB[(size_t)ntok * 8 + nh]; pab[1] = AB[(size_t)ntok * 8 + 4 + nh]; }
        const float xx = a + F.dt_bias[h]; const float sp = xx > 20.f ? xx : __logf(1.f + __expf(xx));
        float gc = -__expf(F.a_log[h]) * sp;
#pragma unroll
        for (int o = 1; o < 64; o <<= 1) { const float t = __shfl_up(gc, o); if (lane >= o) gc += t; }
        gcS[lane] = gc; egcS[lane] = __expf(gc); betaS[lane] = frcp(1.f + __expf(-b));
        if (lane == 63) ((float*)(F.ws + WS_GEND))[item] = __expf(gc);
    } else {
        for (int i = lane; i < 3 * 64 * 72 / 8; i += 64) ((LAS v4u*)Ab)[i] = (v4u){0u, 0u, 0u, 0u};
    }
    LSYNC();
    if (wave < 6) {
        const float glast = gcS[63];
        float bt[8], eg[8], kdx[8];
#pragma unroll
        for (int t = 0; t < 8; ++t) { bt[t] = betaS[8 * rg + t]; eg[t] = egcS[8 * rg + t]; kdx[t] = __expf(glast - gcS[8 * rg + t]); }
        if (X == 0) {
#pragma unroll
            for (int t = 0; t < 8; ++t) { *(LAS v4u*)(Qs + (8 * rg + t) * 136 + 8 * c16) = pack8(y[t]);
                float z[8];
#pragma unroll
                for (int e = 0; e < 8; ++e) z[e] = y[t][e] * eg[t];
                *(v4u*)(GQG + (8 * rg + t) * 128 + 8 * c16) = pack8(z); }
        } else if (X == 1) {
#pragma unroll
            for (int t = 0; t < 8; ++t) *(LAS v4u*)(Ks + (8 * rg + t) * 136 + 8 * c16) = pack8(y[t]);
#pragma unroll
            for (int e = 0; e < 8; ++e) { float z[8], z2[8];
#pragma unroll
                for (int t = 0; t < 8; ++t) { z[t] = y[t][e] * bt[t] * eg[t]; z2[t] = y[t][e] * kdx[t]; }
                *(LAS v4u*)(RHST + (8 * c16 + e) * 72 + 8 * rg) = pack8(z); *(v4u*)(GKD + (8 * c16 + e) * 64 + 8 * rg) = pack8(z2); }
        } else {
#pragma unroll
            for (int e = 0; e < 8; ++e) { float z[8];
#pragma unroll
                for (int t = 0; t < 8; ++t) z[t] = y[t][e] * bt[t];
                *(LAS v4u*)(RHST + (128 + 8 * c16 + e) * 72 + 8 * rg) = pack8(z); }
        }
    }
    LSYNC();
    for (int id = wave; id < 26; id += 8) {
        if (id >= 20) { const int ui = id - 20; const int tt = ui < 3 ? 0 : (ui < 5 ? 1 : 2), st = ui < 3 ? ui + 1 : (ui < 5 ? ui - 1 : 3);
            *(v2u*)(R1 + (size_t)(tok0 + tt * 16 + c) * D + 512 + h * 128 + st * 16 + 4 * q) = (v2u){0u, 0u}; continue; }
        const int which = id >= 10, li = which ? id - 10 : id; const int tt = li >= 6 ? 3 : (li >= 3 ? 2 : (li >= 1 ? 1 : 0)), st = li - tt * (tt + 1) / 2;
        f32x4 acc = (f32x4){0.f, 0.f, 0.f, 0.f};
        const LAS bf16* Fb = (which ? Qs : Ks) + tt * 16 * 136;
#pragma unroll
        for (int kc = 0; kc < 4; ++kc) acc = MFMA16(ldfrag(Ks + st * 16 * 136 + kc * 32, 136, lane), ldfrag(Fb + kc * 32, 136, lane), acc);
        const int t = tt * 16 + c, s0 = st * 16 + 4 * q; const float gt = gcS[t];
        float vals[4];
#pragma unroll
        for (int r = 0; r < 4; ++r) { const int s = s0 + r; const bool keep = which ? (s <= t) : (s < t); vals[r] = keep ? acc[r] * __expf(gt - gcS[s]) : 0.f; }
        if (which == 0) { const float b2 = betaS[t];
#pragma unroll
            for (int r = 0; r < 4; ++r) vals[r] *= b2;
            *(LAS v2u*)(Ab + t * 72 + s0) = (v2u){pk2(vals[0], vals[1]), pk2(vals[2], vals[3])};
            if (tt == st) *(LAS f32x4*)(A16 + tt * 256 + c * 16 + 4 * q) = (f32x4){vals[0], vals[1], vals[2], vals[3]}; }
        else *(v2u*)(R1 + (size_t)(tok0 + t) * D + 512 + h * 128 + s0) = (v2u){pk2(vals[0], vals[1]), pk2(vals[2], vals[3])};
    }
    LSYNC();
    if (wave == 0) {
        { const int bi = q, j = c; float x[16];
          f32x4 ar[16][4];
#pragma unroll
          for (int r = 1; r < 16; ++r)
#pragma unroll
              for (int s4 = 0; s4 < (r + 3) / 4; ++s4) ar[r][s4] = *(const LAS f32x4*)(A16 + bi * 256 + r * 16 + 4 * s4);
#pragma unroll
          for (int r = 0; r < 16; ++r) { float a = (r == j) ? 1.f : 0.f;
#pragma unroll
              for (int s = 0; s < r; ++s) a -= ar[r][s >> 2][s & 3] * x[s];
              x[r] = a; }
          unsigned pk[8];
#pragma unroll
          for (int r = 0; r < 16; r += 2) { pk[r >> 1] = pk2(x[r], x[r + 1]); Tm[(16 * bi + r) * 72 + 16 * bi + j] = (bf16)(pk[r >> 1] & 0xffffu); Tm[(16 * bi + r + 1) * 72 + 16 * bi + j] = (bf16)(pk[r >> 1] >> 16); }
          *(LAS v4u*)(TT + (16 * bi + j) * 72 + 16 * bi) = (v4u){pk[0], pk[1], pk[2], pk[3]}; *(LAS v4u*)(TT + (16 * bi + j) * 72 + 16 * bi + 8) = (v4u){pk[4], pk[5], pk[6], pk[7]}; }
#pragma unroll
        for (int d = 1; d < 4; ++d)
#pragma unroll
            for (int i = d; i < 4; ++i) { const int j = i - d;
                f32x4 m = (f32x4){0.f, 0.f, 0.f, 0.f};
#pragma unroll
                for (int kc = 0; kc < 2; ++kc) m = MFMA16(ldfrag(Ab + 16 * i * 72 + kc * 32, 72, lane), ldfrag(TT + 16 * j * 72 + kc * 32, 72, lane), m);
                *(LAS v2u*)(MT16 + c * 24 + 4 * q) = (v2u){pk2(m[0], m[1]), pk2(m[2], m[3])};
                const bool on = (q >> 1) == (i & 1);
                bf16x8 fa = ldfrag(Tm + 16 * i * 72 + ((16 * i) & ~31), 72, lane); bf16x8 fb = *(const LAS bf16x8*)(MT16 + c * 24 + 8 * (q & 1));
                if (!on) { fa = (bf16x8){0, 0, 0, 0, 0, 0, 0, 0}; fb = fa; }
                const f32x4 t2 = MFMA16(fa, fb, ((f32x4){0.f, 0.f, 0.f, 0.f}));
                const unsigned p0 = pk2(-t2[0], -t2[1]), p1 = pk2(-t2[2], -t2[3]);
                *(LAS v2u*)(TT + (16 * j + c) * 72 + 16 * i + 4 * q) = (v2u){p0, p1};
                Tm[(16 * i + 4 * q) * 72 + 16 * j + c] = (bf16)(p0 & 0xffffu); Tm[(16 * i + 4 * q + 1) * 72 + 16 * j + c] = (bf16)(p0 >> 16);
                Tm[(16 * i + 4 * q + 2) * 72 + 16 * j + c] = (bf16)(p1 & 0xffffu); Tm[(16 * i + 4 * q + 3) * 72 + 16 * j + c] = (bf16)(p1 >> 16); }
    }
    LSYNC();
#pragma unroll
    for (int jj = 0; jj < 8; ++jj) { const int id = wave * 8 + jj, isu = id >> 5, tt = (id >> 3) & 3, ct = id & 7;
        f32x4 acc = (f32x4){0.f, 0.f, 0.f, 0.f};
        const LAS bf16* Rr = RHST + (isu * 128 + ct * 16) * 72; const LAS bf16* Tr = Tm + tt * 16 * 72;
        if (!isu) {
#pragma unroll
            for (int kc = 0; kc < 2; ++kc) acc = MFMA16(ldfrag(Rr + kc * 32, 72, lane), ldfrag(Tr + kc * 32, 72, lane), acc);
            *(v2u*)(GW + (tt * 16 + c) * 128 + ct * 16 + 4 * q) = (v2u){pk2(acc[0], acc[1]), pk2(acc[2], acc[3])};
        } else {
#pragma unroll
            for (int kc = 0; kc < 2; ++kc) acc = MFMA16(ldfrag(Tr + kc * 32, 72, lane), ldfrag(Rr + kc * 32, 72, lane), acc);
            *(v2u*)(GU + (ct * 16 + c) * 64 + tt * 16 + 4 * q) = (v2u){pk2(acc[0], acc[1]), pk2(acc[2], acc[3])};
        }
    }
    LSYNC();
}

#define MKRSRC(ptr) __builtin_amdgcn_make_buffer_rsrc((void*)(ptr), 0, 0x7fffffff, 0x00020000)
#define BLD128(rs, vo, so) __builtin_bit_cast(v4u, __builtin_amdgcn_raw_buffer_load_b128((rs), (int)(vo), (int)(so), 0))
DI float qsum(float p) { p += __shfl_xor(p, 16); p += __shfl_xor(p, 32); return p; }
DI bf16x8 ldfragP(const LAS bf16* base, int ld, int lane) {
    const LAS bf16* p = base + (lane & 15) * ld + 4 * (lane >> 4); const v2u lo = *(const LAS v2u*)p, hi = *(const LAS v2u*)(p + 16);
    return __builtin_bit_cast(bf16x8, (v4u){lo.x, lo.y, hi.x, hi.y}); }
DI bf16x8 accpair(const f32x4 a, const f32x4 b) { return __builtin_bit_cast(bf16x8, (v4u){pk2(a[0], a[1]), pk2(a[2], a[3]), pk2(b[0], b[1]), pk2(b[2], b[3])}); }
DI bf16x8 accpair_neg(const f32x4 a, const f32x4 b) { return __builtin_bit_cast(bf16x8, (v4u){pk2(-a[0], -a[1]), pk2(-a[2], -a[3]), pk2(-b[0], -b[1]), pk2(-b[2], -b[3])}); }
DI f32x4 ld4bf(const LAS bf16* p) { const v2u x = *(const LAS v2u*)p; return (f32x4){bflo(x.x), bfhi(x.x), bflo(x.y), bfhi(x.y)}; }

template <int NOLOAD>
DI void hg_chain(Frame& F, int b, int h, unsigned char* OGo, unsigned* prog) {
    LAS bf16* A1 = (LAS bf16*)F.lds; LAS bf16* A2 = A1 + 64 * 136; LAS bf16* B2 = A2 + 128 * 72; LAS bf16* Gs = B2 + 128 * 72; LAS bf16* Is = Gs + 64 * 136; LAS bf16* OGs = Is + 64 * 136;
    LAS float* dl = (LAS float*)(OGs + 64 * 136); LAS float* PS = dl + 128;
    const bf16* PR = (const bf16*)(F.ws + WS_R2); const bf16* R1 = (const bf16*)(F.ws + WS_R1); const float* DL = (const float*)(F.ws + WS_DLAST);
    const int tid = F.tid, lane0 = F.lane, w = F.wave;
    if (w >= 4) {
        int lt_ = tid - 256; asm volatile("" : "+v"(lt_));
        const int lt = lt_, r1 = lt >> 2, s1 = lt & 3, k2 = lt >> 1, s2 = lt & 1;
        const unsigned oA1 = (unsigned)(r1 * 128 + s1 * 32), oA2 = (unsigned)(4 * 8192 + k2 * 64 + s2 * 32), oB2 = oA2 + 4u * 8192u, oG = oA1 + 12u * 8192u;
        const unsigned oI = (unsigned)(r1 * D + h * 128 + s1 * 32);
        const __amdgpu_buffer_rsrc_t rsP = MKRSRC(PR), rsI = MKRSRC(R1);
        v4u pa[4], pb[4], pc[4], pg[4], pi[4]; float pdl = 0.f;
#define HG_LOAD(n_) do { const int bn_ = b * 64 + (n_); const unsigned so_ = (unsigned)(prb(bn_, h) * 2), si_ = (unsigned)(bn_ * 64 * D * 2); \
            _Pragma("unroll") for (int i_ = 0; i_ < 4; ++i_) { pa[i_] = BLD128(rsP, 2u * oA1 + 16u * i_, so_); pb[i_] = BLD128(rsP, 2u * oA2 + 16u * i_, so_); pc[i_] = BLD128(rsP, 2u * oB2 + 16u * i_, so_); \
                pg[i_] = BLD128(rsP, 2u * oG + 16u * i_, so_); pi[i_] = BLD128(rsI, 2u * oI + 16u * i_, si_); } \
            if (lt < 128) pdl = DL[(size_t)(bn_ * 4 + h) * 128 + lt]; } while (0)
        HG_LOAD(0);
        for (int n = 0; n <= NCH; ++n) {
            if (n < NCH) {
#pragma unroll
                for (int i = 0; i < 4; ++i) { *(LAS v4u*)(A1 + r1 * 136 + s1 * 32 + 8 * i) = pa[i]; *(LAS v4u*)(A2 + k2 * 72 + s2 * 32 + 8 * i) = pb[i]; *(LAS v4u*)(B2 + k2 * 72 + s2 * 32 + 8 * i) = pc[i];
                    *(LAS v4u*)(Gs + r1 * 136 + s1 * 32 + 8 * i) = pg[i]; *(LAS v4u*)(Is + r1 * 136 + s1 * 32 + 8 * i) = pi[i]; }
                if (lt < 128) dl[lt] = pdl;
            }
            LSYNC();
            if (lt == 0) __hip_atomic_store(prog, (unsigned)(n + 1), __ATOMIC_RELAXED, __HIP_MEMORY_SCOPE_AGENT);
            if (NOLOAD == 0 && n + 1 < NCH) HG_LOAD(n + 1);
            if (NOLOAD == 2 && n + 1 < NCH) HG_LOAD(n & 1);
            if (n > 0) {
                unsigned char* orow = OGo + (size_t)((b * 64 + n - 1) * 64 + r1) * OG_PITCH;
                if ((h) < OG_NF) {
                    unsigned char* og = orow + (h) * 128 + s1 * 32;
                    unsigned o8[8];
#pragma unroll
                    for (int i = 0; i < 4; ++i) { const v4u t = *(const LAS v4u*)(OGs + r1 * 136 + s1 * 32 + 8 * i);
                        o8[2 * i] = pk4_fp8(bflo(t.x), bfhi(t.x), bflo(t.y), bfhi(t.y)); o8[2 * i + 1] = pk4_fp8(bflo(t.z), bfhi(t.z), bflo(t.w), bfhi(t.w)); }
                    *(v4u*)og = (v4u){o8[0], o8[1], o8[2], o8[3]}; *(v4u*)(og + 16) = (v4u){o8[4], o8[5], o8[6], o8[7]};
                } else {
                    unsigned char* og = orow + OG_NF * 128 + ((h) - OG_NF) * 256 + s1 * 64;
#pragma unroll
                    for (int i = 0; i < 4; ++i) *(v4u*)(og + 16 * i) = *(const LAS v4u*)(OGs + r1 * 136 + s1 * 32 + 8 * i);
                }
            }
            LSYNC();
        }
#undef HG_LOAD
    } else {
        int ln_ = lane0; asm volatile("" : "+v"(ln_)); const int lane = ln_, c = lane & 15, q = lane >> 4;
        f32x4 onw4[2];
#pragma unroll
        for (int j = 0; j < 2; ++j) onw4[j] = *(const f32x4*)(F.hg_onorm_w + 32 * w + 16 * j + 4 * q);
        f32x4 S[2][8];
#pragma unroll
        for (int j = 0; j < 2; ++j)
#pragma unroll
            for (int kt = 0; kt < 8; ++kt) S[j][kt] = (f32x4){0.f, 0.f, 0.f, 0.f};
        for (int n = 0; n <= NCH; ++n) {
            LSYNC();
            if (n == NCH) { LSYNC(); break; }
            f32x4 oacc[2][4];
            bf16x8 fr[2][4], bb[2][2];
#define HG_LD(buf, g) do { if ((g) < 4) { _Pragma("unroll") for (int i_ = 0; i_ < 4; ++i_) buf[i_] = ldfragP(A1 + i_ * 16 * 136 + (g) * 32, 136, lane); } \
                else { const int tc_ = ((g) - 4) >> 1, hf_ = ((g) - 4) & 1; _Pragma("unroll") for (int i_ = 0; i_ < 4; ++i_) buf[i_] = ldfrag(A2 + (hf_ * 4 + i_) * 16 * 72 + tc_ * 32, 72, lane); \
                    if (hf_ == 0) { bb[tc_][0] = ldfrag(B2 + (32 * w) * 72 + tc_ * 32, 72, lane); bb[tc_][1] = ldfrag(B2 + (32 * w + 16) * 72 + tc_ * 32, 72, lane); } } } while (0)
#define HG_MM(buf, g) do { if ((g) < 4) { const bf16x8 s0_ = accpair(S[0][2 * (g)], S[0][2 * (g) + 1]), s1_ = accpair(S[1][2 * (g)], S[1][2 * (g) + 1]); \
                    _Pragma("unroll") for (int i_ = 0; i_ < 4; ++i_) { oacc[0][i_] = MFMA16(s0_, buf[i_], oacc[0][i_]); oacc[1][i_] = MFMA16(s1_, buf[i_], oacc[1][i_]); } } \
                else { const int tc_ = ((g) - 4) >> 1, hf_ = ((g) - 4) & 1; _Pragma("unroll") for (int i_ = 0; i_ < 4; ++i_) { S[0][hf_ * 4 + i_] = MFMA16(buf[i_], bb[tc_][0], S[0][hf_ * 4 + i_]); S[1][hf_ * 4 + i_] = MFMA16(buf[i_], bb[tc_][1], S[1][hf_ * 4 + i_]); } } } while (0)
#define HG_STEP(g) do { if ((g) + 1 < 8) HG_LD(fr[((g) + 1) & 1], (g) + 1); __builtin_amdgcn_sched_barrier(0); HG_MM(fr[(g) & 1], g); __builtin_amdgcn_sched_barrier(0); } while (0)
            HG_LD(fr[0], 0);
#pragma unroll
            for (int j = 0; j < 2; ++j)
#pragma unroll
                for (int tt = 0; tt < 4; ++tt) oacc[j][tt] = ld4bf(Is + (tt * 16 + c) * 136 + 32 * w + 16 * j + 4 * q);
            HG_STEP(0); HG_STEP(1); HG_STEP(2);
            { f32x4 d4[8];
#pragma unroll
              for (int kt = 0; kt < 8; ++kt) d4[kt] = *(const LAS f32x4*)(dl + kt * 16 + 4 * q);
              HG_STEP(3);
#pragma unroll
              for (int kt = 0; kt < 8; ++kt) { S[0][kt] = S[0][kt] * d4[kt]; S[1][kt] = S[1][kt] * d4[kt]; } }
            HG_STEP(4); HG_STEP(5); HG_STEP(6); HG_STEP(7);
#undef HG_LD
#undef HG_MM
#undef HG_STEP
            f32x4 g4[2][4];
#pragma unroll
            for (int j = 0; j < 2; ++j)
#pragma unroll
                for (int tt = 0; tt < 4; ++tt) g4[j][tt] = ld4bf(Gs + (tt * 16 + c) * 136 + 32 * w + 16 * j + 4 * q);
#pragma unroll
            for (int tt = 0; tt < 4; ++tt) { const f32x4 o0 = oacc[0][tt], o1 = oacc[1][tt];
                const float p = qsum(((o0[0] * o0[0] + o0[1] * o0[1]) + (o0[2] * o0[2] + o0[3] * o0[3])) + ((o1[0] * o1[0] + o1[1] * o1[1]) + (o1[2] * o1[2] + o1[3] * o1[3])));
                if (q == 0) PS[(tt * 16 + c) * 4 + w] = p; }
            LSYNC();
#pragma unroll
            for (int tt = 0; tt < 4; ++tt) { const f32x4 pa4 = *(const LAS f32x4*)(PS + (tt * 16 + c) * 4);
                const float rstd = frsq(((pa4.x + pa4.y) + (pa4.z + pa4.w)) * (1.f / 128.f) + EPS);
#pragma unroll
                for (int j = 0; j < 2; ++j) { const f32x4 o = oacc[j][tt] * onw4[j] * rstd; const f32x4 g = g4[j][tt];
                    *(LAS v2u*)(OGs + (tt * 16 + c) * 136 + 32 * w + 16 * j + 4 * q) = (v2u){pk2(o[0] * silu(g[0]), o[1] * silu(g[1])), pk2(o[2] * silu(g[2]), o[3] * silu(g[3]))}; } }
        }
    }
    LSYNC();
}

template <int NOLOAD>
DI void gd_chain(Frame& F, int b, int h, unsigned char* OGo, unsigned* prog) {
    LAS bf16* W = (LAS bf16*)F.lds; LAS bf16* QG = W + 64 * 136; LAS bf16* QK = QG + 64 * 136; LAS bf16* KD = QK + 64 * 72; LAS bf16* UT = KD + 128 * 72; LAS bf16* Gs = UT + 128 * 72; LAS bf16* OGs = Gs + 64 * 136;
    LAS float* PS = (LAS float*)(OGs + 64 * 136);
    const bf16* PR = (const bf16*)(F.ws + WS_R2); const bf16* R1 = (const bf16*)(F.ws + WS_R1); const float* GEND = (const float*)(F.ws + WS_GEND);
    const int tid = F.tid, lane0 = F.lane, w = F.wave;
    if (w >= 4) {
        int lt_ = tid - 256; asm volatile("" : "+v"(lt_));
        const int lt = lt_, r1 = lt >> 2, s1 = lt & 3, k2 = lt >> 1, s2 = lt & 1;
        const unsigned oQk = (unsigned)(r1 * D + 512 + h * 128 + s1 * 16), oW = (unsigned)(r1 * 128 + s1 * 32), oK = (unsigned)(k2 * 64 + s2 * 32);
        const __amdgpu_buffer_rsrc_t rsW = MKRSRC(F.ws + WS_GW), rsQ = MKRSRC(F.ws + WS_GQG), rsK = MKRSRC(F.ws + WS_GKD), rsU = MKRSRC(F.ws + WS_GU), rsI = MKRSRC(R1), rsP = MKRSRC(PR);
        v4u pw[4], pq[4], pk[2], pd[4], pu[4], pg[4]; float pge = 0.f;
#define GD_LOAD(n_) do { const int bn_ = b * 64 + (n_); const unsigned so_ = (unsigned)((bn_ * 4 + h) * 16384), sg_ = (unsigned)(prb(bn_, 28 + h) * 2); \
            _Pragma("unroll") for (int i_ = 0; i_ < 4; ++i_) { pw[i_] = BLD128(rsW, 2u * oW + 16u * i_, so_); pq[i_] = BLD128(rsQ, 2u * oW + 16u * i_, so_); pd[i_] = BLD128(rsK, 2u * oK + 16u * i_, so_); \
                pu[i_] = BLD128(rsU, 2u * oK + 16u * i_, so_); pg[i_] = BLD128(rsP, 2u * oW + 16u * i_, sg_); } \
            pk[0] = BLD128(rsI, 2u * oQk, (unsigned)(bn_ * 64 * D * 2)); pk[1] = BLD128(rsI, 2u * oQk + 16u, (unsigned)(bn_ * 64 * D * 2)); pge = GEND[bn_ * 4 + h]; } while (0)
        GD_LOAD(0);
        for (int n = 0; n <= NCH; ++n) {
            if (n < NCH) {
#pragma unroll
                for (int i = 0; i < 4; ++i) { *(LAS v4u*)(W + r1 * 136 + s1 * 32 + 8 * i) = pw[i]; *(LAS v4u*)(QG + r1 * 136 + s1 * 32 + 8 * i) = pq[i]; *(LAS v4u*)(KD + k2 * 72 + s2 * 32 + 8 * i) = pd[i];
                    *(LAS v4u*)(UT + k2 * 72 + s2 * 32 + 8 * i) = pu[i]; *(LAS v4u*)(Gs + r1 * 136 + s1 * 32 + 8 * i) = pg[i]; }
                *(LAS v4u*)(QK + r1 * 72 + s1 * 16) = pk[0]; *(LAS v4u*)(QK + r1 * 72 + s1 * 16 + 8) = pk[1]; if (lt == 0) PS[1024] = pge;
            }
            LSYNC();
            if (lt == 0) __hip_atomic_store(prog, (unsigned)(n + 1), __ATOMIC_RELAXED, __HIP_MEMORY_SCOPE_AGENT);
            if (NOLOAD == 0 && n + 1 < NCH) GD_LOAD(n + 1);
            if (NOLOAD == 2 && n + 1 < NCH) GD_LOAD(n & 1);
            if (n > 0) {
                unsigned char* orow = OGo + (size_t)((b * 64 + n - 1) * 64 + r1) * OG_PITCH;
                if ((4 + h) < OG_NF) {
                    unsigned char* og = orow + (4 + h) * 128 + s1 * 32;
                    unsigned o8[8];
#pragma unroll
                    for (int i = 0; i < 4; ++i) { const v4u t = *(const LAS v4u*)(OGs + r1 * 136 + s1 * 32 + 8 * i);
                        o8[2 * i] = pk4_fp8(bflo(t.x), bfhi(t.x), bflo(t.y), bfhi(t.y)); o8[2 * i + 1] = pk4_fp8(bflo(t.z), bfhi(t.z), bflo(t.w), bfhi(t.w)); }
                    *(v4u*)og = (v4u){o8[0], o8[1], o8[2], o8[3]}; *(v4u*)(og + 16) = (v4u){o8[4], o8[5], o8[6], o8[7]};
                } else {
                    unsigned char* og = orow + OG_NF * 128 + ((4 + h) - OG_NF) * 256 + s1 * 64;
#pragma unroll
                    for (int i = 0; i < 4; ++i) *(v4u*)(og + 16 * i) = *(const LAS v4u*)(OGs + r1 * 136 + s1 * 32 + 8 * i);
                }
            }
            LSYNC();
        }
#undef GD_LOAD
    } else {
        int ln_ = lane0; asm volatile("" : "+v"(ln_)); const int lane = ln_, c = lane & 15, q = lane >> 4;
        f32x4 onw4[2];
#pragma unroll
        for (int j = 0; j < 2; ++j) onw4[j] = *(const f32x4*)(F.gd_onorm_w + 32 * w + 16 * j + 4 * q);
        f32x4 S[2][8];
#pragma unroll
        for (int j = 0; j < 2; ++j)
#pragma unroll
            for (int kt = 0; kt < 8; ++kt) S[j][kt] = (f32x4){0.f, 0.f, 0.f, 0.f};
        for (int n = 0; n <= NCH; ++n) {
            LSYNC();
            if (n == NCH) { LSYNC(); break; }
            const float gend = PS[1024];
            f32x4 vacc[2][4], oacc[2][4];
            bf16x8 fr[2][4], p0, p1;
#define GD_LD(buf, g) do { if ((g) < 8) { const LAS bf16* bs_ = (((g) & 1) ? QG : W) + ((g) >> 1) * 32; _Pragma("unroll") for (int i_ = 0; i_ < 4; ++i_) buf[i_] = ldfragP(bs_ + i_ * 16 * 136, 136, lane); } \
                else { const int sc_ = ((g) - 8) / 3, sub_ = ((g) - 8) % 3; const LAS bf16* bs_ = (sub_ == 0 ? QK : KD + (sub_ - 1) * 4 * 16 * 72) + sc_ * 32; \
                    _Pragma("unroll") for (int i_ = 0; i_ < 4; ++i_) buf[i_] = ldfragP(bs_ + i_ * 16 * 72, 72, lane); } } while (0)
#define GD_MM(buf, g) do { if ((g) < 8) { if (((g) & 1) == 0) { p0 = accpair(S[0][(g)], S[0][(g) + 1]); p1 = accpair(S[1][(g)], S[1][(g) + 1]); \
                        _Pragma("unroll") for (int i_ = 0; i_ < 4; ++i_) { vacc[0][i_] = MFMA16(buf[i_], p0, vacc[0][i_]); vacc[1][i_] = MFMA16(buf[i_], p1, vacc[1][i_]); } } \
                    else { _Pragma("unroll") for (int i_ = 0; i_ < 4; ++i_) { oacc[0][i_] = MFMA16(p0, buf[i_], oacc[0][i_]); oacc[1][i_] = MFMA16(p1, buf[i_], oacc[1][i_]); } } } \
                else { const int sc_ = ((g) - 8) / 3, sub_ = ((g) - 8) % 3; \
                    if (sub_ == 0) { p0 = accpair_neg(vacc[0][2 * sc_], vacc[0][2 * sc_ + 1]); p1 = accpair_neg(vacc[1][2 * sc_], vacc[1][2 * sc_ + 1]); \
                        _Pragma("unroll") for (int i_ = 0; i_ < 4; ++i_) { oacc[0][i_] = MFMA16(p0, buf[i_], oacc[0][i_]); oacc[1][i_] = MFMA16(p1, buf[i_], oacc[1][i_]); } } \
                    else { _Pragma("unroll") for (int i_ = 0; i_ < 4; ++i_) { S[0][(sub_ - 1) * 4 + i_] = MFMA16(buf[i_], p0, S[0][(sub_ - 1) * 4 + i_]); S[1][(sub_ - 1) * 4 + i_] = MFMA16(buf[i_], p1, S[1][(sub_ - 1) * 4 + i_]); } } } } while (0)
#define GD_STEP(g) do { if ((g) + 1 < 14) GD_LD(fr[((g) + 1) & 1], (g) + 1); __builtin_amdgcn_sched_barrier(0); GD_MM(fr[(g) & 1], g); __builtin_amdgcn_sched_barrier(0); } while (0)
            GD_LD(fr[0], 0);
#pragma unroll
            for (int j = 0; j < 2; ++j)
#pragma unroll
                for (int tt = 0; tt < 4; ++tt) { vacc[j][tt] = -ld4bf(UT + (32 * w + 16 * j + c) * 72 + tt * 16 + 4 * q); oacc[j][tt] = (f32x4){0.f, 0.f, 0.f, 0.f}; }
            GD_STEP(0); GD_STEP(1); GD_STEP(2); GD_STEP(3); GD_STEP(4); GD_STEP(5); GD_STEP(6); GD_STEP(7);
#pragma unroll
            for (int j = 0; j < 2; ++j)
#pragma unroll
                for (int kt = 0; kt < 8; ++kt) S[j][kt] = S[j][kt] * gend;
            GD_STEP(8); GD_STEP(9); GD_STEP(10); GD_STEP(11); GD_STEP(12); GD_STEP(13);
#undef GD_LD
#undef GD_MM
#undef GD_STEP
            f32x4 g4[2][4];
#pragma unroll
            for (int j = 0; j < 2; ++j)
#pragma unroll
                for (int tt = 0; tt < 4; ++tt) g4[j][tt] = ld4bf(Gs + (tt * 16 + c) * 136 + 32 * w + 16 * j + 4 * q);
#pragma unroll
            for (int tt = 0; tt < 4; ++tt) { const f32x4 o0 = oacc[0][tt], o1 = oacc[1][tt];
                const float p = qsum(((o0[0] * o0[0] + o0[1] * o0[1]) + (o0[2] * o0[2] + o0[3] * o0[3])) + ((o1[0] * o1[0] + o1[1] * o1[1]) + (o1[2] * o1[2] + o1[3] * o1[3])));
                if (q == 0) PS[(tt * 16 + c) * 4 + w] = p; }
            LSYNC();
#pragma unroll
            for (int tt = 0; tt < 4; ++tt) { const f32x4 pa4 = *(const LAS f32x4*)(PS + (tt * 16 + c) * 4);
                const float rstd = frsq(((pa4.x + pa4.y) + (pa4.z + pa4.w)) * (1.f / 128.f) + EPS);
#pragma unroll
                for (int j = 0; j < 2; ++j) { const f32x4 o = oacc[j][tt] * onw4[j] * rstd; const f32x4 g = g4[j][tt];
                    *(LAS v2u*)(OGs + (tt * 16 + c) * 136 + 32 * w + 16 * j + 4 * q) = (v2u){pk2(o[0] * silu(g[0]), o[1] * silu(g[1])), pk2(o[2] * silu(g[2]), o[3] * silu(g[3]))}; } }
        }
    }
    LSYNC();
}

DI void convert_experts(Frame& F) {
    LAS float* scr = (LAS float*)(F.lds + F.wave * 16384);
    unsigned char* WGU = F.ws + WS_WGU; unsigned char* WD = F.ws + WS_WD;
    for (;;) {
        int base = 0;
        if (F.lane == 0) base = (int)__hip_atomic_fetch_add(F.ctl + CW_WORK, 4u, __ATOMIC_RELAXED, __HIP_MEMORY_SCOPE_AGENT);
        base = __builtin_amdgcn_readfirstlane(base);
        if (base >= NE * 384) break;
        for (int it = base; it < base + 4; ++it) { const int e = it / 384, r = it % 384;
            if (r < 256) { const int up = r >> 7, sub = r & 127, nb = sub & 7, n0 = 32 * nb; const int row_off = 256 * (n0 >> 7) + (n0 & 127) - n0 + 128 * up;
                transpose_item8((up ? F.w_up : F.w_gate) + (size_t)e * 1024 * 256, 1024, 256, 8, WGU + (size_t)e * 512 * 1024, row_off, 32.f, F.norm_moe_w, scr, sub, F.lane); }
            else transpose_item8(F.w_down + (size_t)e * 256 * 1024, 256, 1024, 32, WD + (size_t)e * 1024 * 256, 0, 16.f, nullptr, scr, r - 256, F.lane);
        }
    }
}

DI void warm_and_convert(Frame& F, int cid) {
    LAS float* scr = (LAS float*)(F.lds + F.wave * 16384);
    unsigned char* WGU = F.ws + WS_WGU; unsigned char* WD = F.ws + WS_WD;
    const bool gd = cid >= 64; const int bh = gd ? cid - 64 : cid, b = bh >> 2, h = bh & 3;
    unsigned* prog = F.ctl + CW_PROG + 64 * cid;
    int n = 0; bool convleft = true; unsigned spins = 0;
    while (n < NCH || convleft) {
        const int pr = __builtin_amdgcn_readfirstlane((int)__hip_atomic_load(prog, __ATOMIC_RELAXED, __HIP_MEMORY_SCOPE_AGENT));
        if (n < NCH && n <= pr + 1) {
            const int bn = b * 64 + n, item = bn * 4 + h;
#pragma unroll
            for (int pass = 0; pass < 2; ++pass) { const int L = pass * 512 + F.wave * 64 + F.lane; size_t addr = 0; bool ok = true;
                if (gd) { if (L < 512) addr = WS_R3 + (size_t)(L >> 7) * 64 * MiB + (size_t)item * 16384 + (L & 127) * 128;
                          else if (L < 640) addr = WS_R2 + prb(bn, 28 + h) * 2 + (size_t)(L - 512) * 128;
                          else if (L < 704) addr = WS_R1 + ((size_t)(bn * 64 + (L - 640)) * D + 512 + h * 128) * 2;
                          else ok = false; }
                else    { if (L < 512) addr = WS_R2 + prb(bn, h + 4 * (L >> 7)) * 2 + (size_t)(L & 127) * 128;
                          else if (L < 640) addr = WS_R1 + ((size_t)(bn * 64 + ((L - 512) >> 1)) * D + h * 128) * 2 + ((L - 512) & 1) * 128;
                          else if (L < 644) addr = WS_DLAST + (size_t)item * 512 + (size_t)(L - 640) * 128;
                          else ok = false; }
                if (ok) { const unsigned v = *(const unsigned*)(F.ws + addr); asm volatile("" :: "v"(v)); } }
            ++n; spins = 0; continue;
        }
        if (convleft) {
            int base = 0;
            if (F.lane == 0) base = (int)__hip_atomic_fetch_add(F.ctl + CW_WORK, 4u, __ATOMIC_RELAXED, __HIP_MEMORY_SCOPE_AGENT);
            base = __builtin_amdgcn_readfirstlane(base);
            if (base >= NE * 384) { convleft = false; continue; }
            for (int it = base; it < base + 4; ++it) { const int e = it / 384, r = it % 384;
                if (r < 256) { const int up = r >> 7, sub = r & 127, nb = sub & 7, n0 = 32 * nb; const int row_off = 256 * (n0 >> 7) + (n0 & 127) - n0 + 128 * up;
                    transpose_item8((up ? F.w_up : F.w_gate) + (size_t)e * 1024 * 256, 1024, 256, 8, WGU + (size_t)e * 512 * 1024, row_off, 32.f, F.norm_moe_w, scr, sub, F.lane); }
                else transpose_item8(F.w_down + (size_t)e * 256 * 1024, 256, 1024, 32, WD + (size_t)e * 1024 * 256, 0, 16.f, nullptr, scr, r - 256, F.lane); }
            continue;
        }
        __builtin_amdgcn_s_sleep(8); if (++spins > (1u << 16)) n = NCH;
    }
}

struct MoeOrder {
    static constexpr bool GATHER = true;
    const LAS int* tab; const LAS int* cnt; const int* rowtok; int ntiles, nN, G, c; size_t bstride;
    DI bool next(int i, pg8::Unit& u) const {
        const long L = (long)i * G + c; if (L >= (long)ntiles * nN) return false;
        const int tile = (int)(L / nN); const int v = tab[tile];
        u.pm = tile; u.pn = (int)(L % nN); u.e = v & 255; u.j = v >> 8; return true;
    }
    DI const char* a_tile(const pg8::Gemm& g, const pg8::Unit&) const { return (const char*)g.A; }
    DI const char* b_tile(const pg8::Gemm& g, const pg8::Unit& u) const { return (const char*)g.Bt + (size_t)u.e * bstride + (size_t)u.pn * (size_t)pg8::BM * g.K * 2; }
    DI int row_of(const pg8::Unit& u, int r) const { int slot = u.j * 256 + r; const int m = cnt[u.e] - 1; slot = slot < m ? slot : m; return rowtok[u.e * 65536 + slot] >> 1; }
};
struct MoeOrder2 : MoeOrder {
    static constexpr bool GATHER = false;
    DI const char* a_tile(const pg8::Gemm& g, const pg8::Unit& u) const { return (const char*)g.A + (size_t)u.pm * (size_t)pg8::BM * g.K * 2; }
};
DI int moe_build_table(Frame& F) {
    LAS int* tab = (LAS int*)(F.lds + TILETAB_OFF); LAS int* cnt = (LAS int*)(F.lds + CNT_OFF); volatile LAS int* misc = (volatile LAS int*)(F.lds + MISC_OFF);
    if (F.tid < 64) cnt[F.tid] = (int)__hip_atomic_load(F.ctl + CW_CNT + F.tid, __ATOMIC_RELAXED, __HIP_MEMORY_SCOPE_AGENT);
    __syncthreads();
    if (F.tid == 0) { int nt = 0; for (int e = 0; e < NE; ++e) { const int k = (cnt[e] + 255) >> 8; for (int j = 0; j < k; ++j) tab[nt++] = e | (j << 8); } misc[16] = nt; }
    __syncthreads();
    return misc[16];
}

struct OneUnit : pg8::StaticOrder {
    int pm1;
    DI bool next(int i, pg8::Unit& u) const { if (i > 0) return false; u.pm = pm1; u.pn = 0; u.e = 0; u.j = 0; return true; }
};
DI void route_panel(Frame& F, int t0) {
    LAS int* hist = (LAS int*)F.lds; LAS int* base = hist + 64;
    const float* LOG = (const float*)(F.ws + WS_LOGITS); int* ROWTOK = (int*)(F.ws + WS_ROWTOK); float* ROWGATE = (float*)(F.ws + WS_ROWGATE);
    {
        const bool act = F.tid < 256;
        if (F.tid < 64) hist[F.tid] = 0;
        __syncthreads();
        const int tok = t0 + (F.tid & 255); const float* L = LOG + (size_t)tok * 256;
        const f32x4 ga = *(const f32x4*)L, gb = *(const f32x4*)(L + 4);
        float rr; { const f32x4* sp = (const f32x4*)((const float*)(F.ws + WS_SSQ) + (size_t)tok * 16); const f32x4 a = sp[0], b = sp[1], c = sp[2], d = sp[3];
            rr = frsq(((a.x + a.y + a.z + a.w) + (b.x + b.y + b.z + b.w) + (c.x + c.y + c.z + c.w) + (d.x + d.y + d.z + d.w)) * (1.f / D) + EPS); }
        const float g[8] = {ga.x * rr, ga.y * rr, ga.z * rr, ga.w * rr, gb.x * rr, gb.y * rr, gb.z * rr, gb.w * rr};
        int gi = 0; float gm = g[0];
#pragma unroll
        for (int j = 1; j < 8; ++j) if (g[j] > gm) { gm = g[j]; gi = j; }
        float den = 0.f;
#pragma unroll
        for (int j = 0; j < 8; ++j) den += expf(g[j] - gm);
        const float pg = 1.f / den;
        const f32x4 ea = *(const f32x4*)(L + 8 + gi * 8), eb = *(const f32x4*)(L + 12 + gi * 8);
        const float e[8] = {ea.x * rr, ea.y * rr, ea.z * rr, ea.w * rr, eb.x * rr, eb.y * rr, eb.z * rr, eb.w * rr};
        int i1 = 0; float v1 = e[0];
#pragma unroll
        for (int j = 1; j < 8; ++j) if (e[j] > v1) { v1 = e[j]; i1 = j; }
        int i2 = -1; float v2 = -3.0e38f;
#pragma unroll
        for (int j = 0; j < 8; ++j) if (j != i1 && e[j] > v2) { v2 = e[j]; i2 = j; }
        const float ex = expf(v2 - v1), p1 = 1.f / (1.f + ex), p2 = ex / (1.f + ex);
        const int e1 = gi * 8 + i1, e2 = gi * 8 + i2;
        int l1 = 0, l2 = 0;
        if (act) { l1 = __hip_atomic_fetch_add(&hist[e1], 1, __ATOMIC_RELAXED, __HIP_MEMORY_SCOPE_WORKGROUP); l2 = __hip_atomic_fetch_add(&hist[e2], 1, __ATOMIC_RELAXED, __HIP_MEMORY_SCOPE_WORKGROUP); }
        __syncthreads();
        if (F.tid < 64) base[F.tid] = (int)__hip_atomic_fetch_add(F.ctl + CW_CNT + F.tid, (unsigned)hist[F.tid], __ATOMIC_RELAXED, __HIP_MEMORY_SCOPE_AGENT);
        __syncthreads();
        const int s1 = base[e1] + l1, s2 = base[e2] + l2;
        float* ROWSCALE = (float*)(F.ws + WS_ROWSCALE);
        if (act) { ROWTOK[e1 * 65536 + s1] = tok * 2; ROWGATE[e1 * 65536 + s1] = p1 * pg; ROWSCALE[e1 * 65536 + s1] = rr;
            ROWTOK[e2 * 65536 + s2] = tok * 2 + 1; ROWGATE[e2 * 65536 + s2] = p2 * pg; ROWSCALE[e2 * 65536 + s2] = rr; }
        __syncthreads();
    }
}

constexpr int NPHASE = 11;
struct Args { const float* in[17]; float* out; unsigned char* ws; int ph_lo, ph_hi; };
__global__ void __launch_bounds__(NTHR, 2) fwd_kernel(Args args) {
    extern __shared__ __attribute__((aligned(16))) unsigned char lds_raw[];
    Frame F;
    F.lds = (LAS unsigned char*)lds_raw;
    F.tid = threadIdx.x; F.lane = F.tid & 63; F.wave = __builtin_amdgcn_readfirstlane(F.tid >> 6);
    F.G = gridDim.x; { const int bx = blockIdx.x; F.vcu = (F.G % 8 == 0) ? (bx % 8) * (F.G / 8) + bx / 8 : bx; }
    F.ws = args.ws; F.ctl = (unsigned*)(args.ws + WS_CTL); F.out = args.out;
    F.x = args.in[0]; F.norm_mix_w = args.in[1]; F.w_in = args.in[2]; F.lb_logits = args.in[3]; F.hg_onorm_w = args.in[4]; F.conv_w = args.in[5]; F.a_log = args.in[6];
    F.dt_bias = args.in[7]; F.gd_onorm_w = args.in[8]; F.w_out = args.in[9]; F.norm_moe_w = args.in[10]; F.wr_group = args.in[11]; F.wr_expert = args.in[12];
    F.w_gate = args.in[13]; F.w_up = args.in[14]; F.w_down = args.in[15]; F.final_w = args.in[16];
    volatile LAS unsigned* MISC = (volatile LAS unsigned*)(F.lds + MISC_OFF);
    if (F.tid < 64) MISC[F.tid] = 0u;
    __syncthreads();
    const int lo = args.ph_lo, hi = args.ph_hi;
    const bool one = (hi - lo) > 1;
    XcdBarrier bar; bar.bar = F.ctl + CW_BAR; bar.x = 0; bar.st = nullptr;
    if (one) bar = xcd_barrier_post(F.ctl + CW_BAR, MISC + 8);
#ifdef ONLY_PHASE
#define IN(k) ((k) == ONLY_PHASE && lo <= (k) && (k) < hi)
#else
#define IN(k) (lo <= (k) && (k) < hi)
#endif
#define SEAM(k) do { if (IN(k) && IN((k) + 1)) xcd_barrier(bar); } while (0)
    const int gw = F.vcu * NWAVES + F.wave, NGW = F.G * NWAVES;

    if (IN(0)) { for (int rep = 0; rep < REPS(0); ++rep) p0_prologue(F); }
    SEAM(0);
    if (IN(1)) {
        pg8::Gemm g{(const bf16*)F.out, (const bf16*)(F.ws + WS_WIN), T, NP, D}; pg8::StaticOrder S; S.init(T, NP, F.G, (int)blockIdx.x);
        pg8::EpiProjBlocked E{(bf16*)(F.ws + WS_R2)};
        for (int rep = 0; rep < REPS(1); ++rep) pg8::gemm_phase(F.lds, g, S, E);
    }
    SEAM(1);
    if (IN(2)) {
        if (((blockIdx.x >> 3) & 1) == 0) {
            { v4u raw[11]; f32x4 cw[4][2]; float pab[2] = {0.f, 0.f};
                if (F.wave < 6 && F.vcu < 4096) gd_raw_load(F, F.vcu, raw, cw);
                if (F.wave == 6 && F.vcu < 4096) { const int tok = (F.vcu >> 2) * 64 + F.lane; pab[0] = ((const float*)(F.ws + WS_AB))[(size_t)tok * 8 + (F.vcu & 3)]; pab[1] = ((const float*)(F.ws + WS_AB))[(size_t)tok * 8 + 4 + (F.vcu & 3)]; }
                for (int it = F.vcu; it < 4096; it += F.G) gd_pre_item(F, it, raw, cw, pab, it + F.G < 4096 ? it + F.G : -1); }
            __syncthreads();
            { unsigned nq[16], nf[16], ni[16]; float nlb = 0.f;
                if (F.vcu < 4096) hg_raw_load(F, F.vcu, nq, nf, ni, nlb);
                for (int it = F.vcu; it < 4096; it += F.G) hg_pre_item(F, it, (bf16*)(F.ws + WS_R2), NP, (bf16*)(F.ws + WS_R1), (float*)(F.ws + WS_DLAST), nq, nf, ni, nlb, it + F.G < 4096 ? it + F.G : -1); }
        } else {
            { unsigned nq[16], nf[16], ni[16]; float nlb = 0.f;
                if (F.vcu < 4096) hg_raw_load(F, F.vcu, nq, nf, ni, nlb);
                for (int it = F.vcu; it < 4096; it += F.G) hg_pre_item(F, it, (bf16*)(F.ws + WS_R2), NP, (bf16*)(F.ws + WS_R1), (float*)(F.ws + WS_DLAST), nq, nf, ni, nlb, it + F.G < 4096 ? it + F.G : -1); }
            __syncthreads();
            { v4u raw[11]; f32x4 cw[4][2]; float pab[2] = {0.f, 0.f};
                if (F.wave < 6 && F.vcu < 4096) gd_raw_load(F, F.vcu, raw, cw);
                if (F.wave == 6 && F.vcu < 4096) { const int tok = (F.vcu >> 2) * 64 + F.lane; pab[0] = ((const float*)(F.ws + WS_AB))[(size_t)tok * 8 + (F.vcu & 3)]; pab[1] = ((const float*)(F.ws + WS_AB))[(size_t)tok * 8 + 4 + (F.vcu & 3)]; }
                for (int it = F.vcu; it < 4096; it += F.G) gd_pre_item(F, it, raw, cw, pab, it + F.G < 4096 ? it + F.G : -1); }
        }
    }
    SEAM(2);
    if (IN(3)) {
        const int bx = blockIdx.x;
        unsigned char* OG8 = (unsigned char*)F.out + 128 * MiB;
        if (F.G == 256) {
            const int idx = (bx >> 4) * 8 + (bx & 7);
            if (((bx >> 3) & 1) == 0) {
                if (PROBE_PH == 22) { if (idx < 64) hg_chain<0>(F, idx >> 2, idx & 3, (unsigned char*)F.out + 192 * MiB, F.ctl + CW_PROG + 64 * 200); else gd_chain<0>(F, (idx - 64) >> 2, idx & 3, (unsigned char*)F.out + 192 * MiB, F.ctl + CW_PROG + 64 * 200); }
                if (PROBE_PH == 25) { if (idx < 64) hg_chain<0>(F, idx >> 2, idx & 3, (unsigned char*)F.out + 192 * MiB, F.ctl + CW_PROG + 64 * 200); }
                if (PROBE_PH == 26) { if (idx >= 64) gd_chain<0>(F, (idx - 64) >> 2, idx & 3, (unsigned char*)F.out + 192 * MiB, F.ctl + CW_PROG + 64 * 200); }
                if (PROBE_PH == 24) { if (idx < 64) hg_chain<2>(F, idx >> 2, idx & 3, (unsigned char*)F.out + 192 * MiB, F.ctl + CW_PROG + 64 * 200); else gd_chain<2>(F, (idx - 64) >> 2, idx & 3, (unsigned char*)F.out + 192 * MiB, F.ctl + CW_PROG + 64 * 200); }
                if (PROBE_PH == 23) { if (idx < 64) hg_chain<1>(F, idx >> 2, idx & 3, (unsigned char*)F.out + 192 * MiB, F.ctl + CW_PROG + 64 * 200); else gd_chain<1>(F, (idx - 64) >> 2, idx & 3, (unsigned char*)F.out + 192 * MiB, F.ctl + CW_PROG + 64 * 200); }
                if (idx < 64) hg_chain<0>(F, idx >> 2, idx & 3, OG8, F.ctl + CW_PROG + 64 * idx); else gd_chain<0>(F, (idx - 64) >> 2, idx & 3, OG8, F.ctl + CW_PROG + 64 * idx); }
            else warm_and_convert(F, idx);
        } else {
            for (int cid = bx; cid < 128; cid += F.G) { if (cid < 64) hg_chain<0>(F, cid >> 2, cid & 3, OG8, F.ctl + CW_PROG + 64 * cid); else gd_chain<0>(F, (cid - 64) >> 2, cid & 3, OG8, F.ctl + CW_PROG + 64 * cid); }
        }
        convert_experts(F);
    }
    SEAM(3);
    if (IN(4)) {
        pg8::Gemm g{(const bf16*)((const unsigned char*)F.out + 128 * MiB), (const bf16*)(F.ws + WS_WOUT), T, D, OG_PITCH / 2}; pg8::StaticOrder S; S.init(T, D, F.G, (int)blockIdx.x);
        pg8::EpiRes3<OG_NF> E{(bf16*)(F.ws + WS_HB), F.ws + WS_XN8, (float*)(F.ws + WS_SSQ), (const bf16*)F.out, (const float*)(F.ws + WS_RXI), F.norm_mix_w};
        for (int rep = 0; rep < REPS(4); ++rep) pg8::gemm_phase(F.lds, g, S, E);
    }
    SEAM(4);
    if (IN(5)) {
        const bf16* HB = (const bf16*)(F.ws + WS_HB);
        for (int panel = F.vcu; panel < T / 256; panel += F.G) {
            { pg8::Gemm g{HB, (const bf16*)(F.ws + WS_WR), T, 256, D}; OneUnit S; S.init(T, 256, F.G, 0); S.pm1 = panel;
              pg8::EpiF32 E{(float*)(F.ws + WS_LOGITS), 256, nullptr};
              for (int rep = 0; rep < REPS(6); ++rep) pg8::gemm_phase(F.lds, g, S, E); }
            VM_WAIT(); __syncthreads();
            route_panel(F, panel * 256);
        }
    }
    SEAM(7);
    if (IN(8)) {
        const int nt = moe_build_table(F);
        MoeOrder S; S.tab = (const LAS int*)(F.lds + TILETAB_OFF); S.cnt = (const LAS int*)(F.lds + CNT_OFF); S.rowtok = (const int*)(F.ws + WS_ROWTOK);
        S.ntiles = nt; S.nN = 2; S.G = F.G; S.c = F.vcu; S.bstride = (size_t)512 * 1024;
        pg8::Gemm g{(const bf16*)(F.ws + WS_XN8), (const bf16*)(F.ws + WS_WGU), T, 512, D / 2};
        pg8::EpiSwiGLU8 E{F.ws + WS_H, (const float*)(F.ws + WS_ROWSCALE)};
        for (int rep = 0; rep < REPS(8); ++rep) pg8::gemm_phase(F.lds, g, S, E);
    }
    SEAM(8);
    if (IN(9)) {
        const int nt = moe_build_table(F);
        MoeOrder2 S; S.tab = (const LAS int*)(F.lds + TILETAB_OFF); S.cnt = (const LAS int*)(F.lds + CNT_OFF); S.rowtok = (const int*)(F.ws + WS_ROWTOK);
        S.ntiles = nt; S.nN = 4; S.G = F.G; S.c = F.vcu; S.bstride = (size_t)1024 * 256;
        pg8::Gemm g{(const bf16*)(F.ws + WS_H), (const bf16*)(F.ws + WS_WD), MAXTILES * 256, 1024, 128};
        pg8::EpiScatter8 E{F.ws + WS_Y2, (const int*)(F.ws + WS_ROWTOK), (const float*)(F.ws + WS_ROWGATE), (const LAS int*)(F.lds + CNT_OFF)};
        for (int rep = 0; rep < REPS(9); ++rep) pg8::gemm_phase(F.lds, g, S, E);
    }
    SEAM(9);
    if (IN(10)) {
        float wn[16];
#pragma unroll
        for (int j = 0; j < 4; ++j) { const f32x4 t = *(const f32x4*)(F.final_w + 4 * F.lane + 256 * j); wn[4 * j] = t.x; wn[4 * j + 1] = t.y; wn[4 * j + 2] = t.z; wn[4 * j + 3] = t.w; }
        const unsigned char* Y2 = F.ws + WS_Y2;
        v2u nh[4]; unsigned na[4], nb[4];
#define P7_LOAD(m_) do { const v2u* hr_ = (const v2u*)((const bf16*)(F.ws + WS_HB) + (size_t)(m_) * D) + F.lane; const unsigned* y0_ = (const unsigned*)(Y2 + (size_t)(2 * (m_)) * D) + F.lane; const unsigned* y1_ = (const unsigned*)(Y2 + (size_t)(2 * (m_) + 1) * D) + F.lane; \
            _Pragma("unroll") for (int j_ = 0; j_ < 4; ++j_) { nh[j_] = hr_[64 * j_]; na[j_] = y0_[64 * j_]; nb[j_] = y1_[64 * j_]; } } while (0)
        if (gw < T) P7_LOAD(gw);
        for (int m = gw; m < T; m += NGW) {
            f32x4* xr = (f32x4*)(F.out + (size_t)m * D) + F.lane;
            v2u ch[4]; unsigned ca[4], cb[4];
#pragma unroll
            for (int j = 0; j < 4; ++j) { ch[j] = nh[j]; ca[j] = na[j]; cb[j] = nb[j]; }
            if (m + NGW < T) P7_LOAD(m + NGW);
            float v[16]; float s = 0.f;
#pragma unroll
            for (int j = 0; j < 4; ++j) { const v2u t = ch[j];
                const auto a0 = __builtin_amdgcn_cvt_pk_f32_fp8((int)ca[j], false), a1 = __builtin_amdgcn_cvt_pk_f32_fp8((int)ca[j], true), b0 = __builtin_amdgcn_cvt_pk_f32_fp8((int)cb[j], false), b1 = __builtin_amdgcn_cvt_pk_f32_fp8((int)cb[j], true);
                v[4 * j] = bflo(t.x) + (a0[0] + b0[0]) * 0.03125f; v[4 * j + 1] = bfhi(t.x) + (a0[1] + b0[1]) * 0.03125f; v[4 * j + 2] = bflo(t.y) + (a1[0] + b1[0]) * 0.03125f; v[4 * j + 3] = bfhi(t.y) + (a1[1] + b1[1]) * 0.03125f; }
#pragma unroll
            for (int i = 0; i < 16; ++i) s += v[i] * v[i];
            const float r = frsq(wave_sum(s) * (1.f / D) + EPS);
#pragma unroll
            for (int j = 0; j < 4; ++j) xr[64 * j] = (f32x4){v[4 * j] * r * wn[4 * j], v[4 * j + 1] * r * wn[4 * j + 1], v[4 * j + 2] * r * wn[4 * j + 2], v[4 * j + 3] * r * wn[4 * j + 3]};
        }
    }
#undef IN
#undef SEAM
}

extern "C" void kernel_launch(void* const* d_in, const int* in_sizes, int n_in, void* d_out, int out_size, void* d_ws, size_t ws_size, hipStream_t stream) {
    static int grid = 0;
    if (grid == 0) {
        if (n_in != 17 || in_sizes[0] != T * D || out_size != T * D || ws_size < WS_END) {
            fprintf(stderr, "kernel_launch: unexpected shapes: n_in %d in0 %d out %d ws %zu (need %zu)\n", n_in, n_in > 0 ? in_sizes[0] : -1, out_size, ws_size, (size_t)WS_END); grid = -1; return; }
        int dev = 0, cus = 0, per_cu = 0;
        if (hipGetDevice(&dev) != hipSuccess || hipDeviceGetAttribute(&cus, hipDeviceAttributeMultiprocessorCount, dev) != hipSuccess) { grid = -1; return; }
        if (hipFuncSetAttribute((const void*)fwd_kernel, hipFuncAttributeMaxDynamicSharedMemorySize, LDS_BYTES) != hipSuccess) { fprintf(stderr, "kernel_launch: hipFuncSetAttribute failed\n"); grid = -1; return; }
        if (hipOccupancyMaxActiveBlocksPerMultiprocessor(&per_cu, (const void*)fwd_kernel, NTHR, LDS_BYTES) != hipSuccess || per_cu < 1) { fprintf(stderr, "kernel_launch: occupancy query says %d\n", per_cu); }
        (void)hipGetLastError();
        grid = cus;
    }
    if (grid < 0) return;
    if (hipMemsetAsync((char*)d_ws + WS_CTL, 0, CTL_ZERO_BYTES, stream) != hipSuccess) return;
    Args a{};
    for (int i = 0; i < 17; ++i) a.in[i] = (const float*)d_in[i];
    a.out = (float*)d_out; a.ws = (unsigned char*)d_ws;
#if MK_PER_PHASE
    for (int ph = 0; ph < NPHASE; ++ph) { a.ph_lo = ph; a.ph_hi = ph + 1; hipLaunchKernelGGL(fwd_kernel, dim3(grid), dim3(NTHR), LDS_BYTES, stream, a); }
#else
    a.ph_lo = 0; a.ph_hi = NPHASE; hipLaunchKernelGGL(fwd_kernel, dim3(grid), dim3(NTHR), LDS_BYTES, stream, a);
#endif
}
```

```cpp
#include <hip/hip_runtime.h>
#include <cstdio>
#include <cstdint>

#ifndef MK_PER_PHASE
#define MK_PER_PHASE 0
#endif

#ifndef PROBE_PH
#define PROBE_PH -1
#endif
#define REPS(k) ((PROBE_PH == (k)) ? 2 : 1)
#define DI __device__ __forceinline__
#define GAS __attribute__((address_space(1)))
#define LAS __attribute__((address_space(3)))
typedef unsigned short bf16;
typedef unsigned v4u __attribute__((ext_vector_type(4)));
typedef unsigned v2u __attribute__((ext_vector_type(2)));
typedef float f32x4 __attribute__((ext_vector_type(4)));
typedef float f32x2 __attribute__((ext_vector_type(2)));
typedef short bf16x8 __attribute__((ext_vector_type(8)));

constexpr int T = 65536, D = 1024, SEQ = 4096, NB = 16, NCH = 64  , CH = 64;
constexpr int NP = 4096;
constexpr int INC = 4104;
constexpr int NE = 64, FF = 256, MAXTILES = 576;
constexpr int OG_NF = 6;
constexpr int OG_PITCH = OG_NF * 128 + (8 - OG_NF) * 256;
constexpr float EPS = 1e-6f;
constexpr int NWAVES = 8, NTHR = 512;

constexpr size_t MiB = 1u << 20;
constexpr size_t WS_CTL = 0, CTL_ZERO_BYTES = 1 * MiB;
constexpr size_t WS_WIN = 2 * MiB;
constexpr size_t WS_WOUT = 10 * MiB;
constexpr size_t WS_WR = 12 * MiB;
constexpr size_t WS_AB = 13 * MiB;
constexpr size_t WS_DLAST = 15 * MiB;
constexpr size_t WS_GEND = 17 * MiB;
constexpr size_t WS_LB = 18 * MiB;
constexpr size_t WS_R1 = 20 * MiB;
constexpr size_t WS_R2 = 148 * MiB;
constexpr size_t WS_LOGITS = WS_R2;
constexpr size_t WS_H = WS_R2 + 64 * MiB;
constexpr size_t WS_Y2 = WS_R2 + 140 * MiB;
constexpr size_t WS_RXI = 948 * MiB;
constexpr size_t WS_SSQ = WS_R2 + 270 * MiB;
constexpr size_t WS_XN8 = WS_R2 + 396 * MiB;
constexpr size_t WS_R3 = 660 * MiB;
constexpr size_t WS_GW = WS_R3, WS_GU = WS_R3 + 64 * MiB, WS_GQG = WS_R3 + 128 * MiB, WS_GKD = WS_R3 + 192 * MiB;
constexpr size_t WS_ROWTOK = WS_R3;
constexpr size_t WS_ROWGATE = WS_R3 + 16 * MiB;
constexpr size_t WS_ROWSCALE = WS_R3 + 32 * MiB;
constexpr size_t WS_HB = WS_R3 + 64 * MiB;
constexpr size_t WS_WGU = 916 * MiB;
constexpr size_t WS_WD = 980 * MiB;
constexpr size_t WS_END = 1012 * MiB;
constexpr int CW_BAR = 4096;
constexpr int CW_CNT = 16384;
constexpr int CW_PROG = 49152;
constexpr int CW_WORK = 16512;

constexpr int LDS_BYTES = 147456;
constexpr int MISC_OFF = 131072;
constexpr int TILETAB_OFF = MISC_OFF + 256;
constexpr int CNT_OFF = TILETAB_OFF + MAXTILES * 4;

typedef __bf16 hbf2 __attribute__((ext_vector_type(2)));
DI unsigned pk2(float lo, float hi) { return __builtin_bit_cast(unsigned, __builtin_convertvector((f32x2){lo, hi}, hbf2)); }
DI unsigned f2bf(float f) { return pk2(f, 0.f) & 0xffffu; }
DI float bf2f(unsigned b) { return __builtin_bit_cast(float, b << 16); }
DI float bflo(unsigned w) { return __builtin_bit_cast(float, w << 16); }
DI float bfhi(unsigned w) { return __builtin_bit_cast(float, w & 0xffff0000u); }
DI unsigned pk4_fp8(float a, float b, float c, float d) { int p = 0; p = __builtin_amdgcn_cvt_pk_fp8_f32(a, b, p, false); p = __builtin_amdgcn_cvt_pk_fp8_f32(c, d, p, true); return (unsigned)p; }
DI float frcp(float x) { return __builtin_amdgcn_rcpf(x); }
DI float frsq(float x) { return __builtin_amdgcn_rsqf(x); }
DI float sigm(float x) { return frcp(1.f + __expf(-x)); }
DI float silu(float x) { return x * frcp(1.f + __expf(-x)); }
DI float wave_sum(float v) {
#pragma unroll
    for (int o = 1; o < 64; o <<= 1) v += __shfl_xor(v, o);
    return v;
}
#define LDS_WAIT() asm volatile("s_waitcnt lgkmcnt(0)" ::: "memory")
#define VM_WAIT() asm volatile("s_waitcnt vmcnt(0)" ::: "memory")
#define LSYNC() do { asm volatile("s_waitcnt lgkmcnt(0)" ::: "memory"); __builtin_amdgcn_s_barrier(); asm volatile("" ::: "memory"); } while (0)

namespace pg8 {
#define PG8_LAS __attribute__((address_space(3)))
typedef unsigned short bf16_t;
typedef unsigned u32x4 __attribute__((ext_vector_type(4)));
typedef int v8i __attribute__((ext_vector_type(8)));
typedef int v4i __attribute__((ext_vector_type(4)));
constexpr int BM = 256, BK = 64, HALF = 128, HTB = HALF * BK * 2, STAGE_BYTES = 8 * HTB, NXCD = 8, WGM = 8;

__host__ __device__ __forceinline__ int lds_byte(int r, int c) { const int st = (r >> 4) * 2 + (c >> 5), rr = r & 15, cc = c & 31, ob = rr * 64 + cc * 2; return st * 1024 + (ob ^ (((ob >> 9) & 1) << 5)); }
__host__ __device__ __forceinline__ void stage_rc(int b, int& R, int& C) { const int st = b / 1024, sb = b % 1024, swz = sb ^ (((sb >> 9) & 1) << 5); R = (st >> 1) * 16 + swz / 64; C = (st & 1) * 32 + (swz % 64) / 2; }
__host__ __device__ __forceinline__ int perm32(int rho) { const int n = rho >> 4, i = rho & 15; return 8 * (i >> 2) + 4 * n + (i & 3); }

struct Unit { int pm, pn, e, j; };
struct Gemm { const bf16_t* A; const bf16_t* Bt; int M, N, K; };

struct StaticOrder {
    static constexpr bool GATHER = false;
    int nM, nN, nwg, G, c;
    __host__ __device__ void init(int M, int N, int G_, int c_) { nM = M / BM; nN = N / BM; nwg = nM * nN; G = G_; c = c_; }
    __device__ __forceinline__ bool next(int i, Unit& u) const {
        const long L = (long)i * G + c; if (L >= nwg) return false;
        int wgid = (int)L; { const int q = nwg / NXCD, r = nwg % NXCD, xcd = wgid % NXCD, off = wgid / NXCD; wgid = (xcd < r ? xcd * (q + 1) : r * (q + 1) + (xcd - r) * q) + off; }
        const int nig = WGM * nN, gid = wgid / nig, fm = gid * WGM, gsz = (nM - fm) < WGM ? (nM - fm) : WGM;
        u.pm = fm + ((wgid % nig) % gsz); u.pn = (wgid % nig) / gsz; u.e = 0; u.j = 0; return true;
    }
    __device__ __forceinline__ const char* a_tile(const Gemm& g, const Unit& u) const { return (const char*)g.A + (size_t)u.pm * (size_t)BM * g.K * 2; }
    __device__ __forceinline__ const char* b_tile(const Gemm& g, const Unit& u) const { return (const char*)g.Bt + (size_t)u.pn * (size_t)BM * g.K * 2; }
    __device__ __forceinline__ int row_of(const Unit&, int) const { return 0; }
};

__device__ __forceinline__ unsigned cvt_pk_bf16(float lo, float hi) { unsigned r; asm volatile("v_cvt_pk_bf16_f32 %0, %1, %2" : "=v"(r) : "v"(lo), "v"(hi)); return r; }

struct EpiBf16 {
    static constexpr bool PERM = true, FP8 = false;
    static constexpr int NF8T = -1;
    static constexpr int NVM = 16;
    __device__ __forceinline__ void pre(PG8_LAS unsigned char*, const Unit&, int, int, int) const {}
    bf16_t* O; int ldc;
    __device__ __forceinline__ void operator()(const f32x4 (&acc)[2][2][4][2], const Unit& u, int wr, int wc, int fr, int fq, PG8_LAS unsigned char* lds, int ui) const {
        const int row0 = u.pm * BM + wr * 64 + fr, col0 = u.pn * BM + wc * 32 + 8 * fq;
#pragma unroll
        for (int ai = 0; ai < 2; ++ai)
#pragma unroll
            for (int m = 0; m < 4; ++m) { bf16_t* rowp = O + (size_t)(row0 + ai * HALF + m * 16) * ldc + col0;
#pragma unroll
                for (int bj = 0; bj < 2; ++bj) { const f32x4 v0 = acc[ai][bj][m][0], v1 = acc[ai][bj][m][1];
                    u32x4 w; w.x = cvt_pk_bf16(v0[0], v0[1]); w.y = cvt_pk_bf16(v0[2], v0[3]); w.z = cvt_pk_bf16(v1[0], v1[1]); w.w = cvt_pk_bf16(v1[2], v1[3]);
                    *(u32x4*)(rowp + bj * HALF) = w; } }
    }
};
struct EpiProjBlocked {
    static constexpr bool PERM = true, FP8 = false;
    static constexpr int NF8T = -1;
    static constexpr int NVM = 16;
    __device__ __forceinline__ void pre(PG8_LAS unsigned char*, const Unit&, int, int, int) const {}
    bf16_t* O;
    __device__ __forceinline__ void operator()(const f32x4 (&acc)[2][2][4][2], const Unit& u, int wr, int wc, int fr, int fq, PG8_LAS unsigned char* lds, int ui) const {
#pragma unroll
        for (int ai = 0; ai < 2; ++ai)
#pragma unroll
            for (int m = 0; m < 4; ++m) { const int chunk = u.pm * 4 + ai * 2 + wr;
#pragma unroll
                for (int bj = 0; bj < 2; ++bj) { const f32x4 v0 = acc[ai][bj][m][0], v1 = acc[ai][bj][m][1];
                    u32x4 w; w.x = cvt_pk_bf16(v0[0], v0[1]); w.y = cvt_pk_bf16(v0[2], v0[3]); w.z = cvt_pk_bf16(v1[0], v1[1]); w.w = cvt_pk_bf16(v1[2], v1[3]);
                    *(u32x4*)(O + (((size_t)chunk * 32 + u.pn * 2 + bj) * 64 + m * 16 + fr) * 128 + wc * 32 + 8 * fq) = w; } }
    }
};
struct EpiF32 {
    static constexpr bool PERM = false, FP8 = false;
    static constexpr int NF8T = -1;
    static constexpr int NVM = 32;
    __device__ __forceinline__ void pre(PG8_LAS unsigned char*, const Unit&, int, int, int) const {}
    float* C; int ldc; const float* R;
    __device__ __forceinline__ void operator()(const f32x4 (&acc)[2][2][4][2], const Unit& u, int wr, int wc, int fr, int fq, PG8_LAS unsigned char* lds, int ui) const {
        const int row0 = u.pm * BM + wr * 64 + fr, col0 = u.pn * BM + wc * 32 + 4 * fq;
#pragma unroll
        for (int ai = 0; ai < 2; ++ai)
#pragma unroll
            for (int m = 0; m < 4; ++m) { const size_t ro = (size_t)(row0 + ai * HALF + m * 16) * ldc + col0;
#pragma unroll
                for (int bj = 0; bj < 2; ++bj)
#pragma unroll
                    for (int n = 0; n < 2; ++n) { f32x4 v = acc[ai][bj][m][n]; if (R) v = v + *(const f32x4*)(R + ro + bj * HALF + n * 16); *(f32x4*)(C + ro + bj * HALF + n * 16) = v; } }
    }
};
struct EpiResBf16 {
    static constexpr bool PERM = true, FP8 = false;
    static constexpr int NF8T = -1;
    static constexpr int NVM = 16;
    __device__ __forceinline__ void pre(PG8_LAS unsigned char*, const Unit&, int, int, int) const {}
    bf16_t* O; int ldc; const float* R;
    __device__ __forceinline__ void operator()(const f32x4 (&acc)[2][2][4][2], const Unit& u, int wr, int wc, int fr, int fq, PG8_LAS unsigned char* lds, int ui) const {
        const int row0 = u.pm * BM + wr * 64 + fr, col0 = u.pn * BM + wc * 32 + 8 * fq;
#pragma unroll
        for (int ai = 0; ai < 2; ++ai)
#pragma unroll
            for (int m = 0; m < 4; ++m) { const size_t ro = (size_t)(row0 + ai * HALF + m * 16) * ldc + col0;
#pragma unroll
                for (int bj = 0; bj < 2; ++bj) { const f32x4 v0 = acc[ai][bj][m][0] + *(const f32x4*)(R + ro + bj * HALF), v1 = acc[ai][bj][m][1] + *(const f32x4*)(R + ro + bj * HALF + 4);
                    u32x4 w; w.x = cvt_pk_bf16(v0[0], v0[1]); w.y = cvt_pk_bf16(v0[2], v0[3]); w.z = cvt_pk_bf16(v1[0], v1[1]); w.w = cvt_pk_bf16(v1[2], v1[3]);
                    *(u32x4*)(O + ro + bj * HALF) = w; } }
    }
};
template <int NF8T_>
struct EpiRes3 {
    static constexpr bool PERM = true, FP8 = false; static constexpr int NF8T = NF8T_;
    static constexpr int NVM = 32;
    __device__ __forceinline__ void pre(PG8_LAS unsigned char*, const Unit&, int, int, int) const {}
    bf16_t* O; unsigned char* O8; float* SSQ; const bf16_t* HN; const float* RXI; const float* W;
    __device__ __forceinline__ void operator()(const f32x4 (&acc)[2][2][4][2], const Unit& u, int wr, int wc, int fr, int fq, PG8_LAS unsigned char* lds, int ui) const {
        const int row0 = u.pm * BM + wr * 64 + fr, col0 = u.pn * BM + wc * 32 + 8 * fq;
        constexpr float as = 0.03125f;
        float wi[2][8];
#pragma unroll
        for (int bj = 0; bj < 2; ++bj) { const f32x4 a = *(const f32x4*)(W + col0 + bj * HALF), b = *(const f32x4*)(W + col0 + bj * HALF + 4);
            wi[bj][0] = __builtin_amdgcn_rcpf(a.x); wi[bj][1] = __builtin_amdgcn_rcpf(a.y); wi[bj][2] = __builtin_amdgcn_rcpf(a.z); wi[bj][3] = __builtin_amdgcn_rcpf(a.w);
            wi[bj][4] = __builtin_amdgcn_rcpf(b.x); wi[bj][5] = __builtin_amdgcn_rcpf(b.y); wi[bj][6] = __builtin_amdgcn_rcpf(b.z); wi[bj][7] = __builtin_amdgcn_rcpf(b.w); }
#pragma unroll
        for (int ai = 0; ai < 2; ++ai) {
            u32x4 rv[4][2]; float rx[4];
#pragma unroll
            for (int m = 0; m < 4; ++m) { const int row = row0 + ai * HALF + m * 16; rx[m] = RXI[row];
#pragma unroll
                for (int bj = 0; bj < 2; ++bj) rv[m][bj] = *(const u32x4*)(HN + (size_t)row * 1024 + col0 + bj * HALF); }
            __builtin_amdgcn_sched_barrier(0);
#pragma unroll
            for (int m = 0; m < 4; ++m) { const int row = row0 + ai * HALF + m * 16; const size_t ro = (size_t)row * 1024 + col0; float ss = 0.f;
#pragma unroll
                for (int bj = 0; bj < 2; ++bj) { const u32x4 q = rv[m][bj]; f32x4 v0, v1;
                    v0[0] = acc[ai][bj][m][0][0] * as + __uint_as_float(q.x << 16) * rx[m] * wi[bj][0]; v0[1] = acc[ai][bj][m][0][1] * as + __uint_as_float(q.x & 0xffff0000u) * rx[m] * wi[bj][1];
                    v0[2] = acc[ai][bj][m][0][2] * as + __uint_as_float(q.y << 16) * rx[m] * wi[bj][2]; v0[3] = acc[ai][bj][m][0][3] * as + __uint_as_float(q.y & 0xffff0000u) * rx[m] * wi[bj][3];
                    v1[0] = acc[ai][bj][m][1][0] * as + __uint_as_float(q.z << 16) * rx[m] * wi[bj][4]; v1[1] = acc[ai][bj][m][1][1] * as + __uint_as_float(q.z & 0xffff0000u) * rx[m] * wi[bj][5];
                    v1[2] = acc[ai][bj][m][1][2] * as + __uint_as_float(q.w << 16) * rx[m] * wi[bj][6]; v1[3] = acc[ai][bj][m][1][3] * as + __uint_as_float(q.w & 0xffff0000u) * rx[m] * wi[bj][7];
                    u32x4 w; w.x = cvt_pk_bf16(v0[0], v0[1]); w.y = cvt_pk_bf16(v0[2], v0[3]); w.z = cvt_pk_bf16(v1[0], v1[1]); w.w = cvt_pk_bf16(v1[2], v1[3]);
                    *(u32x4*)(O + ro + bj * HALF) = w;
                    int w0 = 0, w1 = 0; w0 = __builtin_amdgcn_cvt_pk_fp8_f32(v0[0], v0[1], w0, false); w0 = __builtin_amdgcn_cvt_pk_fp8_f32(v0[2], v0[3], w0, true); w1 = __builtin_amdgcn_cvt_pk_fp8_f32(v1[0], v1[1], w1, false); w1 = __builtin_amdgcn_cvt_pk_fp8_f32(v1[2], v1[3], w1, true);
                    *(unsigned long long*)(O8 + ro + bj * HALF) = (unsigned long long)(unsigned)w0 | ((unsigned long long)(unsigned)w1 << 32);
                    ss += v0[0] * v0[0] + v0[1] * v0[1] + v0[2] * v0[2] + v0[3] * v0[3] + v1[0] * v1[0] + v1[1] * v1[1] + v1[2] * v1[2] + v1[3] * v1[3]; }
                ss += __shfl_xor(ss, 16); ss += __shfl_xor(ss, 32);
                if (fq == 0) SSQ[(size_t)row * 16 + u.pn * 4 + wc] = ss; }
            __builtin_amdgcn_sched_barrier(0);
        }
    }
};
struct EpiSwiGLU {
    static constexpr bool PERM = true, FP8 = false;
    static constexpr int NF8T = -1;
    static constexpr int NVM = 0;
    __device__ __forceinline__ void pre(PG8_LAS unsigned char*, const Unit&, int, int, int) const {}
    bf16_t* H;
    __device__ __forceinline__ void operator()(const f32x4 (&acc)[2][2][4][2], const Unit& u, int wr, int wc, int fr, int fq, PG8_LAS unsigned char* lds, int ui) const {
        const int row0 = u.pm * BM + wr * 64 + fr, col0 = u.pn * HALF + wc * 32 + 8 * fq;
#pragma unroll
        for (int ai = 0; ai < 2; ++ai)
#pragma unroll
            for (int m = 0; m < 4; ++m) { bf16_t* rowp = H + (size_t)(row0 + ai * HALF + m * 16) * 256 + col0;
                float h[8];
#pragma unroll
                for (int n = 0; n < 2; ++n)
#pragma unroll
                    for (int j = 0; j < 4; ++j) { const float g = acc[ai][0][m][n][j], up = acc[ai][1][m][n][j]; h[n * 4 + j] = g * __builtin_amdgcn_rcpf(1.f + __expf(-g)) * up; }
                u32x4 w; w.x = cvt_pk_bf16(h[0], h[1]); w.y = cvt_pk_bf16(h[2], h[3]); w.z = cvt_pk_bf16(h[4], h[5]); w.w = cvt_pk_bf16(h[6], h[7]);
                *(u32x4*)rowp = w; }
    }
};
struct EpiScatter {
    static constexpr bool PERM = true, FP8 = false;
    static constexpr int NF8T = -1;
    static constexpr int NVM = 0;
    __device__ __forceinline__ void pre(PG8_LAS unsigned char*, const Unit&, int, int, int) const {}
    bf16_t* Y; const int* rowtok; const float* rowgate; const PG8_LAS int* cnt;
    __device__ __forceinline__ void operator()(const f32x4 (&acc)[2][2][4][2], const Unit& u, int wr, int wc, int fr, int fq, PG8_LAS unsigned char* lds, int ui) const {
        const int col0 = u.pn * BM + wc * 32 + 8 * fq, n_e = cnt[u.e];
        int tk[8]; float gt[8];
#pragma unroll
        for (int i = 0; i < 8; ++i) { int slot = u.j * BM + (i >> 2) * HALF + wr * 64 + (i & 3) * 16 + fr; const bool ok = slot < n_e; slot = ok ? slot : 0;
            tk[i] = rowtok[u.e * 65536 + slot]; gt[i] = rowgate[u.e * 65536 + slot]; tk[i] = ok ? tk[i] : -1; }
#pragma unroll
        for (int ai = 0; ai < 2; ++ai)
#pragma unroll
            for (int m = 0; m < 4; ++m) { const int i = ai * 4 + m;
                if (tk[i] >= 0) { bf16_t* rowp = Y + (size_t)tk[i] * 1024 + col0;
#pragma unroll
                    for (int bj = 0; bj < 2; ++bj) { const f32x4 v0 = acc[ai][bj][m][0] * gt[i], v1 = acc[ai][bj][m][1] * gt[i];
                        u32x4 w; w.x = cvt_pk_bf16(v0[0], v0[1]); w.y = cvt_pk_bf16(v0[2], v0[3]); w.z = cvt_pk_bf16(v1[0], v1[1]); w.w = cvt_pk_bf16(v1[2], v1[3]);
                        *(u32x4*)(rowp + bj * HALF) = w; } } }
    }
};

struct EpiSwiGLU8 {
    static constexpr bool PERM = true, FP8 = true;
    static constexpr int NF8T = -1;
    static constexpr int NVM = 8;
    static constexpr int LOOK_OFF = 131072 + 4096;
    unsigned char* H; const float* rowscale;
    __device__ __forceinline__ void pre(PG8_LAS unsigned char* lds, const Unit& u, int ui, int wid, int lane) const {
        if (wid < 4) __builtin_amdgcn_global_load_lds((const unsigned*)rowscale + u.e * 65536 + u.j * BM + 64 * wid + lane, (PG8_LAS unsigned*)(lds + LOOK_OFF + (ui & 1) * 1024 + wid * 256), 4, 0, 0);
    }
    __device__ __forceinline__ void operator()(const f32x4 (&acc)[2][2][4][2], const Unit& u, int wr, int wc, int fr, int fq, PG8_LAS unsigned char* lds, int ui) const {
        const int row0 = u.pm * BM + wr * 64 + fr, col0 = u.pn * HALF + wc * 32 + 8 * fq;
        const PG8_LAS float* ls = (const PG8_LAS float*)(lds + LOOK_OFF + (ui & 1) * 1024);
#pragma unroll
        for (int ai = 0; ai < 2; ++ai)
#pragma unroll
            for (int m = 0; m < 4; ++m) { unsigned char* rowp = H + (size_t)(row0 + ai * HALF + m * 16) * 256 + col0;
                const float sc = ls[ai * HALF + wr * 64 + m * 16 + fr] * 0.03125f;
                float h[8];
#pragma unroll
                for (int n = 0; n < 2; ++n)
#pragma unroll
                    for (int j = 0; j < 4; ++j) { const float g = acc[ai][0][m][n][j] * sc, up = acc[ai][1][m][n][j] * sc; h[n * 4 + j] = g * __builtin_amdgcn_rcpf(1.f + __expf(-g)) * up; }
                int w0 = 0, w1 = 0; w0 = __builtin_amdgcn_cvt_pk_fp8_f32(h[0], h[1], w0, false); w0 = __builtin_amdgcn_cvt_pk_fp8_f32(h[2], h[3], w0, true); w1 = __builtin_amdgcn_cvt_pk_fp8_f32(h[4], h[5], w1, false); w1 = __builtin_amdgcn_cvt_pk_fp8_f32(h[6], h[7], w1, true);
                *(unsigned long long*)rowp = (unsigned long long)(unsigned)w0 | ((unsigned long long)(unsigned)w1 << 32); }
    }
};
struct EpiScatter8 {
    static constexpr bool PERM = true, FP8 = true;
    static constexpr int NF8T = -1;
    static constexpr int NVM = 16;
    static constexpr int LOOK_OFF = 131072 + 4096;
    unsigned char* Y; const int* rowtok; const float* rowgate; const PG8_LAS int* cnt;
    __device__ __forceinline__ void pre(PG8_LAS unsigned char* lds, const Unit& u, int ui, int wid, int lane) const {
        const unsigned* src = (wid < 4 ? (const unsigned*)rowtok : (const unsigned*)rowgate) + u.e * 65536 + u.j * BM + 64 * (wid & 3) + lane;
        __builtin_amdgcn_global_load_lds(src, (PG8_LAS unsigned*)(lds + LOOK_OFF + (ui & 1) * 2048 + wid * 256), 4, 0, 0);
    }
    __device__ __forceinline__ void operator()(const f32x4 (&acc)[2][2][4][2], const Unit& u, int wr, int wc, int fr, int fq, PG8_LAS unsigned char* lds, int ui) const {
        const int col0 = u.pn * BM + wc * 32 + 8 * fq, n_e = cnt[u.e];
        const PG8_LAS int* ltok = (const PG8_LAS int*)(lds + LOOK_OFF + (ui & 1) * 2048); const PG8_LAS float* lgate = (const PG8_LAS float*)(lds + LOOK_OFF + (ui & 1) * 2048 + 1024);
        int tk[8]; float gt[8];
#pragma unroll
        for (int i = 0; i < 8; ++i) { const int r = (i >> 2) * HALF + wr * 64 + (i & 3) * 16 + fr; const bool ok = u.j * BM + r < n_e;
            tk[i] = ok ? ltok[r] : 2 * 65536; gt[i] = lgate[r] * 2.f; }
#pragma unroll
        for (int ai = 0; ai < 2; ++ai)
#pragma unroll
            for (int m = 0; m < 4; ++m) { const int i = ai * 4 + m;
                unsigned char* rowp = Y + (size_t)tk[i] * 1024 + col0;
#pragma unroll
                for (int bj = 0; bj < 2; ++bj) { const f32x4 v0 = acc[ai][bj][m][0] * gt[i], v1 = acc[ai][bj][m][1] * gt[i];
                    int w0 = 0, w1 = 0; w0 = __builtin_amdgcn_cvt_pk_fp8_f32(v0[0], v0[1], w0, false); w0 = __builtin_amdgcn_cvt_pk_fp8_f32(v0[2], v0[3], w0, true); w1 = __builtin_amdgcn_cvt_pk_fp8_f32(v1[0], v1[1], w1, false); w1 = __builtin_amdgcn_cvt_pk_fp8_f32(v1[2], v1[3], w1, true);
                    *(unsigned long long*)(rowp + bj * HALF) = (unsigned long long)(unsigned)w0 | ((unsigned long long)(unsigned)w1 << 32); } }
    }
};

template <class Epi, class Sched>
__device__ __forceinline__ void gemm_phase(PG8_LAS unsigned char* lds, const Gemm g, const Sched& S, const Epi& E) {
    constexpr bool GA = Sched::GATHER;
    const int tid = threadIdx.x, wid = __builtin_amdgcn_readfirstlane(tid >> 6), lane = tid & 63, wr = wid >> 2, wc = wid & 3, fr = lane & 15, fq = lane >> 4;
    int Kq = g.K; asm volatile("" : "+s"(Kq));
    const int K = Kq, nt = K / BK;
    unsigned voffA[2], voffB[2]; int RA[2], CA[2];
#pragma unroll
    for (int i = 0; i < 2; ++i) { int R, C; stage_rc(tid * 16 + i * 8192, R, C); const int Rb = Epi::PERM ? ((R & ~31) + perm32(R & 31)) : R;
        voffA[i] = (unsigned)(R * K + C) * 2u; voffB[i] = (unsigned)(Rb * K + C) * 2u; RA[i] = R; CA[i] = C; }
    const size_t kstep = (size_t)(BK * 2);
    const size_t hstep = (size_t)HALF * K * 2;
    const size_t hstepA = GA ? 0 : hstep;
    const unsigned ldsw = (unsigned)wid * 1024u;
    const int aoff = lds_byte(wr * 64 + fr, fq * 8), boff = lds_byte(wc * 32 + fr, fq * 8);
    constexpr bool MIXED = Epi::NF8T >= 0;
    constexpr bool F8 = Epi::FP8;
#define PG8_SA(b, h) (((b) * 2 + (h)) * HTB)
#define PG8_SB(b, h) ((4 + (b) * 2 + (h)) * HTB)
#define PG8_STAGE(bufoff, gbase, voff) do { _Pragma("unroll") for (int _i = 0; _i < 2; ++_i) \
        __builtin_amdgcn_global_load_lds((const unsigned*)((const char*)(gbase) + (voff)[_i]), (PG8_LAS unsigned*)(lds + (bufoff) + ldsw + _i * 8192), 16, 0, 0); } while (0)
#define PG8_LD2(p) __builtin_shufflevector(*(const PG8_LAS v4i*)(p), *(const PG8_LAS v4i*)((p) + 1024), 0, 1, 2, 3, 4, 5, 6, 7)
#define PG8_LDA(dst, b, h) do { _Pragma("unroll") for (int m = 0; m < 4; ++m) dst[m] = PG8_LD2(lds + PG8_SA(b, h) + aoff + m * 2048); } while (0)
#define PG8_LDB(dst, b, h) do { _Pragma("unroll") for (int n = 0; n < 2; ++n) dst[n] = PG8_LD2(lds + PG8_SB(b, h) + boff + n * 2048); } while (0)
#define PG8_LO(x) __builtin_shufflevector(x, x, 0, 1, 2, 3)
#define PG8_HI(x) __builtin_shufflevector(x, x, 4, 5, 6, 7)
#define PG8_MMA8(ai, bj, At, Bt) do { _Pragma("unroll") for (int m = 0; m < 4; ++m) _Pragma("unroll") for (int n = 0; n < 2; ++n) \
            asm volatile("v_mfma_f32_16x16x128_f8f6f4 %0, %1, %2, %0" : "+v"(acc[ai][bj][m][n]) : "v"(Bt[n]), "v"(At[m])); } while (0)
#define PG8_MMA16(ai, bj, At, Bt) do { _Pragma("unroll") for (int m = 0; m < 4; ++m) _Pragma("unroll") for (int n = 0; n < 2; ++n) { \
            asm volatile("v_mfma_f32_16x16x32_bf16 %0, %1, %2, %0" : "+v"(acc[ai][bj][m][n]) : "v"(PG8_LO(Bt[n])), "v"(PG8_LO(At[m]))); \
            asm volatile("v_mfma_f32_16x16x32_bf16 %0, %1, %2, %0" : "+v"(acc[ai][bj][m][n]) : "v"(PG8_HI(Bt[n])), "v"(PG8_HI(At[m]))); } } while (0)
#define PG8_MMA8P(ai, bj, At, Bt) do { __builtin_amdgcn_s_setprio(1); PG8_MMA8(ai, bj, At, Bt); __builtin_amdgcn_s_setprio(0); } while (0)
#define PG8_MMA16P(ai, bj, At, Bt) do { __builtin_amdgcn_s_setprio(1); PG8_MMA16(ai, bj, At, Bt); __builtin_amdgcn_s_setprio(0); } while (0)
#define PG8_MMA(ai, bj, At, Bt) do { __builtin_amdgcn_s_setprio(1); \
        if constexpr (F8) PG8_MMA8(ai, bj, At, Bt); else PG8_MMA16(ai, bj, At, Bt); \
        __builtin_amdgcn_s_setprio(0); } while (0)
#define PG8_WAIT_V(n) asm volatile("s_waitcnt vmcnt(" #n ")" ::: "memory")
#define PG8_WAIT_VN(n) asm volatile("s_waitcnt vmcnt(%0)" :: "n"(n) : "memory")
#define PG8_WAIT_L(n) asm volatile("s_waitcnt lgkmcnt(" #n ")" ::: "memory")
#define PG8_BAR __builtin_amdgcn_s_barrier()
#define PG8_SCHED __builtin_amdgcn_sched_barrier(0)
    Unit cur, nxt; int ui = 0;
    if (!S.next(0, cur)) return;
    f32x4 acc[2][2][4][2];
#pragma unroll
    for (int a = 0; a < 2; ++a)
#pragma unroll
        for (int b = 0; b < 2; ++b)
#pragma unroll
            for (int m = 0; m < 4; ++m)
#pragma unroll
                for (int n = 0; n < 2; ++n) { acc[a][b][m][n] = (f32x4){0.f, 0.f, 0.f, 0.f}; asm volatile("" : "+v"(acc[a][b][m][n])); }
    v8i At[4], B0[2], B1[2];
    const char* cA = S.a_tile(g, cur); const char* cB = S.b_tile(g, cur);
    unsigned cg0[2], cg1[2], ng0[2], ng1[2];
#pragma unroll
    for (int i = 0; i < 2; ++i) { cg0[i] = voffA[i]; cg1[i] = voffA[i]; ng0[i] = voffA[i]; ng1[i] = voffA[i]; }
    if constexpr (GA) {
#pragma unroll
        for (int i = 0; i < 2; ++i) { cg0[i] = (unsigned)(S.row_of(cur, RA[i]) * K + CA[i]) * 2u; cg1[i] = (unsigned)(S.row_of(cur, HALF + RA[i]) * K + CA[i]) * 2u; }
    }
    E.pre(lds, cur, 0, wid, lane);
    PG8_STAGE(PG8_SB(0, 0), cB, voffB); PG8_STAGE(PG8_SB(0, 1), cB + hstep, voffB); PG8_STAGE(PG8_SA(0, 0), cA, cg0); PG8_STAGE(PG8_SA(0, 1), cA + hstepA, cg1);
    if (wr == 1) PG8_BAR;
    PG8_WAIT_V(2); PG8_BAR;
    PG8_STAGE(PG8_SB(1, 0), cB + kstep, voffB); PG8_STAGE(PG8_SA(1, 0), cA + kstep, cg0); PG8_STAGE(PG8_SB(1, 1), cB + hstep + kstep, voffB);
    PG8_WAIT_V(6); PG8_BAR;
    for (;;) {
        const bool has_next = S.next(ui + 1, nxt);
        const char* nA = has_next ? S.a_tile(g, nxt) : cA; const char* nB = has_next ? S.b_tile(g, nxt) : cB;
        if constexpr (GA) {
            if (has_next) {
#pragma unroll
                for (int i = 0; i < 2; ++i) { ng0[i] = (unsigned)(S.row_of(nxt, RA[i]) * K + CA[i]) * 2u; ng1[i] = (unsigned)(S.row_of(nxt, HALF + RA[i]) * K + CA[i]) * 2u; }
            } else {
#pragma unroll
                for (int i = 0; i < 2; ++i) { ng0[i] = cg0[i]; ng1[i] = cg1[i]; }
            }
        }
#define PG8_BODY(MM) { \
            const bool last = (t == nt - 2); \
            const char* a1 = cA + (size_t)(t + 1) * kstep; \
            const char* a2 = last ? nA : cA + (size_t)(t + 2) * kstep; const char* b2 = last ? nB : cB + (size_t)(t + 2) * kstep; \
            const char* a3 = a2 + kstep; const char* b3 = b2 + kstep; \
            unsigned x0[2], x1[2]; \
            _Pragma("unroll") for (int i = 0; i < 2; ++i) { x0[i] = (GA && last) ? ng0[i] : cg0[i]; x1[i] = (GA && last) ? ng1[i] : cg1[i]; } \
              \
            const bool relaxed = Epi::NVM > 0 && t == 0 && ui > 0; \
              \
            PG8_LDB(B0, 0, 0); PG8_LDB(B1, 0, 1); PG8_SCHED; PG8_LDA(At, 0, 0); if (!(t == 0 && ui > 0)) PG8_STAGE(PG8_SA(1, 1), a1 + hstepA, cg1);     \
            PG8_WAIT_FIRST; PG8_WAIT_L(0); PG8_BAR; MM(0, 0, At, B0); MM(0, 1, At, B1); PG8_BAR; PG8_SCHED; \
              \
            PG8_LDA(At, 0, 1); PG8_STAGE(PG8_SB(0, 0), b2, voffB); PG8_STAGE(PG8_SB(0, 1), b2 + hstep, voffB); PG8_STAGE(PG8_SA(0, 0), a2, x0); \
            PG8_WAIT_FIRST; PG8_WAIT_L(0); PG8_BAR; MM(1, 0, At, B0); MM(1, 1, At, B1); PG8_BAR; PG8_SCHED; \
              \
            PG8_LDB(B0, 1, 0); PG8_LDB(B1, 1, 1); PG8_SCHED; PG8_LDA(At, 1, 0); PG8_STAGE(PG8_SA(0, 1), a2 + hstepA, x1); \
            PG8_WAIT_FIRST; PG8_WAIT_L(0); PG8_BAR; MM(0, 0, At, B0); MM(0, 1, At, B1); PG8_BAR; PG8_SCHED; \
              \
            PG8_LDA(At, 1, 1); PG8_STAGE(PG8_SB(1, 0), b3, voffB); PG8_STAGE(PG8_SB(1, 1), b3 + hstep, voffB); PG8_STAGE(PG8_SA(1, 0), a3, x0); \
            PG8_WAIT_V(8); PG8_WAIT_L(0); PG8_BAR; MM(1, 0, At, B0); MM(1, 1, At, B1); PG8_BAR; PG8_SCHED; }
#define PG8_WAIT_FIRST do { if (relaxed) PG8_WAIT_VN(8 + Epi::NVM); else PG8_WAIT_V(8); } while (0)
        if constexpr (MIXED) {
            int t = 0;
            for (; t < Epi::NF8T; t += 2) PG8_BODY(PG8_MMA8P)
            for (; t < nt; t += 2) PG8_BODY(PG8_MMA16P)
        } else {
            for (int t = 0; t < nt; t += 2) PG8_BODY(PG8_MMA)
        }
#undef PG8_WAIT_FIRST
#undef PG8_BODY
        if (has_next) PG8_STAGE(PG8_SA(1, 1), nA + kstep + hstepA, ng1);
        asm volatile("s_nop 15");
        if (wr == 0) PG8_BAR;
        E(acc, cur, wr, wc, fr, fq, lds, ui);
        if (!has_next) break;
#pragma unroll
        for (int a = 0; a < 2; ++a)
#pragma unroll
            for (int b = 0; b < 2; ++b)
#pragma unroll
                for (int m = 0; m < 4; ++m)
#pragma unroll
                    for (int n = 0; n < 2; ++n) { acc[a][b][m][n] = (f32x4){0.f, 0.f, 0.f, 0.f}; asm volatile("" : "+v"(acc[a][b][m][n])); }
        cur = nxt; cA = nA; cB = nB; ++ui;
        E.pre(lds, cur, ui, wid, lane);
        if constexpr (GA) {
#pragma unroll
            for (int i = 0; i < 2; ++i) { cg0[i] = ng0[i]; cg1[i] = ng1[i]; }
        }
        if (wr == 1) PG8_BAR;
    }
    PG8_WAIT_V(0);
    PG8_BAR;
#undef PG8_SA
#undef PG8_SB
#undef PG8_STAGE
#undef PG8_LDA
#undef PG8_LDB
#undef PG8_MMA
#undef PG8_MMA8
#undef PG8_MMA16
#undef PG8_MMA8P
#undef PG8_MMA16P
#undef PG8_LD2
#undef PG8_LO
#undef PG8_HI
#undef PG8_WAIT_V
#undef PG8_WAIT_VN
#undef PG8_WAIT_L
#undef PG8_BAR
#undef PG8_SCHED
}
}

#define XB_TMO      128
#define XB_XCNT(j)  (256  + 64 * (j))
#define XB_XSUB(j)  (1280 + 64 * (j))
#define XB_XGEN(j)  (2304 + 64 * (j))
#define XB_TOP      3328
#define XB_TOPGEN   3392
#define XCD_BAR_WORDS 3456
#define XB_SPIN_CAP (1u << 20)

__device__ __forceinline__ unsigned xb_ld(unsigned* p)              { return __hip_atomic_load(p, __ATOMIC_RELAXED, __HIP_MEMORY_SCOPE_AGENT); }
__device__ __forceinline__ unsigned xb_add(unsigned* p, unsigned v) { return __hip_atomic_fetch_add(p, v, __ATOMIC_RELAXED, __HIP_MEMORY_SCOPE_AGENT); }
__device__ __forceinline__ unsigned xb_xcc_id() { return (unsigned)__builtin_amdgcn_s_getreg((3 << 11) | 20) & 0xFu; }
#define XB_SPIN(cond, bar) do { unsigned _sp = 0; while (cond) { __builtin_amdgcn_s_sleep(1); \
    if ((++_sp & 255u) == 0u) { if (xb_ld(&(bar)[XB_TMO])) break; if (_sp > XB_SPIN_CAP) { atomicAdd(&(bar)[XB_TMO], 1u); break; } } } } while (0)

struct XcdBarrier { unsigned* bar; unsigned x; volatile LAS unsigned* st; };

__device__ __forceinline__ XcdBarrier xcd_barrier_post(unsigned* bar, volatile LAS unsigned* st) {
    XcdBarrier b; b.bar = bar; b.x = xb_xcc_id(); b.st = st;
    if (threadIdx.x == 0) (void)xb_add(&bar[XB_XCNT(b.x)], 1u);
    return b;
}
__device__ __forceinline__ void xcd_barrier_complete(unsigned* bar, unsigned x, unsigned& nloc, unsigned& nx) {
    const unsigned G = gridDim.x * gridDim.y * gridDim.z;
    unsigned sum, cnt, mine, sp = 0u;
    for (;;) {
        sum = 0u; cnt = 0u; mine = 0u;
#pragma unroll
        for (unsigned j = 0; j < 16; ++j) { const unsigned c = xb_ld(&bar[XB_XCNT(j)]); sum += c; cnt += (c > 0u) ? 1u : 0u; mine = (j == x) ? c : mine; }
        if (sum == G) break;
        __builtin_amdgcn_s_sleep(1);
        if ((++sp & 255u) == 0u) { if (xb_ld(&bar[XB_TMO])) break; if (sp > XB_SPIN_CAP) { atomicAdd(&bar[XB_TMO], 1u); break; } }
    }
    nloc = mine > 0u ? mine : 1u; nx = cnt > 0u ? cnt : 1u;
}
__device__ __forceinline__ void xcd_barrier(const XcdBarrier& b) {
    asm volatile("s_waitcnt vmcnt(0)" ::: "memory");
    __syncthreads();
    if (threadIdx.x == 0) {
        unsigned* bar = b.bar;
        __builtin_amdgcn_s_waitcnt(0);
        unsigned nloc = b.st[0], nx = b.st[1];
        if (nloc == 0u) { xcd_barrier_complete(bar, b.x, nloc, nx); b.st[0] = nloc; b.st[1] = nx; }
        const unsigned old = xb_add(&bar[XB_XSUB(b.x)], 1u);
        const unsigned gen = old / nloc;
        if (old + 1u == (gen + 1u) * nloc) {
            __builtin_amdgcn_fence(__ATOMIC_RELEASE, "agent");
            asm volatile("s_waitcnt vmcnt(0)" ::: "memory");
            const unsigned og = xb_add(&bar[XB_TOP], 1u);
            const unsigned tg = og / nx;
            if (og + 1u == (tg + 1u) * nx) xb_add(&bar[XB_TOPGEN], 1u);
            else XB_SPIN(xb_ld(&bar[XB_TOPGEN]) == tg, bar);
            __builtin_amdgcn_fence(__ATOMIC_ACQUIRE, "agent");
            xb_add(&bar[XB_XGEN(b.x)], 1u);
            asm volatile("s_waitcnt vmcnt(0)" ::: "memory");
        } else {
            XB_SPIN(xb_ld(&bar[XB_XGEN(b.x)]) == gen, bar);
            __builtin_amdgcn_fence(__ATOMIC_ACQUIRE, "agent");
            asm volatile("s_waitcnt vmcnt(0)" ::: "memory");
        }
    }
    __syncthreads();
}

struct Frame {
    LAS unsigned char* lds;
    unsigned* ctl;
    int tid, lane, wave, G, vcu;
    const float *x, *norm_mix_w, *w_in, *lb_logits, *hg_onorm_w, *conv_w, *a_log, *dt_bias, *gd_onorm_w, *w_out, *norm_moe_w, *wr_group, *wr_expert, *w_gate, *w_up, *w_down, *final_w;
    float* out;
    unsigned char* ws;
};

DI void transpose_item(const float* W, int K, int ldw, int nblk, bf16* WT, int row_off, LAS float* scr, int item, int lane) {
    const int kb = item / nblk, nb = item % nblk, k0 = 64 * kb, n0 = 32 * nb;
    f32x4 v[8];
#pragma unroll
    for (int i = 0; i < 8; ++i) v[i] = *(const f32x4*)(W + (size_t)(k0 + 8 * i + (lane >> 3)) * ldw + n0 + 4 * (lane & 7));
#pragma unroll
    for (int i = 0; i < 8; ++i) { LAS float* d = scr + (8 * i + (lane >> 3)) * 33 + 4 * (lane & 7); d[0] = v[i].x; d[1] = v[i].y; d[2] = v[i].z; d[3] = v[i].w; }
    LDS_WAIT(); asm volatile("" ::: "memory");
    const int c = lane & 7;
#pragma unroll
    for (int j = 0; j < 4; ++j) { const int n = (lane >> 3) + 8 * j; const LAS float* s = scr + (8 * c) * 33 + n;
        v4u o; o.x = pk2(s[0 * 33], s[1 * 33]); o.y = pk2(s[2 * 33], s[3 * 33]); o.z = pk2(s[4 * 33], s[5 * 33]); o.w = pk2(s[6 * 33], s[7 * 33]);
        *(v4u*)(WT + (size_t)(row_off + n0 + n) * K + k0 + 8 * c) = o; }
    LDS_WAIT(); asm volatile("" ::: "memory");
}

DI void transpose_item8(const float* W, int K, int ldw, int nblk, unsigned char* WT, int row_off, float scale, const float* kscale, LAS float* scr, int item, int lane) {
    const int kb = item / nblk, nb = item % nblk, k0 = 64 * kb, n0 = 32 * nb;
    f32x4 v[8];
#pragma unroll
    for (int i = 0; i < 8; ++i) v[i] = *(const f32x4*)(W + (size_t)(k0 + 8 * i + (lane >> 3)) * ldw + n0 + 4 * (lane & 7));
#pragma unroll
    for (int i = 0; i < 8; ++i) { LAS float* d = scr + (8 * i + (lane >> 3)) * 33 + 4 * (lane & 7); d[0] = v[i].x; d[1] = v[i].y; d[2] = v[i].z; d[3] = v[i].w; }
    LDS_WAIT(); asm volatile("" ::: "memory");
    const int c = lane & 7;
    float ks[8];
    if (kscale) { const f32x4 a = *(const f32x4*)(kscale + k0 + 8 * c), b = *(const f32x4*)(kscale + k0 + 8 * c + 4); ks[0] = a.x * scale; ks[1] = a.y * scale; ks[2] = a.z * scale; ks[3] = a.w * scale; ks[4] = b.x * scale; ks[5] = b.y * scale; ks[6] = b.z * scale; ks[7] = b.w * scale; }
    else {
#pragma unroll
        for (int i = 0; i < 8; ++i) ks[i] = scale; }
#pragma unroll
    for (int j = 0; j < 4; ++j) { const int n = (lane >> 3) + 8 * j; const LAS float* sp = scr + (8 * c) * 33 + n;
        const unsigned lo = pk4_fp8(sp[0 * 33] * ks[0], sp[1 * 33] * ks[1], sp[2 * 33] * ks[2], sp[3 * 33] * ks[3]), hi = pk4_fp8(sp[4 * 33] * ks[4], sp[5 * 33] * ks[5], sp[6 * 33] * ks[6], sp[7 * 33] * ks[7]);
        *(v2u*)(WT + (size_t)(row_off + n0 + n) * K + k0 + 8 * c) = (v2u){lo, hi}; }
    LDS_WAIT(); asm volatile("" ::: "memory");
}

DI void transpose_wout(const float* W, unsigned char* WT, LAS float* scr, int item, int lane) {
    const int kb = item / 32, nb = item % 32, k0 = 64 * kb, n0 = 32 * nb, hh = kb >> 1;
    f32x4 v[8];
#pragma unroll
    for (int i = 0; i < 8; ++i) v[i] = *(const f32x4*)(W + (size_t)(k0 + 8 * i + (lane >> 3)) * D + n0 + 4 * (lane & 7));
#pragma unroll
    for (int i = 0; i < 8; ++i) { LAS float* d = scr + (8 * i + (lane >> 3)) * 33 + 4 * (lane & 7); d[0] = v[i].x; d[1] = v[i].y; d[2] = v[i].z; d[3] = v[i].w; }
    LDS_WAIT(); asm volatile("" ::: "memory");
    const int c = lane & 7;
#pragma unroll
    for (int j = 0; j < 4; ++j) { const int n = (lane >> 3) + 8 * j; const LAS float* sp = scr + (8 * c) * 33 + n;
        unsigned char* row = WT + (size_t)(n0 + n) * OG_PITCH;
        if (hh < OG_NF) { const unsigned lo = pk4_fp8(sp[0 * 33] * 32.f, sp[1 * 33] * 32.f, sp[2 * 33] * 32.f, sp[3 * 33] * 32.f), hi = pk4_fp8(sp[4 * 33] * 32.f, sp[5 * 33] * 32.f, sp[6 * 33] * 32.f, sp[7 * 33] * 32.f);
            *(v2u*)(row + k0 + 8 * c) = (v2u){lo, hi}; }
        else { v4u o; o.x = pk2(sp[0 * 33] * 32.f, sp[1 * 33] * 32.f); o.y = pk2(sp[2 * 33] * 32.f, sp[3 * 33] * 32.f); o.z = pk2(sp[4 * 33] * 32.f, sp[5 * 33] * 32.f); o.w = pk2(sp[6 * 33] * 32.f, sp[7 * 33] * 32.f);
            *(v4u*)(row + OG_NF * 128 + (k0 - OG_NF * 128 + 8 * c) * 2) = o; }
    }
    LDS_WAIT(); asm volatile("" ::: "memory");
}

DI void p0_prologue(Frame& F) {
    LAS float* scr = (LAS float*)(F.lds + F.wave * 16384);
    const int gw = F.vcu * NWAVES + F.wave, NGW = F.G * NWAVES;
    constexpr int I_IN = (D / 64) * (NP / 32), I_OUT = (D / 64) * (D / 32);
    for (int it = gw; it < I_IN + I_OUT; it += NGW) {
        if (it < I_IN) transpose_item(F.w_in, D, INC, NP / 32, (bf16*)(F.ws + WS_WIN), 0, scr, it, F.lane);
        else transpose_wout(F.w_out, F.ws + WS_WOUT, scr, it - I_IN, F.lane);
    }
    {
        bf16* WR = (bf16*)(F.ws + WS_WR);
        const int gt = F.vcu * NTHR + F.tid, NGT = F.G * NTHR;
        for (int i = gt; i < 256 * D; i += NGT) { const int n = i >> 10, k = i & 1023;
            const float v = n < 8 ? F.wr_group[k * 8 + n] : (n < 72 ? F.wr_expert[k * 64 + (n - 8)] : 0.f);
            WR[i] = (bf16)f2bf(v * F.norm_moe_w[k]); }
        float* LB = (float*)(F.ws + WS_LB);
        if (gt < 512) { const float l0 = F.lb_logits[gt], l1 = F.lb_logits[512 + gt]; LB[gt] = 1.f / (1.f + __expf(l1 - l0)); }
    }
    float wn[16]; f32x4 wab[16][2];
#pragma unroll
    for (int j = 0; j < 4; ++j) { const f32x4 t = *(const f32x4*)(F.norm_mix_w + 4 * F.lane + 256 * j); wn[4 * j] = t.x; wn[4 * j + 1] = t.y; wn[4 * j + 2] = t.z; wn[4 * j + 3] = t.w; }
#pragma unroll
    for (int j = 0; j < 4; ++j)
#pragma unroll
        for (int e = 0; e < 4; ++e) { const int k = 4 * F.lane + 256 * j + e; const float* p = F.w_in + (size_t)k * INC + NP; wab[4 * j + e][0] = *(const f32x4*)p; wab[4 * j + e][1] = *(const f32x4*)(p + 4); }
    bf16* HN = (bf16*)F.out; float* AB = (float*)(F.ws + WS_AB); float* RXI = (float*)(F.ws + WS_RXI);
    f32x4 nx[4];
    if (gw < T) {
#pragma unroll
        for (int j = 0; j < 4; ++j) nx[j] = ((const f32x4*)(F.x + (size_t)gw * D) + F.lane)[64 * j]; }
    for (int m = gw; m < T; m += NGW) {
        f32x4 cx[4];
#pragma unroll
        for (int j = 0; j < 4; ++j) cx[j] = nx[j];
        if (m + NGW < T) {
#pragma unroll
            for (int j = 0; j < 4; ++j) nx[j] = ((const f32x4*)(F.x + (size_t)(m + NGW) * D) + F.lane)[64 * j]; }
        float v[16]; float s = 0.f;
#pragma unroll
        for (int j = 0; j < 4; ++j) { const f32x4 t = cx[j]; v[4 * j] = t.x; v[4 * j + 1] = t.y; v[4 * j + 2] = t.z; v[4 * j + 3] = t.w; s += (t.x * t.x + t.y * t.y) + (t.z * t.z + t.w * t.w); }
        const float ms = wave_sum(s) * (1.f / D) + EPS; const float r = frsq(ms);
        if (F.lane == 0) RXI[m] = ms * r;
        float p[8];
#pragma unroll
        for (int c = 0; c < 8; ++c) p[c] = 0.f;
#pragma unroll
        for (int i = 0; i < 16; ++i) { v[i] = v[i] * r * wn[i];
#pragma unroll
            for (int c = 0; c < 4; ++c) { p[c] += v[i] * wab[i][0][c]; p[4 + c] += v[i] * wab[i][1][c]; } }
        unsigned long long* o8 = (unsigned long long*)(HN + (size_t)m * D) + F.lane;
#pragma unroll
        for (int j = 0; j < 4; ++j) o8[64 * j] = (unsigned long long)pk2(v[4 * j], v[4 * j + 1]) | ((unsigned long long)pk2(v[4 * j + 2], v[4 * j + 3]) << 32);
        float mine = 0.f;
#pragma unroll
        for (int c = 0; c < 8; ++c) { const float t = wave_sum(p[c]); mine = (F.lane == c) ? t : mine; }
        if (F.lane < 8) AB[(size_t)m * 8 + F.lane] = mine;
    }
}

DI bf16x8 ldfrag(const LAS bf16* base, int ld, int lane) { return *(const LAS bf16x8*)(base + (lane & 15) * ld + 8 * (lane >> 4)); }
#define MFMA16(a, b, c) __builtin_amdgcn_mfma_f32_16x16x32_bf16((a), (b), (c), 0, 0, 0)
constexpr float QSCALE = 0.08838834764831845f;
DI size_t prb(int bn, int cb) { return ((size_t)bn * 32 + cb) * 8192; }

DI void hg_raw_load(Frame& F, int item, unsigned (&nq)[16], unsigned (&nf)[16], unsigned (&ni)[16], float& nlb) {
    const int h = item & 3, bn = item >> 2, ch = F.tid & 127, tg = F.tid >> 7;
    const bf16* pbase = (const bf16*)(F.ws + WS_R2) + prb(bn, h) + (tg * 16) * 128 + ch;
#pragma unroll
    for (int i = 0; i < 16; ++i) { const bf16* p = pbase + i * 128; nq[i] = p[0]; nf[i] = p[4 * 8192]; ni[i] = p[8 * 8192]; }
    nlb = ((const float*)(F.ws + WS_LB))[h * 128 + ch];
}
DI void hg_pre_item(Frame& F, int item, bf16* PRo, int ldo, bf16* OGo, float* DL, unsigned (&nq)[16], unsigned (&nf)[16], unsigned (&ni)[16], float& nlb, int next_item) {
    const int h = item & 3, bn = item >> 2, tok0 = bn * 64;
    LAS bf16* Aq = (LAS bf16*)F.lds; LAS bf16* Ak = Aq + 64 * 136; LAS bf16* Vt = Ak + 64 * 136; LAS bf16* Att = Vt + 128 * 72; LAS float* part = (LAS float*)(Att + 64 * 72);
    bf16* PR = (bf16*)(F.ws + WS_R2); bf16* R1 = (bf16*)(F.ws + WS_R1);
    const float* LB = (const float*)(F.ws + WS_LB);
    const int ch = F.tid & 127, tg = F.tid >> 7, lane = F.lane, wave = F.wave;
    const float lbv = nlb, olb = 1.f - lbv;
    float qv[16], kk[16], cum[16]; unsigned iv[16], cq[16], cf[16];
#pragma unroll
    for (int i = 0; i < 16; ++i) { cq[i] = nq[i]; cf[i] = nf[i]; iv[i] = ni[i]; }
    if (next_item >= 0) hg_raw_load(F, next_item, nq, nf, ni, nlb);
    float run = 0.f;
    bf16* pbase = PR + prb(bn, h) + (tg * 16) * 128 + ch; bf16* pobase = PRo + prb(bn, h) + (tg * 16) * 128 + ch;
#pragma unroll
    for (int i = 0; i < 16; ++i) {
        const float q = bf2f(cq[i]), fl = bf2f(cf[i]);
        const float e = __expf(-fl), sg = frcp(1.f + e);
        const float f = lbv + olb * sg; run += __logf(f); cum[i] = run; kk[i] = olb * (e * sg); qv[i] = silu(q) * QSCALE; }
    part[tg * 128 + ch] = run;
    LSYNC();
    const float p0 = part[ch], p1 = part[128 + ch], p2 = part[256 + ch], p3 = part[384 + ch];
    const float prefix = (tg > 0 ? p0 : 0.f) + (tg > 1 ? p1 : 0.f) + (tg > 2 ? p2 : 0.f), last = ((p0 + p1) + p2) + p3, cref = p0 + p1;
    unsigned kd[8], ivp[8];
    const float ecref = __expf(cref), elc = __expf(last - cref);
#pragma unroll
    for (int i = 0; i < 16; i += 2) {
        const float c0 = cum[i] + prefix, c1 = cum[i + 1] + prefix; const int t = tg * 16 + i;
        const float e0 = __expf(c0 - cref), e1 = __expf(c1 - cref), r0 = __expf(cref - c0), r1 = __expf(cref - c1);
        Aq[t * 136 + ch] = (bf16)f2bf(qv[i] * e0); Aq[(t + 1) * 136 + ch] = (bf16)f2bf(qv[i + 1] * e1);
        Ak[t * 136 + ch] = (bf16)f2bf(kk[i] * r0); Ak[(t + 1) * 136 + ch] = (bf16)f2bf(kk[i + 1] * r1);
        pobase[i * 128] = (bf16)f2bf(qv[i] * e0 * ecref); pobase[(i + 1) * 128] = (bf16)f2bf(qv[i + 1] * e1 * ecref);
        kd[i >> 1] = pk2(kk[i] * r0 * elc, kk[i + 1] * r1 * elc); ivp[i >> 1] = iv[i] | (iv[i + 1] << 16); }
    {
        bf16* kp = PRo + prb(bn, 4 + h) + ch * 64 + tg * 16;
        *(v4u*)kp = (v4u){kd[0], kd[1], kd[2], kd[3]}; *(v4u*)(kp + 8) = (v4u){kd[4], kd[5], kd[6], kd[7]};
        *(v4u*)(kp + 4 * 8192) = (v4u){ivp[0], ivp[1], ivp[2], ivp[3]}; *(v4u*)(kp + 4 * 8192 + 8) = (v4u){ivp[4], ivp[5], ivp[6], ivp[7]};
        LAS bf16* vp = Vt + ch * 72 + tg * 16;
        *(LAS v4u*)vp = (v4u){ivp[0], ivp[1], ivp[2], ivp[3]}; *(LAS v4u*)(vp + 8) = (v4u){ivp[4], ivp[5], ivp[6], ivp[7]};
        if (tg == 0) DL[(size_t)item * 128 + ch] = __expf(last);
    }
    LSYNC();
#pragma unroll
    for (int j = 0; j < 2; ++j) { const int id = wave * 2 + j, tt = id >> 2, st = id & 3; const int c = lane & 15, q = lane >> 4;
        f32x4 acc = (f32x4){0.f, 0.f, 0.f, 0.f};
        if (st <= tt) {
#pragma unroll
            for (int kc = 0; kc < 4; ++kc) acc = MFMA16(ldfrag(Ak + st * 16 * 136 + kc * 32, 136, lane), ldfrag(Aq + tt * 16 * 136 + kc * 32, 136, lane), acc);
        }
        const int t = tt * 16 + c, s0 = st * 16 + 4 * q;
        const float a0 = (s0 <= t) ? acc[0] : 0.f, a1 = (s0 + 1 <= t) ? acc[1] : 0.f, a2 = (s0 + 2 <= t) ? acc[2] : 0.f, a3 = (s0 + 3 <= t) ? acc[3] : 0.f;
        *(LAS v2u*)(Att + t * 72 + s0) = (v2u){pk2(a0, a1), pk2(a2, a3)}; }
    LSYNC();
#pragma unroll
    for (int j = 0; j < 4; ++j) { const int id = wave * 4 + j, tt = id >> 3, vt = id & 7; const int c = lane & 15, q = lane >> 4;
        f32x4 acc = (f32x4){0.f, 0.f, 0.f, 0.f};
#pragma unroll
        for (int sc = 0; sc < 2; ++sc) acc = MFMA16(ldfrag(Vt + vt * 16 * 72 + sc * 32, 72, lane), ldfrag(Att + tt * 16 * 72 + sc * 32, 72, lane), acc);
        *(v2u*)(OGo + (size_t)(tok0 + tt * 16 + c) * D + h * 128 + vt * 16 + 4 * q) = (v2u){pk2(acc[0], acc[1]), pk2(acc[2], acc[3])}; }
    LSYNC();
}

#define DPP_ADD(v, ctrl) (v) += __builtin_bit_cast(float, __builtin_amdgcn_mov_dpp(__builtin_bit_cast(int, (v)), (ctrl), 0xF, 0xF, true))
DI float row16_sum(float v) { DPP_ADD(v, 0xB1); DPP_ADD(v, 0x4E); DPP_ADD(v, 0x141); DPP_ADD(v, 0x140); return v; }
DI v4u pack8(const float (&y)[8]) { return (v4u){pk2(y[0], y[1]), pk2(y[2], y[3]), pk2(y[4], y[5]), pk2(y[6], y[7])}; }
DI void gd_raw_load(Frame& F, int item, v4u (&raw)[11], f32x4 (&cw)[4][2]) {
    const int h = item & 3, bn = item >> 2, n = bn & 63; const int X = F.wave >> 1, rg = (F.tid >> 4) & 7, c16 = F.tid & 15;
    const bf16* p = (const bf16*)(F.ws + WS_R2) + prb(bn, 16 + 4 * X + h) + 8 * c16;
#pragma unroll
    for (int i = 0; i < 11; ++i) { const int rr = 8 * rg - 3 + i; raw[i] = (v4u){0u, 0u, 0u, 0u};
        if (rr >= 0) raw[i] = *(const v4u*)(p + rr * 128); else if (n > 0) raw[i] = *(const v4u*)(p - (long)32 * 8192 + (64 + rr) * 128); }
#pragma unroll
    for (int j = 0; j < 4; ++j) { const float* wp = F.conv_w + j * 1536 + 512 * X + h * 128 + 8 * c16; cw[j][0] = *(const f32x4*)wp; cw[j][1] = *(const f32x4*)(wp + 4); }
}
DI void gd_pre_item(Frame& F, int item, v4u (&raw)[11], f32x4 (&cw)[4][2], float (&pab)[2], int next_item) {
    const int h = item & 3, bn = item >> 2, n = bn & 63, tok0 = bn * 64;
    LAS bf16* Qs = (LAS bf16*)F.lds; LAS bf16* Ks = Qs + 64 * 136; LAS bf16* Ab = Ks + 64 * 136; LAS bf16* Tm = Ab + 64 * 72; LAS bf16* TT = Tm + 64 * 72; LAS bf16* RHST = TT + 64 * 72;
    LAS float* A16 = (LAS float*)(RHST + 256 * 72); LAS bf16* MT16 = (LAS bf16*)(A16 + 1024); LAS float* gcS = (LAS float*)(MT16 + 16 * 24); LAS float* egcS = gcS + 64; LAS float* betaS = gcS + 128;
    const bf16* PR = (const bf16*)(F.ws + WS_R2); bf16* R1 = (bf16*)(F.ws + WS_R1); const float* AB = (const float*)(F.ws + WS_AB);
    bf16* GW = (bf16*)(F.ws + WS_GW) + (size_t)item * 8192; bf16* GU = (bf16*)(F.ws + WS_GU) + (size_t)item * 8192;
    bf16* GQG = (bf16*)(F.ws + WS_GQG) + (size_t)item * 8192; bf16* GKD = (bf16*)(F.ws + WS_GKD) + (size_t)item * 8192;
    int tidv = F.tid; asm volatile("" : "+v"(tidv));
    const int lane = tidv & 63, wave = F.wave, c = lane & 15, q = lane >> 4;
    float y[8][8];
    const int X = wave >> 1, rg = (tidv >> 4) & 7, c16 = tidv & 15;
    if (wave < 6) {
        const int ccol = 512 * X + h * 128 + 8 * c16;
#pragma unroll
        for (int ep = 0; ep < 4; ++ep) {
            float w0[4], w1[4];
#pragma unroll
            for (int j = 0; j < 4; ++j) { w0[j] = cw[j][ep >> 1][(2 * ep) & 3]; w1[j] = cw[j][ep >> 1][((2 * ep) & 3) + 1]; }
            float u0[11], u1[11];
#pragma unroll
            for (int i = 0; i < 11; ++i) { u0[i] = bflo(raw[i][ep]); u1[i] = bfhi(raw[i][ep]); }
#pragma unroll
            for (int t = 0; t < 8; ++t) { float a = u0[t] * w0[0]; a += u0[t + 1] * w0[1]; a += u0[t + 2] * w0[2]; a += u0[t + 3] * w0[3];
                float b = u1[t] * w1[0]; b += u1[t + 1] * w1[1]; b += u1[t + 2] * w1[2]; b += u1[t + 3] * w1[3];
                y[t][2 * ep] = silu(a); y[t][2 * ep + 1] = silu(b); }
        }
        if (next_item >= 0) gd_raw_load(F, next_item, raw, cw);
        if (X < 2) {
#pragma unroll
            for (int t = 0; t < 8; ++t) { float s = 0.f;
#pragma unroll
                for (int e = 0; e < 8; ++e) s += y[t][e] * y[t][e];
                s = row16_sum(s); const float r = (X == 0 ? QSCALE : 1.f) * frsq(s + 1e-6f);
#pragma unroll
                for (int e = 0; e < 8; ++e) y[t][e] *= r; }
        }
    } else if (wave == 6) {
        const float a = pab[0], b = pab[1];
        if (next_item >= 0) { const int nh = next_item & 3, ntok = (next_item >> 2) * 64 + lane; pab[0] = AB[(size_t)ntok * 8 + nh]; pab[1] = AB[(size_t)ntok * 8 + 4 + nh]; }
        const float xx = a + F.dt_bias[h]; const float sp = xx > 20.f ? xx : __logf(1.f + __expf(xx));
        float gc = -__expf(F.a_log[h]) * sp;
#pragma unroll
        for (int o = 1; o < 64; o <<= 1) { const float t = __shfl_up(gc, o); if (lane >= o) gc += t; }
        gcS[lane] = gc; egcS[lane] = __expf(gc); betaS[lane] = frcp(1.f + __expf(-b));
        if (lane == 63) ((float*)(F.ws + WS_GEND))[item] = __expf(gc);
    } else {
        for (int i = lane; i < 3 * 64 * 72 / 8; i += 64) ((LAS v4u*)Ab)[i] = (v4u){0u, 0u, 0u, 0u};
    }
    LSYNC();
    if (wave < 6) {
        const float glast = gcS[63];
        float bt[8], eg[8], kdx[8];
#pragma unroll
        for (int t = 0; t < 8; ++t) { bt[t] = betaS[8 * rg + t]; eg[t] = egcS[8 * rg + t]; kdx[t] = __expf(glast - gcS[8 * rg + t]); }
        if (X == 0) {
#pragma unroll
            for (int t = 0; t < 8; ++t) { *(LAS v4u*)(Qs + (8 * rg + t) * 136 + 8 * c16) = pack8(y[t]);
                float z[8];
#pragma unroll
                for (int e = 0; e < 8; ++e) z[e] = y[t][e] * eg[t];
                *(v4u*)(GQG + (8 * rg + t) * 128 + 8 * c16) = pack8(z); }
        } else if (X == 1) {
#pragma unroll
            for (int t = 0; t < 8; ++t) *(LAS v4u*)(Ks + (8 * rg + t) * 136 + 8 * c16) = pack8(y[t]);
#pragma unroll
            for (int e = 0; e < 8; ++e) { float z[8], z2[8];
#pragma unroll
                for (int t = 0; t < 8; ++t) { z[t] = y[t][e] * bt[t] * eg[t]; z2[t] = y[t][e] * kdx[t]; }
                *(LAS v4u*)(RHST + (8 * c16 + e) * 72 + 8 * rg) = pack8(z); *(v4u*)(GKD + (8 * c16 + e) * 64 + 8 * rg) = pack8(z2); }
        } else {
#pragma unroll
            for (int e = 0; e < 8; ++e) { float z[8];
#pragma unroll
                for (int t = 0; t < 8; ++t) z[t] = y[t][e] * bt[t];
                *(LAS v4u*)(RHST + (128 + 8 * c16 + e) * 72 + 8 * rg) = pack8(z); }
        }
    }
    LSYNC();
    for (int id = wave; id < 26; id += 8) {
        if (id >= 20) { const int ui = id - 20; const int tt = ui < 3 ? 0 : (ui < 5 ? 1 : 2), st = ui < 3 ? ui + 1 : (ui < 5 ? ui - 1 : 3);
            *(v2u*)(R1 + (size_t)(tok0 + tt * 16 + c) * D + 512 + h * 128 + st * 16 + 4 * q) = (v2u){0u, 0u}; continue; }
        const int which = id >= 10, li = which ? id - 10 : id; const int tt = li >= 6 ? 3 : (li >= 3 ? 2 : (li >= 1 ? 1 : 0)), st = li - tt * (tt + 1) / 2;
        f32x4 acc = (f32x4){0.f, 0.f, 0.f, 0.f};
        const LAS bf16* Fb = (which ? Qs : Ks) + tt * 16 * 136;
        const int t = tt * 16 + c, s0 = st * 16 + 4 * q;
        bf16x8 fa[4], fb[4];
#pragma unroll
        for (int kc = 0; kc < 4; ++kc) { fa[kc] = ldfrag(Ks + st * 16 * 136 + kc * 32, 136, lane); fb[kc] = ldfrag(Fb + kc * 32, 136, lane); }
        const f32x4 gs4 = *(const LAS f32x4*)(gcS + s0); const float gt = gcS[t]; const float b2 = betaS[t];
        __builtin_amdgcn_sched_barrier(0);
#pragma unroll
        for (int kc = 0; kc < 4; ++kc) acc = MFMA16(fa[kc], fb[kc], acc);
        float vals[4];
#pragma unroll
        for (int r = 0; r < 4; ++r) { const int s = s0 + r; const bool keep = which ? (s <= t) : (s < t); const float e = __expf(fminf(gt - gs4[r], 0.f)); vals[r] = keep ? acc[r] * e : 0.f; }
        if (which == 0) {
#pragma unroll
            for (int r = 0; r < 4; ++r) vals[r] *= b2;
            *(LAS v2u*)(Ab + t * 72 + s0) = (v2u){pk2(vals[0], vals[1]), pk2(vals[2], vals[3])};
            if (tt == st) *(LAS f32x4*)(A16 + tt * 256 + c * 16 + 4 * q) = (f32x4){vals[0], vals[1], vals[2], vals[3]}; }
        else *(v2u*)(R1 + (size_t)(tok0 + t) * D + 512 + h * 128 + s0) = (v2u){pk2(vals[0], vals[1]), pk2(vals[2], vals[3])};
    }
    LSYNC();
    if (wave == 0) {
        { const int bi = q, j = c; float x[16];
          f32x4 ar[16][4];
#pragma unroll
          for (int r = 1; r < 16; ++r)
#pragma unroll
              for (int s4 = 0; s4 < (r + 3) / 4; ++s4) ar[r][s4] = *(const LAS f32x4*)(A16 + bi * 256 + r * 16 + 4 * s4);
#pragma unroll
          for (int r = 0; r < 16; ++r) { float a = (r == j) ? 1.f : 0.f;
#pragma unroll
              for (int s = 0; s < r; ++s) a -= ar[r][s >> 2][s & 3] * x[s];
              x[r] = a; }
          unsigned pk[8];
#pragma unroll
          for (int r = 0; r < 16; r += 2) { pk[r >> 1] = pk2(x[r], x[r + 1]); Tm[(16 * bi + r) * 72 + 16 * bi + j] = (bf16)(pk[r >> 1] & 0xffffu); Tm[(16 * bi + r + 1) * 72 + 16 * bi + j] = (bf16)(pk[r >> 1] >> 16); }
          *(LAS v4u*)(TT + (16 * bi + j) * 72 + 16 * bi) = (v4u){pk[0], pk[1], pk[2], pk[3]}; *(LAS v4u*)(TT + (16 * bi + j) * 72 + 16 * bi + 8) = (v4u){pk[4], pk[5], pk[6], pk[7]}; }
#pragma unroll
        for (int d = 1; d < 4; ++d)
#pragma unroll
            for (int i = d; i < 4; ++i) { const int j = i - d;
                f32x4 m = (f32x4){0.f, 0.f, 0.f, 0.f};
#pragma unroll
                for (int kc = 0; kc < 2; ++kc) m = MFMA16(ldfrag(Ab + 16 * i * 72 + kc * 32, 72, lane), ldfrag(TT + 16 * j * 72 + kc * 32, 72, lane), m);
                *(LAS v2u*)(MT16 + c * 24 + 4 * q) = (v2u){pk2(m[0], m[1]), pk2(m[2], m[3])};
                const bool on = (q >> 1) == (i & 1);
                bf16x8 fa = ldfrag(Tm + 16 * i * 72 + ((16 * i) & ~31), 72, lane); bf16x8 fb = *(const LAS bf16x8*)(MT16 + c * 24 + 8 * (q & 1));
                if (!on) { fa = (bf16x8){0, 0, 0, 0, 0, 0, 0, 0}; fb = fa; }
                const f32x4 t2 = MFMA16(fa, fb, ((f32x4){0.f, 0.f, 0.f, 0.f}));
                const unsigned p0 = pk2(-t2[0], -t2[1]), p1 = pk2(-t2[2], -t2[3]);
                *(LAS v2u*)(TT + (16 * j + c) * 72 + 16 * i + 4 * q) = (v2u){p0, p1};
                Tm[(16 * i + 4 * q) * 72 + 16 * j + c] = (bf16)(p0 & 0xffffu); Tm[(16 * i + 4 * q + 1) * 72 + 16 * j + c] = (bf16)(p0 >> 16);
                Tm[(16 * i + 4 * q + 2) * 72 + 16 * j + c] = (bf16)(p1 & 0xffffu); Tm[(16 * i + 4 * q + 3) * 72 + 16 * j + c] = (bf16)(p1 >> 16); }
    }
    LSYNC();
#pragma unroll
    for (int jj = 0; jj < 8; ++jj) { const int id = wave * 8 + jj, isu = id >> 5, tt = (id >> 3) & 3, ct = id & 7;
        f32x4 acc = (f32x4){0.f, 0.f, 0.f, 0.f};
        const LAS bf16* Rr = RHST + (isu * 128 + ct * 16) * 72; const LAS bf16* Tr = Tm + tt * 16 * 72;
        if (!isu) {
#pragma unroll
            for (int kc = 0; kc < 2; ++kc) acc = MFMA16(ldfrag(Rr + kc * 32, 72, lane), ldfrag(Tr + kc * 32, 72, lane), acc);
            *(v2u*)(GW + (tt * 16 + c) * 128 + ct * 16 + 4 * q) = (v2u){pk2(acc[0], acc[1]), pk2(acc[2], acc[3])};
        } else {
#pragma unroll
            for (int kc = 0; kc < 2; ++kc) acc = MFMA16(ldfrag(Tr + kc * 32, 72, lane), ldfrag(Rr + kc * 32, 72, lane), acc);
            *(v2u*)(GU + (ct * 16 + c) * 64 + tt * 16 + 4 * q) = (v2u){pk2(acc[0], acc[1]), pk2(acc[2], acc[3])};
        }
    }
    LSYNC();
}

#define MKRSRC(ptr) __builtin_amdgcn_make_buffer_rsrc((void*)(ptr), 0, 0x7fffffff, 0x00020000)
#define BLD128(rs, vo, so) __builtin_bit_cast(v4u, __builtin_amdgcn_raw_buffer_load_b128((rs), (int)(vo), (int)(so), 0))
DI float qsum(float p) { p += __shfl_xor(p, 16); p += __shfl_xor(p, 32); return p; }
DI bf16x8 ldfragP(const LAS bf16* base, int ld, int lane) {
    const LAS bf16* p = base + (lane & 15) * ld + 4 * (lane >> 4); const v2u lo = *(const LAS v2u*)p, hi = *(const LAS v2u*)(p + 16);
    return __builtin_bit_cast(bf16x8, (v4u){lo.x, lo.y, hi.x, hi.y}); }
DI bf16x8 accpair(const f32x4 a, const f32x4 b) { return __builtin_bit_cast(bf16x8, (v4u){pk2(a[0], a[1]), pk2(a[2], a[3]), pk2(b[0], b[1]), pk2(b[2], b[3])}); }
DI bf16x8 accpair_neg(const f32x4 a, const f32x4 b) { return __builtin_bit_cast(bf16x8, (v4u){pk2(-a[0], -a[1]), pk2(-a[2], -a[3]), pk2(-b[0], -b[1]), pk2(-b[2], -b[3])}); }
DI f32x4 ld4bf(const LAS bf16* p) { const v2u x = *(const LAS v2u*)p; return (f32x4){bflo(x.x), bfhi(x.x), bflo(x.y), bfhi(x.y)}; }

template <int NOLOAD>
DI void hg_chain(Frame& F, int b, int h, unsigned char* OGo, unsigned* prog) {
    LAS bf16* A1 = (LAS bf16*)F.lds; LAS bf16* A2 = A1 + 64 * 136; LAS bf16* B2 = A2 + 128 * 72; LAS bf16* Gs = B2 + 128 * 72; LAS bf16* Is = Gs + 64 * 136; LAS bf16* OGs = Is + 64 * 136;
    LAS float* dl = (LAS float*)(OGs + 64 * 136); LAS float* PS = dl + 128;
    const bf16* PR = (const bf16*)(F.ws + WS_R2); const bf16* R1 = (const bf16*)(F.ws + WS_R1); const float* DL = (const float*)(F.ws + WS_DLAST);
    const int tid = F.tid, lane0 = F.lane, w = F.wave;
    if (w >= 4) {
        int lt_ = tid - 256; asm volatile("" : "+v"(lt_));
        const int lt = lt_, r1 = lt >> 2, s1 = lt & 3, k2 = lt >> 1, s2 = lt & 1;
        const unsigned oA1 = (unsigned)(r1 * 128 + s1 * 32), oA2 = (unsigned)(4 * 8192 + k2 * 64 + s2 * 32), oB2 = oA2 + 4u * 8192u, oG = oA1 + 12u * 8192u;
        const unsigned oI = (unsigned)(r1 * D + h * 128 + s1 * 32);
        const __amdgpu_buffer_rsrc_t rsP = MKRSRC(PR), rsI = MKRSRC(R1);
        v4u pa[4], pb[4], pc[4], pg[4], pi[4]; float pdl = 0.f;
#define HG_LOAD(n_) do { const int bn_ = b * 64 + (n_); const unsigned so_ = (unsigned)(prb(bn_, h) * 2), si_ = (unsigned)(bn_ * 64 * D * 2); \
            _Pragma("unroll") for (int i_ = 0; i_ < 4; ++i_) { pa[i_] = BLD128(rsP, 2u * oA1 + 16u * i_, so_); pb[i_] = BLD128(rsP, 2u * oA2 + 16u * i_, so_); pc[i_] = BLD128(rsP, 2u * oB2 + 16u * i_, so_); \
                pg[i_] = BLD128(rsP, 2u * oG + 16u * i_, so_); pi[i_] = BLD128(rsI, 2u * oI + 16u * i_, si_); } \
            if (lt < 128) pdl = DL[(size_t)(bn_ * 4 + h) * 128 + lt]; } while (0)
        HG_LOAD(0);
        for (int n = 0; n <= NCH; ++n) {
            if (n < NCH) {
#pragma unroll
                for (int i = 0; i < 4; ++i) { *(LAS v4u*)(A1 + r1 * 136 + s1 * 32 + 8 * i) = pa[i]; *(LAS v4u*)(A2 + k2 * 72 + s2 * 32 + 8 * i) = pb[i]; *(LAS v4u*)(B2 + k2 * 72 + s2 * 32 + 8 * i) = pc[i];
                    *(LAS v4u*)(Gs + r1 * 136 + s1 * 32 + 8 * i) = pg[i]; *(LAS v4u*)(Is + r1 * 136 + s1 * 32 + 8 * i) = pi[i]; }
                if (lt < 128) dl[lt] = pdl;
            }
            LSYNC();
            if (lt == 0) __hip_atomic_store(prog, (unsigned)(n + 1), __ATOMIC_RELAXED, __HIP_MEMORY_SCOPE_AGENT);
            if (NOLOAD == 0 && n + 1 < NCH) HG_LOAD(n + 1);
            if (NOLOAD == 2 && n + 1 < NCH) HG_LOAD(n & 1);
            if (n > 0) {
                unsigned char* orow = OGo + (size_t)((b * 64 + n - 1) * 64 + r1) * OG_PITCH;
                if ((h) < OG_NF) {
                    unsigned char* og = orow + (h) * 128 + s1 * 32;
                    unsigned o8[8];
#pragma unroll
                    for (int i = 0; i < 4; ++i) { const v4u t = *(const LAS v4u*)(OGs + r1 * 136 + s1 * 32 + 8 * i);
                        o8[2 * i] = pk4_fp8(bflo(t.x), bfhi(t.x), bflo(t.y), bfhi(t.y)); o8[2 * i + 1] = pk4_fp8(bflo(t.z), bfhi(t.z), bflo(t.w), bfhi(t.w)); }
                    *(v4u*)og = (v4u){o8[0], o8[1], o8[2], o8[3]}; *(v4u*)(og + 16) = (v4u){o8[4], o8[5], o8[6], o8[7]};
                } else {
                    unsigned char* og = orow + OG_NF * 128 + ((h) - OG_NF) * 256 + s1 * 64;
#pragma unroll
                    for (int i = 0; i < 4; ++i) *(v4u*)(og + 16 * i) = *(const LAS v4u*)(OGs + r1 * 136 + s1 * 32 + 8 * i);
                }
            }
            LSYNC();
        }
#undef HG_LOAD
    } else {
        int ln_ = lane0; asm volatile("" : "+v"(ln_)); const int lane = ln_, c = lane & 15, q = lane >> 4;
        f32x4 onw4[2];
#pragma unroll
        for (int j = 0; j < 2; ++j) onw4[j] = *(const f32x4*)(F.hg_onorm_w + 32 * w + 16 * j + 4 * q);
        f32x4 S[2][8];
#pragma unroll
        for (int j = 0; j < 2; ++j)
#pragma unroll
            for (int kt = 0; kt < 8; ++kt) S[j][kt] = (f32x4){0.f, 0.f, 0.f, 0.f};
        for (int n = 0; n <= NCH; ++n) {
            LSYNC();
            if (n == NCH) { LSYNC(); break; }
            f32x4 oacc[2][4];
            bf16x8 fr[2][4], bb[2][2];
#define HG_LD(buf, g) do { if ((g) < 4) { _Pragma("unroll") for (int i_ = 0; i_ < 4; ++i_) buf[i_] = ldfragP(A1 + i_ * 16 * 136 + (g) * 32, 136, lane); } \
                else { const int tc_ = ((g) - 4) >> 1, hf_ = ((g) - 4) & 1; _Pragma("unroll") for (int i_ = 0; i_ < 4; ++i_) buf[i_] = ldfrag(A2 + (hf_ * 4 + i_) * 16 * 72 + tc_ * 32, 72, lane); \
                    if (hf_ == 0) { bb[tc_][0] = ldfrag(B2 + (32 * w) * 72 + tc_ * 32, 72, lane); bb[tc_][1] = ldfrag(B2 + (32 * w + 16) * 72 + tc_ * 32, 72, lane); } } } while (0)
#define HG_MM(buf, g) do { if ((g) < 4) { const bf16x8 s0_ = accpair(S[0][2 * (g)], S[0][2 * (g) + 1]), s1_ = accpair(S[1][2 * (g)], S[1][2 * (g) + 1]); \
                    _Pragma("unroll") for (int i_ = 0; i_ < 4; ++i_) { oacc[0][i_] = MFMA16(s0_, buf[i_], oacc[0][i_]); oacc[1][i_] = MFMA16(s1_, buf[i_], oacc[1][i_]); } } \
                else { const int tc_ = ((g) - 4) >> 1, hf_ = ((g) - 4) & 1; _Pragma("unroll") for (int i_ = 0; i_ < 4; ++i_) { S[0][hf_ * 4 + i_] = MFMA16(buf[i_], bb[tc_][0], S[0][hf_ * 4 + i_]); S[1][hf_ * 4 + i_] = MFMA16(buf[i_], bb[tc_][1], S[1][hf_ * 4 + i_]); } } } while (0)
#define HG_STEP(g) do { if ((g) + 1 < 8) HG_LD(fr[((g) + 1) & 1], (g) + 1); __builtin_amdgcn_sched_barrier(0); HG_MM(fr[(g) & 1], g); __builtin_amdgcn_sched_barrier(0); } while (0)
            HG_LD(fr[0], 0);
#pragma unroll
            for (int j = 0; j < 2; ++j)
#pragma unroll
                for (int tt = 0; tt < 4; ++tt) oacc[j][tt] = ld4bf(Is + (tt * 16 + c) * 136 + 32 * w + 16 * j + 4 * q);
            HG_STEP(0); HG_STEP(1); HG_STEP(2);
            { f32x4 d4[8];
#pragma unroll
              for (int kt = 0; kt < 8; ++kt) d4[kt] = *(const LAS f32x4*)(dl + kt * 16 + 4 * q);
              HG_STEP(3);
#pragma unroll
              for (int kt = 0; kt < 8; ++kt) { S[0][kt] = S[0][kt] * d4[kt]; S[1][kt] = S[1][kt] * d4[kt]; } }
            HG_STEP(4); HG_STEP(5); HG_STEP(6); HG_STEP(7);
#undef HG_LD
#undef HG_MM
#undef HG_STEP
            f32x4 g4[2][4];
#pragma unroll
            for (int j = 0; j < 2; ++j)
#pragma unroll
                for (int tt = 0; tt < 4; ++tt) g4[j][tt] = ld4bf(Gs + (tt * 16 + c) * 136 + 32 * w + 16 * j + 4 * q);
#pragma unroll
            for (int tt = 0; tt < 4; ++tt) { const f32x4 o0 = oacc[0][tt], o1 = oacc[1][tt];
                const float p = qsum(((o0[0] * o0[0] + o0[1] * o0[1]) + (o0[2] * o0[2] + o0[3] * o0[3])) + ((o1[0] * o1[0] + o1[1] * o1[1]) + (o1[2] * o1[2] + o1[3] * o1[3])));
                if (q == 0) PS[(tt * 16 + c) * 4 + w] = p; }
            LSYNC();
#pragma unroll
            for (int tt = 0; tt < 4; ++tt) { const f32x4 pa4 = *(const LAS f32x4*)(PS + (tt * 16 + c) * 4);
                const float rstd = frsq(((pa4.x + pa4.y) + (pa4.z + pa4.w)) * (1.f / 128.f) + EPS);
#pragma unroll
                for (int j = 0; j < 2; ++j) { const f32x4 o = oacc[j][tt] * onw4[j] * rstd; const f32x4 g = g4[j][tt];
                    *(LAS v2u*)(OGs + (tt * 16 + c) * 136 + 32 * w + 16 * j + 4 * q) = (v2u){pk2(o[0] * silu(g[0]), o[1] * silu(g[1])), pk2(o[2] * silu(g[2]), o[3] * silu(g[3]))}; } }
        }
    }
    LSYNC();
}

template <int NOLOAD>
DI void gd_chain(Frame& F, int b, int h, unsigned char* OGo, unsigned* prog) {
    LAS bf16* W = (LAS bf16*)F.lds; LAS bf16* QG = W + 64 * 136; LAS bf16* QK = QG + 64 * 136; LAS bf16* KD = QK + 64 * 72; LAS bf16* UT = KD + 128 * 72; LAS bf16* Gs = UT + 128 * 72; LAS bf16* OGs = Gs + 64 * 136;
    LAS float* PS = (LAS float*)(OGs + 64 * 136);
    const bf16* PR = (const bf16*)(F.ws + WS_R2); const bf16* R1 = (const bf16*)(F.ws + WS_R1); const float* GEND = (const float*)(F.ws + WS_GEND);
    const int tid = F.tid, lane0 = F.lane, w = F.wave;
    if (w >= 4) {
        int lt_ = tid - 256; asm volatile("" : "+v"(lt_));
        const int lt = lt_, r1 = lt >> 2, s1 = lt & 3, k2 = lt >> 1, s2 = lt & 1;
        const unsigned oQk = (unsigned)(r1 * D + 512 + h * 128 + s1 * 16), oW = (unsigned)(r1 * 128 + s1 * 32), oK = (unsigned)(k2 * 64 + s2 * 32);
        const __amdgpu_buffer_rsrc_t rsW = MKRSRC(F.ws + WS_GW), rsQ = MKRSRC(F.ws + WS_GQG), rsK = MKRSRC(F.ws + WS_GKD), rsU = MKRSRC(F.ws + WS_GU), rsI = MKRSRC(R1), rsP = MKRSRC(PR);
        v4u pw[4], pq[4], pk[2], pd[4], pu[4], pg[4]; float pge = 0.f;
#define GD_LOAD(n_) do { const int bn_ = b * 64 + (n_); const unsigned so_ = (unsigned)((bn_ * 4 + h) * 16384), sg_ = (unsigned)(prb(bn_, 28 + h) * 2); \
            _Pragma("unroll") for (int i_ = 0; i_ < 4; ++i_) { pw[i_] = BLD128(rsW, 2u * oW + 16u * i_, so_); pq[i_] = BLD128(rsQ, 2u * oW + 16u * i_, so_); pd[i_] = BLD128(rsK, 2u * oK + 16u * i_, so_); \
                pu[i_] = BLD128(rsU, 2u * oK + 16u * i_, so_); pg[i_] = BLD128(rsP, 2u * oW + 16u * i_, sg_); } \
            pk[0] = BLD128(rsI, 2u * oQk, (unsigned)(bn_ * 64 * D * 2)); pk[1] = BLD128(rsI, 2u * oQk + 16u, (unsigned)(bn_ * 64 * D * 2)); pge = GEND[bn_ * 4 + h]; } while (0)
        GD_LOAD(0);
        for (int n = 0; n <= NCH; ++n) {
            if (n < NCH) {
#pragma unroll
                for (int i = 0; i < 4; ++i) { *(LAS v4u*)(W + r1 * 136 + s1 * 32 + 8 * i) = pw[i]; *(LAS v4u*)(QG + r1 * 136 + s1 * 32 + 8 * i) = pq[i]; *(LAS v4u*)(KD + k2 * 72 + s2 * 32 + 8 * i) = pd[i];
                    *(LAS v4u*)(UT + k2 * 72 + s2 * 32 + 8 * i) = pu[i]; *(LAS v4u*)(Gs + r1 * 136 + s1 * 32 + 8 * i) = pg[i]; }
                *(LAS v4u*)(QK + r1 * 72 + s1 * 16) = pk[0]; *(LAS v4u*)(QK + r1 * 72 + s1 * 16 + 8) = pk[1]; if (lt == 0) PS[1024] = pge;
            }
            LSYNC();
            if (lt == 0) __hip_atomic_store(prog, (unsigned)(n + 1), __ATOMIC_RELAXED, __HIP_MEMORY_SCOPE_AGENT);
            if (NOLOAD == 0 && n + 1 < NCH) GD_LOAD(n + 1);
            if (NOLOAD == 2 && n + 1 < NCH) GD_LOAD(n & 1);
            if (n > 0) {
                unsigned char* orow = OGo + (size_t)((b * 64 + n - 1) * 64 + r1) * OG_PITCH;
                if ((4 + h) < OG_NF) {
                    unsigned char* og = orow + (4 + h) * 128 + s1 * 32;
                    unsigned o8[8];
#pragma unroll
                    for (int i = 0; i < 4; ++i) { const v4u t = *(const LAS v4u*)(OGs + r1 * 136 + s1 * 32 + 8 * i);
                        o8[2 * i] = pk4_fp8(bflo(t.x), bfhi(t.x), bflo(t.y), bfhi(t.y)); o8[2 * i + 1] = pk4_fp8(bflo(t.z), bfhi(t.z), bflo(t.w), bfhi(t.w)); }
                    *(v4u*)og = (v4u){o8[0], o8[1], o8[2], o8[3]}; *(v4u*)(og + 16) = (v4u){o8[4], o8[5], o8[6], o8[7]};
                } else {
                    unsigned char* og = orow + OG_NF * 128 + ((4 + h) - OG_NF) * 256 + s1 * 64;
#pragma unroll
                    for (int i = 0; i < 4; ++i) *(v4u*)(og + 16 * i) = *(const LAS v4u*)(OGs + r1 * 136 + s1 * 32 + 8 * i);
                }
            }
            LSYNC();
        }
#undef GD_LOAD
    } else {
        int ln_ = lane0; asm volatile("" : "+v"(ln_)); const int lane = ln_, c = lane & 15, q = lane >> 4;
        f32x4 onw4[2];
#pragma unroll
        for (int j = 0; j < 2; ++j) onw4[j] = *(const f32x4*)(F.gd_onorm_w + 32 * w + 16 * j + 4 * q);
        f32x4 S[2][8];
#pragma unroll
        for (int j = 0; j < 2; ++j)
#pragma unroll
            for (int kt = 0; kt < 8; ++kt) S[j][kt] = (f32x4){0.f, 0.f, 0.f, 0.f};
        for (int n = 0; n <= NCH; ++n) {
            LSYNC();
            if (n == NCH) { LSYNC(); break; }
            const float gend = PS[1024];
            f32x4 vacc[2][4], oacc[2][4];
            bf16x8 fr[2][4], p0, p1;
#define GD_LD(buf, g) do { if ((g) < 8) { const LAS bf16* bs_ = (((g) & 1) ? QG : W) + ((g) >> 1) * 32; _Pragma("unroll") for (int i_ = 0; i_ < 4; ++i_) buf[i_] = ldfragP(bs_ + i_ * 16 * 136, 136, lane); } \
                else { const int sc_ = ((g) - 8) / 3, sub_ = ((g) - 8) % 3; const LAS bf16* bs_ = (sub_ == 0 ? QK : KD + (sub_ - 1) * 4 * 16 * 72) + sc_ * 32; \
                    _Pragma("unroll") for (int i_ = 0; i_ < 4; ++i_) buf[i_] = ldfragP(bs_ + i_ * 16 * 72, 72, lane); } } while (0)
#define GD_MM(buf, g) do { if ((g) < 8) { if (((g) & 1) == 0) { p0 = accpair(S[0][(g)], S[0][(g) + 1]); p1 = accpair(S[1][(g)], S[1][(g) + 1]); \
                        _Pragma("unroll") for (int i_ = 0; i_ < 4; ++i_) { vacc[0][i_] = MFMA16(buf[i_], p0, vacc[0][i_]); vacc[1][i_] = MFMA16(buf[i_], p1, vacc[1][i_]); } } \
                    else { _Pragma("unroll") for (int i_ = 0; i_ < 4; ++i_) { oacc[0][i_] = MFMA16(p0, buf[i_], oacc[0][i_]); oacc[1][i_] = MFMA16(p1, buf[i_], oacc[1][i_]); } } } \
                else { const int sc_ = ((g) - 8) / 3, sub_ = ((g) - 8) % 3; \
                    if (sub_ == 0) { p0 = accpair_neg(vacc[0][2 * sc_], vacc[0][2 * sc_ + 1]); p1 = accpair_neg(vacc[1][2 * sc_], vacc[1][2 * sc_ + 1]); \
                        _Pragma("unroll") for (int i_ = 0; i_ < 4; ++i_) { oacc[0][i_] = MFMA16(p0, buf[i_], oacc[0][i_]); oacc[1][i_] = MFMA16(p1, buf[i_], oacc[1][i_]); } } \
                    else { _Pragma("unroll") for (int i_ = 0; i_ < 4; ++i_) { S[0][(sub_ - 1) * 4 + i_] = MFMA16(buf[i_], p0, S[0][(sub_ - 1) * 4 + i_]); S[1][(sub_ - 1) * 4 + i_] = MFMA16(buf[i_], p1, S[1][(sub_ - 1) * 4 + i_]); } } } } while (0)
#define GD_STEP(g) do { if ((g) + 1 < 14) GD_LD(fr[((g) + 1) & 1], (g) + 1); __builtin_amdgcn_sched_barrier(0); GD_MM(fr[(g) & 1], g); __builtin_amdgcn_sched_barrier(0); } while (0)
            GD_LD(fr[0], 0);
#pragma unroll
            for (int j = 0; j < 2; ++j)
#pragma unroll
                for (int tt = 0; tt < 4; ++tt) { vacc[j][tt] = -ld4bf(UT + (32 * w + 16 * j + c) * 72 + tt * 16 + 4 * q); oacc[j][tt] = (f32x4){0.f, 0.f, 0.f, 0.f}; }
            GD_STEP(0); GD_STEP(1); GD_STEP(2); GD_STEP(3); GD_STEP(4); GD_STEP(5); GD_STEP(6); GD_STEP(7);
#pragma unroll
            for (int j = 0; j < 2; ++j)
#pragma unroll
                for (int kt = 0; kt < 8; ++kt) S[j][kt] = S[j][kt] * gend;
            GD_STEP(8); GD_STEP(9); GD_STEP(10); GD_STEP(11); GD_STEP(12); GD_STEP(13);
#undef GD_LD
#undef GD_MM
#undef GD_STEP
            f32x4 g4[2][4];
#pragma unroll
            for (int j = 0; j < 2; ++j)
#pragma unroll
                for (int tt = 0; tt < 4; ++tt) g4[j][tt] = ld4bf(Gs + (tt * 16 + c) * 136 + 32 * w + 16 * j + 4 * q);
#pragma unroll
            for (int tt = 0; tt < 4; ++tt) { const f32x4 o0 = oacc[0][tt], o1 = oacc[1][tt];
                const float p = qsum(((o0[0] * o0[0] + o0[1] * o0[1]) + (o0[2] * o0[2] + o0[3] * o0[3])) + ((o1[0] * o1[0] + o1[1] * o1[1]) + (o1[2] * o1[2] + o1[3] * o1[3])));
                if (q == 0) PS[(tt * 16 + c) * 4 + w] = p; }
            LSYNC();
#pragma unroll
            for (int tt = 0; tt < 4; ++tt) { const f32x4 pa4 = *(const LAS f32x4*)(PS + (tt * 16 + c) * 4);
                const float rstd = frsq(((pa4.x + pa4.y) + (pa4.z + pa4.w)) * (1.f / 128.f) + EPS);
#pragma unroll
                for (int j = 0; j < 2; ++j) { const f32x4 o = oacc[j][tt] * onw4[j] * rstd; const f32x4 g = g4[j][tt];
                    *(LAS v2u*)(OGs + (tt * 16 + c) * 136 + 32 * w + 16 * j + 4 * q) = (v2u){pk2(o[0] * silu(g[0]), o[1] * silu(g[1])), pk2(o[2] * silu(g[2]), o[3] * silu(g[3]))}; } }
        }
    }
    LSYNC();
}

DI void convert_experts(Frame& F) {
    LAS float* scr = (LAS float*)(F.lds + F.wave * 16384);
    unsigned char* WGU = F.ws + WS_WGU; unsigned char* WD = F.ws + WS_WD;
    for (;;) {
        int base = 0;
        if (F.lane == 0) base = (int)__hip_atomic_fetch_add(F.ctl + CW_WORK, 4u, __ATOMIC_RELAXED, __HIP_MEMORY_SCOPE_AGENT);
        base = __builtin_amdgcn_readfirstlane(base);
        if (base >= NE * 384) break;
        for (int it = base; it < base + 4; ++it) { const int e = it / 384, r = it % 384;
            if (r < 256) { const int up = r >> 7, sub = r & 127, nb = sub & 7, n0 = 32 * nb; const int row_off = 256 * (n0 >> 7) + (n0 & 127) - n0 + 128 * up;
                transpose_item8((up ? F.w_up : F.w_gate) + (size_t)e * 1024 * 256, 1024, 256, 8, WGU + (size_t)e * 512 * 1024, row_off, 32.f, F.norm_moe_w, scr, sub, F.lane); }
            else transpose_item8(F.w_down + (size_t)e * 256 * 1024, 256, 1024, 32, WD + (size_t)e * 1024 * 256, 0, 16.f, nullptr, scr, r - 256, F.lane);
        }
    }
}

DI void warm_and_convert(Frame& F, int cid) {
    LAS float* scr = (LAS float*)(F.lds + F.wave * 16384);
    unsigned char* WGU = F.ws + WS_WGU; unsigned char* WD = F.ws + WS_WD;
    const bool gd = cid >= 64; const int bh = gd ? cid - 64 : cid, b = bh >> 2, h = bh & 3;
    unsigned* prog = F.ctl + CW_PROG + 64 * cid;
    int n = 0; bool convleft = true; unsigned spins = 0;
    while (n < NCH || convleft) {
        const int pr = __builtin_amdgcn_readfirstlane((int)__hip_atomic_load(prog, __ATOMIC_RELAXED, __HIP_MEMORY_SCOPE_AGENT));
        if (n < NCH && n <= pr + 1) {
            const int bn = b * 64 + n, item = bn * 4 + h;
#pragma unroll
            for (int pass = 0; pass < 2; ++pass) { const int L = pass * 512 + F.wave * 64 + F.lane; size_t addr = 0; bool ok = true;
                if (gd) { if (L < 512) addr = WS_R3 + (size_t)(L >> 7) * 64 * MiB + (size_t)item * 16384 + (L & 127) * 128;
                          else if (L < 640) addr = WS_R2 + prb(bn, 28 + h) * 2 + (size_t)(L - 512) * 128;
                          else if (L < 704) addr = WS_R1 + ((size_t)(bn * 64 + (L - 640)) * D + 512 + h * 128) * 2;
                          else ok = false; }
                else    { if (L < 512) addr = WS_R2 + prb(bn, h + 4 * (L >> 7)) * 2 + (size_t)(L & 127) * 128;
                          else if (L < 640) addr = WS_R1 + ((size_t)(bn * 64 + ((L - 512) >> 1)) * D + h * 128) * 2 + ((L - 512) & 1) * 128;
                          else if (L < 644) addr = WS_DLAST + (size_t)item * 512 + (size_t)(L - 640) * 128;
                          else ok = false; }
                if (ok) { const unsigned v = *(const unsigned*)(F.ws + addr); asm volatile("" :: "v"(v)); } }
            ++n; spins = 0; continue;
        }
        if (convleft) {
            int base = 0;
            if (F.lane == 0) base = (int)__hip_atomic_fetch_add(F.ctl + CW_WORK, 4u, __ATOMIC_RELAXED, __HIP_MEMORY_SCOPE_AGENT);
            base = __builtin_amdgcn_readfirstlane(base);
            if (base >= NE * 384) { convleft = false; continue; }
            for (int it = base; it < base + 4; ++it) { const int e = it / 384, r = it % 384;
                if (r < 256) { const int up = r >> 7, sub = r & 127, nb = sub & 7, n0 = 32 * nb; const int row_off = 256 * (n0 >> 7) + (n0 & 127) - n0 + 128 * up;
                    transpose_item8((up ? F.w_up : F.w_gate) + (size_t)e * 1024 * 256, 1024, 256, 8, WGU + (size_t)e * 512 * 1024, row_off, 32.f, F.norm_moe_w, scr, sub, F.lane); }
                else transpose_item8(F.w_down + (size_t)e * 256 * 1024, 256, 1024, 32, WD + (size_t)e * 1024 * 256, 0, 16.f, nullptr, scr, r - 256, F.lane); }
            continue;
        }
        __builtin_amdgcn_s_sleep(8); if (++spins > (1u << 16)) n = NCH;
    }
}

struct MoeOrder {
    static constexpr bool GATHER = true;
    const LAS int* tab; const LAS int* cnt; const int* rowtok; int ntiles, nN, G, c; size_t bstride;
    DI bool next(int i, pg8::Unit& u) const {
        const long L = (long)i * G + c; if (L >= (long)ntiles * nN) return false;
        const int tile = (int)(L / nN); const int v = tab[tile];
        u.pm = tile; u.pn = (int)(L % nN); u.e = v & 255; u.j = v >> 8; return true;
    }
    DI const char* a_tile(const pg8::Gemm& g, const pg8::Unit&) const { return (const char*)g.A; }
    DI const char* b_tile(const pg8::Gemm& g, const pg8::Unit& u) const { return (const char*)g.Bt + (size_t)u.e * bstride + (size_t)u.pn * (size_t)pg8::BM * g.K * 2; }
    DI int row_of(const pg8::Unit& u, int r) const { int slot = u.j * 256 + r; const int m = cnt[u.e] - 1; slot = slot < m ? slot : m; return rowtok[u.e * 65536 + slot] >> 1; }
};
struct MoeOrder2 : MoeOrder {
    static constexpr bool GATHER = false;
    DI const char* a_tile(const pg8::Gemm& g, const pg8::Unit& u) const { return (const char*)g.A + (size_t)u.pm * (size_t)pg8::BM * g.K * 2; }
};
DI int moe_build_table(Frame& F) {
    LAS int* tab = (LAS int*)(F.lds + TILETAB_OFF); LAS int* cnt = (LAS int*)(F.lds + CNT_OFF); volatile LAS int* misc = (volatile LAS int*)(F.lds + MISC_OFF);
    if (F.tid < 64) cnt[F.tid] = (int)__hip_atomic_load(F.ctl + CW_CNT + F.tid, __ATOMIC_RELAXED, __HIP_MEMORY_SCOPE_AGENT);
    __syncthreads();
    if (F.tid == 0) { int nt = 0; for (int e = 0; e < NE; ++e) { const int k = (cnt[e] + 255) >> 8; for (int j = 0; j < k; ++j) tab[nt++] = e | (j << 8); } misc[16] = nt; }
    __syncthreads();
    return misc[16];
}

struct OneUnit : pg8::StaticOrder {
    int pm1;
    DI bool next(int i, pg8::Unit& u) const { if (i > 0) return false; u.pm = pm1; u.pn = 0; u.e = 0; u.j = 0; return true; }
};
DI void route_panel(Frame& F, int t0) {
    LAS int* hist = (LAS int*)F.lds; LAS int* base = hist + 64;
    const float* LOG = (const float*)(F.ws + WS_LOGITS); int* ROWTOK = (int*)(F.ws + WS_ROWTOK); float* ROWGATE = (float*)(F.ws + WS_ROWGATE);
    {
        const bool act = F.tid < 256;
        if (F.tid < 64) hist[F.tid] = 0;
        __syncthreads();
        const int tok = t0 + (F.tid & 255); const float* L = LOG + (size_t)tok * 256;
        const f32x4 ga = *(const f32x4*)L, gb = *(const f32x4*)(L + 4);
        float rr; { const f32x4* sp = (const f32x4*)((const float*)(F.ws + WS_SSQ) + (size_t)tok * 16); const f32x4 a = sp[0], b = sp[1], c = sp[2], d = sp[3];
            rr = frsq(((a.x + a.y + a.z + a.w) + (b.x + b.y + b.z + b.w) + (c.x + c.y + c.z + c.w) + (d.x + d.y + d.z + d.w)) * (1.f / D) + EPS); }
        const float g[8] = {ga.x * rr, ga.y * rr, ga.z * rr, ga.w * rr, gb.x * rr, gb.y * rr, gb.z * rr, gb.w * rr};
        int gi = 0; float gm = g[0];
#pragma unroll
        for (int j = 1; j < 8; ++j) if (g[j] > gm) { gm = g[j]; gi = j; }
        float den = 0.f;
#pragma unroll
        for (int j = 0; j < 8; ++j) den += expf(g[j] - gm);
        const float pg = 1.f / den;
        const f32x4 ea = *(const f32x4*)(L + 8 + gi * 8), eb = *(const f32x4*)(L + 12 + gi * 8);
        const float e[8] = {ea.x * rr, ea.y * rr, ea.z * rr, ea.w * rr, eb.x * rr, eb.y * rr, eb.z * rr, eb.w * rr};
        int i1 = 0; float v1 = e[0];
#pragma unroll
        for (int j = 1; j < 8; ++j) if (e[j] > v1) { v1 = e[j]; i1 = j; }
        int i2 = -1; float v2 = -3.0e38f;
#pragma unroll
        for (int j = 0; j < 8; ++j) if (j != i1 && e[j] > v2) { v2 = e[j]; i2 = j; }
        const float ex = expf(v2 - v1), p1 = 1.f / (1.f + ex), p2 = ex / (1.f + ex);
        const int e1 = gi * 8 + i1, e2 = gi * 8 + i2;
        int l1 = 0, l2 = 0;
        if (act) { l1 = __hip_atomic_fetch_add(&hist[e1], 1, __ATOMIC_RELAXED, __HIP_MEMORY_SCOPE_WORKGROUP); l2 = __hip_atomic_fetch_add(&hist[e2], 1, __ATOMIC_RELAXED, __HIP_MEMORY_SCOPE_WORKGROUP); }
        __syncthreads();
        if (F.tid < 64) base[F.tid] = (int)__hip_atomic_fetch_add(F.ctl + CW_CNT + F.tid, (unsigned)hist[F.tid], __ATOMIC_RELAXED, __HIP_MEMORY_SCOPE_AGENT);
        __syncthreads();
        const int s1 = base[e1] + l1, s2 = base[e2] + l2;
        float* ROWSCALE = (float*)(F.ws + WS_ROWSCALE);
        if (act) { ROWTOK[e1 * 65536 + s1] = tok * 2; ROWGATE[e1 * 65536 + s1] = p1 * pg; ROWSCALE[e1 * 65536 + s1] = rr;
            ROWTOK[e2 * 65536 + s2] = tok * 2 + 1; ROWGATE[e2 * 65536 + s2] = p2 * pg; ROWSCALE[e2 * 65536 + s2] = rr; }
        __syncthreads();
    }
}

constexpr int NPHASE = 11;
struct Args { const float* in[17]; float* out; unsigned char* ws; int ph_lo, ph_hi; };
__global__ void __launch_bounds__(NTHR, 2) fwd_kernel(Args args) {
    extern __shared__ __attribute__((aligned(16))) unsigned char lds_raw[];
    Frame F;
    F.lds = (LAS unsigned char*)lds_raw;
    F.tid = threadIdx.x; F.lane = F.tid & 63; F.wave = __builtin_amdgcn_readfirstlane(F.tid >> 6);
    F.G = gridDim.x; { const int bx = blockIdx.x; F.vcu = (F.G % 8 == 0) ? (bx % 8) * (F.G / 8) + bx / 8 : bx; }
    F.ws = args.ws; F.ctl = (unsigned*)(args.ws + WS_CTL); F.out = args.out;
    F.x = args.in[0]; F.norm_mix_w = args.in[1]; F.w_in = args.in[2]; F.lb_logits = args.in[3]; F.hg_onorm_w = args.in[4]; F.conv_w = args.in[5]; F.a_log = args.in[6];
    F.dt_bias = args.in[7]; F.gd_onorm_w = args.in[8]; F.w_out = args.in[9]; F.norm_moe_w = args.in[10]; F.wr_group = args.in[11]; F.wr_expert = args.in[12];
    F.w_gate = args.in[13]; F.w_up = args.in[14]; F.w_down = args.in[15]; F.final_w = args.in[16];
    volatile LAS unsigned* MISC = (volatile LAS unsigned*)(F.lds + MISC_OFF);
    if (F.tid < 64) MISC[F.tid] = 0u;
    __syncthreads();
    const int lo = args.ph_lo, hi = args.ph_hi;
    const bool one = (hi - lo) > 1;
    XcdBarrier bar; bar.bar = F.ctl + CW_BAR; bar.x = 0; bar.st = nullptr;
    if (one) bar = xcd_barrier_post(F.ctl + CW_BAR, MISC + 8);
#ifdef ONLY_PHASE
#define IN(k) ((k) == ONLY_PHASE && lo <= (k) && (k) < hi)
#else
#define IN(k) (lo <= (k) && (k) < hi)
#endif
#define SEAM(k) do { if (IN(k) && IN((k) + 1)) xcd_barrier(bar); } while (0)
    const int gw = F.vcu * NWAVES + F.wave, NGW = F.G * NWAVES;

    if (IN(0)) { for (int rep = 0; rep < REPS(0); ++rep) p0_prologue(F); }
    SEAM(0);
    if (IN(1)) {
        pg8::Gemm g{(const bf16*)F.out, (const bf16*)(F.ws + WS_WIN), T, NP, D}; pg8::StaticOrder S; S.init(T, NP, F.G, (int)blockIdx.x);
        pg8::EpiProjBlocked E{(bf16*)(F.ws + WS_R2)};
        for (int rep = 0; rep < REPS(1); ++rep) pg8::gemm_phase(F.lds, g, S, E);
    }
    SEAM(1);
    if (IN(2)) {
        for (int rep = 0; rep < REPS(2); ++rep) { v4u raw[11]; f32x4 cw[4][2]; float pab[2] = {0.f, 0.f};
            if (F.wave < 6 && F.vcu < 4096) gd_raw_load(F, F.vcu, raw, cw);
            if (F.wave == 6 && F.vcu < 4096) { const int tok = (F.vcu >> 2) * 64 + F.lane; pab[0] = ((const float*)(F.ws + WS_AB))[(size_t)tok * 8 + (F.vcu & 3)]; pab[1] = ((const float*)(F.ws + WS_AB))[(size_t)tok * 8 + 4 + (F.vcu & 3)]; }
            for (int it = F.vcu; it < 4096; it += F.G) gd_pre_item(F, it, raw, cw, pab, it + F.G < 4096 ? it + F.G : -1); }
        { unsigned nq[16], nf[16], ni[16]; float nlb = 0.f;
          if (F.vcu < 4096) hg_raw_load(F, F.vcu, nq, nf, ni, nlb);
          for (int it = F.vcu; it < 4096; it += F.G) hg_pre_item(F, it, (bf16*)(F.ws + WS_R2), NP, (bf16*)(F.ws + WS_R1), (float*)(F.ws + WS_DLAST), nq, nf, ni, nlb, it + F.G < 4096 ? it + F.G : -1); }
    }
    SEAM(2);
    if (IN(3)) {
        const int bx = blockIdx.x;
        unsigned char* OG8 = (unsigned char*)F.out + 128 * MiB;
        if (F.G == 256) {
            const int idx = (bx >> 4) * 8 + (bx & 7);
            if (((bx >> 3) & 1) == 0) {
                if (PROBE_PH == 22) { if (idx < 64) hg_chain<0>(F, idx >> 2, idx & 3, (unsigned char*)F.out + 192 * MiB, F.ctl + CW_PROG + 64 * 200); else gd_chain<0>(F, (idx - 64) >> 2, idx & 3, (unsigned char*)F.out + 192 * MiB, F.ctl + CW_PROG + 64 * 200); }
                if (PROBE_PH == 25) { if (idx < 64) hg_chain<0>(F, idx >> 2, idx & 3, (unsigned char*)F.out + 192 * MiB, F.ctl + CW_PROG + 64 * 200); }
                if (PROBE_PH == 26) { if (idx >= 64) gd_chain<0>(F, (idx - 64) >> 2, idx & 3, (unsigned char*)F.out + 192 * MiB, F.ctl + CW_PROG + 64 * 200); }
                if (PROBE_PH == 24) { if (idx < 64) hg_chain<2>(F, idx >> 2, idx & 3, (unsigned char*)F.out + 192 * MiB, F.ctl + CW_PROG + 64 * 200); else gd_chain<2>(F, (idx - 64) >> 2, idx & 3, (unsigned char*)F.out + 192 * MiB, F.ctl + CW_PROG + 64 * 200); }
                if (PROBE_PH == 23) { if (idx < 64) hg_chain<1>(F, idx >> 2, idx & 3, (unsigned char*)F.out + 192 * MiB, F.ctl + CW_PROG + 64 * 200); else gd_chain<1>(F, (idx - 64) >> 2, idx & 3, (unsigned char*)F.out + 192 * MiB, F.ctl + CW_PROG + 64 * 200); }
                if (idx < 64) hg_chain<0>(F, idx >> 2, idx & 3, OG8, F.ctl + CW_PROG + 64 * idx); else gd_chain<0>(F, (idx - 64) >> 2, idx & 3, OG8, F.ctl + CW_PROG + 64 * idx); }
            else warm_and_convert(F, idx);
        } else {
            for (int cid = bx; cid < 128; cid += F.G) { if (cid < 64) hg_chain<0>(F, cid >> 2, cid & 3, OG8, F.ctl + CW_PROG + 64 * cid); else gd_chain<0>(F, (cid - 64) >> 2, cid & 3, OG8, F.ctl + CW_PROG + 64 * cid); }
        }
        convert_experts(F);
    }
    SEAM(3);
    if (IN(4)) {
        pg8::Gemm g{(const bf16*)((const unsigned char*)F.out + 128 * MiB), (const bf16*)(F.ws + WS_WOUT), T, D, OG_PITCH / 2}; pg8::StaticOrder S; S.init(T, D, F.G, (int)blockIdx.x);
        pg8::EpiRes3<OG_NF> E{(bf16*)(F.ws + WS_HB), F.ws + WS_XN8, (float*)(F.ws + WS_SSQ), (const bf16*)F.out, (const float*)(F.ws + WS_RXI), F.norm_mix_w};
        for (int rep = 0; rep < REPS(4); ++rep) pg8::gemm_phase(F.lds, g, S, E);
    }
    SEAM(4);
    if (IN(5)) {
        const bf16* HB = (const bf16*)(F.ws + WS_HB);
        for (int panel = F.vcu; panel < T / 256; panel += F.G) {
            { pg8::Gemm g{HB, (const bf16*)(F.ws + WS_WR), T, 256, D}; OneUnit S; S.init(T, 256, F.G, 0); S.pm1 = panel;
              pg8::EpiF32 E{(float*)(F.ws + WS_LOGITS), 256, nullptr};
              for (int rep = 0; rep < REPS(6); ++rep) pg8::gemm_phase(F.lds, g, S, E); }
            VM_WAIT(); __syncthreads();
            route_panel(F, panel * 256);
        }
    }
    SEAM(7);
    if (IN(8)) {
        const int nt = moe_build_table(F);
        MoeOrder S; S.tab = (const LAS int*)(F.lds + TILETAB_OFF); S.cnt = (const LAS int*)(F.lds + CNT_OFF); S.rowtok = (const int*)(F.ws + WS_ROWTOK);
        S.ntiles = nt; S.nN = 2; S.G = F.G; S.c = F.vcu; S.bstride = (size_t)512 * 1024;
        pg8::Gemm g{(const bf16*)(F.ws + WS_XN8), (const bf16*)(F.ws + WS_WGU), T, 512, D / 2};
        pg8::EpiSwiGLU8 E{F.ws + WS_H, (const float*)(F.ws + WS_ROWSCALE)};
        for (int rep = 0; rep < REPS(8); ++rep) pg8::gemm_phase(F.lds, g, S, E);
    }
    SEAM(8);
    if (IN(9)) {
        const int nt = moe_build_table(F);
        MoeOrder2 S; S.tab = (const LAS int*)(F.lds + TILETAB_OFF); S.cnt = (const LAS int*)(F.lds + CNT_OFF); S.rowtok = (const int*)(F.ws + WS_ROWTOK);
        S.ntiles = nt; S.nN = 4; S.G = F.G; S.c = F.vcu; S.bstride = (size_t)1024 * 256;
        pg8::Gemm g{(const bf16*)(F.ws + WS_H), (const bf16*)(F.ws + WS_WD), MAXTILES * 256, 1024, 128};
        pg8::EpiScatter8 E{F.ws + WS_Y2, (const int*)(F.ws + WS_ROWTOK), (const float*)(F.ws + WS_ROWGATE), (const LAS int*)(F.lds + CNT_OFF)};
        for (int rep = 0; rep < REPS(9); ++rep) pg8::gemm_phase(F.lds, g, S, E);
    }
    SEAM(9);
    if (IN(10)) {
        float wn[16];
#pragma unroll
        for (int j = 0; j < 4; ++j) { const f32x4 t = *(const f32x4*)(F.final_w + 4 * F.lane + 256 * j); wn[4 * j] = t.x; wn[4 * j + 1] = t.y; wn[4 * j + 2] = t.z; wn[4 * j + 3] = t.w; }
        const unsigned char* Y2 = F.ws + WS_Y2;
        v2u nh[4]; unsigned na[4], nb[4];
#define P7_LOAD(m_) do { const v2u* hr_ = (const v2u*)((const bf16*)(F.ws + WS_HB) + (size_t)(m_) * D) + F.lane; const unsigned* y0_ = (const unsigned*)(Y2 + (size_t)(2 * (m_)) * D) + F.lane; const unsigned* y1_ = (const unsigned*)(Y2 + (size_t)(2 * (m_) + 1) * D) + F.lane; \
            _Pragma("unroll") for (int j_ = 0; j_ < 4; ++j_) { nh[j_] = hr_[64 * j_]; na[j_] = y0_[64 * j_]; nb[j_] = y1_[64 * j_]; } } while (0)
        if (gw < T) P7_LOAD(gw);
        for (int m = gw; m < T; m += NGW) {
            f32x4* xr = (f32x4*)(F.out + (size_t)m * D) + F.lane;
            v2u ch[4]; unsigned ca[4], cb[4];
#pragma unroll
            for (int j = 0; j < 4; ++j) { ch[j] = nh[j]; ca[j] = na[j]; cb[j] = nb[j]; }
            if (m + NGW < T) P7_LOAD(m + NGW);
            float v[16]; float s = 0.f;
#pragma unroll
            for (int j = 0; j < 4; ++j) { const v2u t = ch[j];
                const auto a0 = __builtin_amdgcn_cvt_pk_f32_fp8((int)ca[j], false), a1 = __builtin_amdgcn_cvt_pk_f32_fp8((int)ca[j], true), b0 = __builtin_amdgcn_cvt_pk_f32_fp8((int)cb[j], false), b1 = __builtin_amdgcn_cvt_pk_f32_fp8((int)cb[j], true);
                v[4 * j] = bflo(t.x) + (a0[0] + b0[0]) * 0.03125f; v[4 * j + 1] = bfhi(t.x) + (a0[1] + b0[1]) * 0.03125f; v[4 * j + 2] = bflo(t.y) + (a1[0] + b1[0]) * 0.03125f; v[4 * j + 3] = bfhi(t.y) + (a1[1] + b1[1]) * 0.03125f; }
#pragma unroll
            for (int i = 0; i < 16; ++i) s += v[i] * v[i];
            const float r = frsq(wave_sum(s) * (1.f / D) + EPS);
#pragma unroll
            for (int j = 0; j < 4; ++j) xr[64 * j] = (f32x4){v[4 * j] * r * wn[4 * j], v[4 * j + 1] * r * wn[4 * j + 1], v[4 * j + 2] * r * wn[4 * j + 2], v[4 * j + 3] * r * wn[4 * j + 3]};
        }
    }
#undef IN
#undef SEAM
}

extern "C" void kernel_launch(void* const* d_in, const int* in_sizes, int n_in, void* d_out, int out_size, void* d_ws, size_t ws_size, hipStream_t stream) {
    static int grid = 0;
    if (grid == 0) {
        if (n_in != 17 || in_sizes[0] != T * D || out_size != T * D || ws_size < WS_END) {
            fprintf(stderr, "kernel_launch: unexpected shapes: n_in %d in0 %d out %d ws %zu (need %zu)\n", n_in, n_in > 0 ? in_sizes[0] : -1, out_size, ws_size, (size_t)WS_END); grid = -1; return; }
        int dev = 0, cus = 0, per_cu = 0;
        if (hipGetDevice(&dev) != hipSuccess || hipDeviceGetAttribute(&cus, hipDeviceAttributeMultiprocessorCount, dev) != hipSuccess) { grid = -1; return; }
        if (hipFuncSetAttribute((const void*)fwd_kernel, hipFuncAttributeMaxDynamicSharedMemorySize, LDS_BYTES) != hipSuccess) { fprintf(stderr, "kernel_launch: hipFuncSetAttribute failed\n"); grid = -1; return; }
        if (hipOccupancyMaxActiveBlocksPerMultiprocessor(&per_cu, (const void*)fwd_kernel, NTHR, LDS_BYTES) != hipSuccess || per_cu < 1) { fprintf(stderr, "kernel_launch: occupancy query says %d\n", per_cu); }
        (void)hipGetLastError();
        grid = cus;
    }
    if (grid < 0) return;
    if (hipMemsetAsync((char*)d_ws + WS_CTL, 0, CTL_ZERO_BYTES, stream) != hipSuccess) return;
    Args a{};
    for (int i = 0; i < 17; ++i) a.in[i] = (const float*)d_in[i];
    a.out = (float*)d_out; a.ws = (unsigned char*)d_ws;
#if MK_PER_PHASE
    for (int ph = 0; ph < NPHASE; ++ph) { a.ph_lo = ph; a.ph_hi = ph + 1; hipLaunchKernelGGL(fwd_kernel, dim3(grid), dim3(NTHR), LDS_BYTES, stream, a); }
#else
    a.ph_lo = 0; a.ph_hi = NPHASE; hipLaunchKernelGGL(fwd_kernel, dim3(grid), dim3(NTHR), LDS_BYTES, stream, a);
#endif
}
```

```cpp
#include <hip/hip_runtime.h>
#include <cstdio>
#include <cstdint>

#ifndef MK_PER_PHASE
#define MK_PER_PHASE 0
#endif

#ifndef PROBE_PH
#define PROBE_PH -1
#endif
#define REPS(k) ((PROBE_PH == (k)) ? 2 : 1)
#define DI __device__ __forceinline__
#define GAS __attribute__((address_space(1)))
#define LAS __attribute__((address_space(3)))
typedef unsigned short bf16;
typedef unsigned v4u __attribute__((ext_vector_type(4)));
typedef unsigned v2u __attribute__((ext_vector_type(2)));
typedef float f32x4 __attribute__((ext_vector_type(4)));
typedef float f32x2 __attribute__((ext_vector_type(2)));
typedef short bf16x8 __attribute__((ext_vector_type(8)));

constexpr int T = 65536, D = 1024, SEQ = 4096, NB = 16, NCH = 64  , CH = 64;
constexpr int NP = 4096;
constexpr int INC = 4104;
constexpr int NE = 64, FF = 256, MAXTILES = 576;
constexpr int OG_NF = 8;
constexpr int OG_PITCH = OG_NF * 128 + (8 - OG_NF) * 256;
constexpr float EPS = 1e-6f;
constexpr int NWAVES = 8, NTHR = 512;

constexpr size_t MiB = 1u << 20;
constexpr size_t WS_CTL = 0, CTL_ZERO_BYTES = 1 * MiB;
constexpr size_t WS_WIN = 2 * MiB;
constexpr size_t WS_WOUT = 10 * MiB;
constexpr size_t WS_WR = 12 * MiB;
constexpr size_t WS_AB = 13 * MiB;
constexpr size_t WS_DLAST = 15 * MiB;
constexpr size_t WS_GEND = 17 * MiB;
constexpr size_t WS_LB = 18 * MiB;
constexpr size_t WS_R1 = 20 * MiB;
constexpr size_t WS_R2 = 148 * MiB;
constexpr size_t WS_LOGITS = WS_R2;
constexpr size_t WS_H = WS_R2 + 64 * MiB;
constexpr size_t WS_Y2 = WS_R2 + 140 * MiB;
constexpr size_t WS_RXI = 948 * MiB;
constexpr size_t WS_SSQ = WS_R2 + 270 * MiB;
constexpr size_t WS_XN8 = WS_R2 + 396 * MiB;
constexpr size_t WS_R3 = 660 * MiB;
constexpr size_t WS_GW = WS_R3, WS_GU = WS_R3 + 64 * MiB, WS_GQG = WS_R3 + 128 * MiB, WS_GKD = WS_R3 + 192 * MiB;
constexpr size_t WS_ROWTOK = WS_R3;
constexpr size_t WS_ROWGATE = WS_R3 + 16 * MiB;
constexpr size_t WS_ROWSCALE = WS_R3 + 32 * MiB;
constexpr size_t WS_HB = WS_R3 + 64 * MiB;
constexpr size_t WS_WGU = 916 * MiB;
constexpr size_t WS_WD = 980 * MiB;
constexpr size_t WS_END = 1012 * MiB;
constexpr int CW_BAR = 4096;
constexpr int CW_CNT = 16384;
constexpr int CW_PROG = 49152;
constexpr int CW_WORK = 16512;

constexpr int LDS_BYTES = 147456;
constexpr int MISC_OFF = 131072;
constexpr int TILETAB_OFF = MISC_OFF + 256;
constexpr int CNT_OFF = TILETAB_OFF + MAXTILES * 4;

typedef __bf16 hbf2 __attribute__((ext_vector_type(2)));
DI unsigned pk2(float lo, float hi) { return __builtin_bit_cast(unsigned, __builtin_convertvector((f32x2){lo, hi}, hbf2)); }
DI unsigned f2bf(float f) { return pk2(f, 0.f) & 0xffffu; }
DI float bf2f(unsigned b) { return __builtin_bit_cast(float, b << 16); }
DI float bflo(unsigned w) { return __builtin_bit_cast(float, w << 16); }
DI float bfhi(unsigned w) { return __builtin_bit_cast(float, w & 0xffff0000u); }
DI unsigned pk4_fp8(float a, float b, float c, float d) { int p = 0; p = __builtin_amdgcn_cvt_pk_fp8_f32(a, b, p, false); p = __builtin_amdgcn_cvt_pk_fp8_f32(c, d, p, true); return (unsigned)p; }
DI float frcp(float x) { return __builtin_amdgcn_rcpf(x); }
DI float frsq(float x) { return __builtin_amdgcn_rsqf(x); }
DI float sigm(float x) { return frcp(1.f + __expf(-x)); }
DI float silu(float x) { return x * frcp(1.f + __expf(-x)); }
DI float wave_sum(float v) {
    v += __builtin_bit_cast(float, __builtin_amdgcn_mov_dpp(__builtin_bit_cast(int, v), 0xB1, 0xF, 0xF, true));
    v += __builtin_bit_cast(float, __builtin_amdgcn_mov_dpp(__builtin_bit_cast(int, v), 0x4E, 0xF, 0xF, true));
    v += __builtin_bit_cast(float, __builtin_amdgcn_mov_dpp(__builtin_bit_cast(int, v), 0x141, 0xF, 0xF, true));
    v += __builtin_bit_cast(float, __builtin_amdgcn_mov_dpp(__builtin_bit_cast(int, v), 0x140, 0xF, 0xF, true));
    const int b = __builtin_bit_cast(int, v);
    return (__builtin_bit_cast(float, __builtin_amdgcn_readlane(b, 0)) + __builtin_bit_cast(float, __builtin_amdgcn_readlane(b, 16))) +
           (__builtin_bit_cast(float, __builtin_amdgcn_readlane(b, 32)) + __builtin_bit_cast(float, __builtin_amdgcn_readlane(b, 48)));
}
#define LDS_WAIT() asm volatile("s_waitcnt lgkmcnt(0)" ::: "memory")
#define VM_WAIT() asm volatile("s_waitcnt vmcnt(0)" ::: "memory")
#define LSYNC() do { asm volatile("s_waitcnt lgkmcnt(0)" ::: "memory"); __builtin_amdgcn_s_barrier(); asm volatile("" ::: "memory"); } while (0)

namespace pg8 {
#define PG8_LAS __attribute__((address_space(3)))
typedef unsigned short bf16_t;
typedef unsigned u32x4 __attribute__((ext_vector_type(4)));
typedef int v8i __attribute__((ext_vector_type(8)));
typedef int v4i __attribute__((ext_vector_type(4)));
constexpr int BM = 256, BK = 64, HALF = 128, HTB = HALF * BK * 2, STAGE_BYTES = 8 * HTB, NXCD = 8, WGM = 8;

__host__ __device__ __forceinline__ int lds_byte(int r, int c) { const int st = (r >> 4) * 2 + (c >> 5), rr = r & 15, cc = c & 31, ob = rr * 64 + cc * 2; return st * 1024 + (ob ^ (((ob >> 9) & 1) << 5)); }
__host__ __device__ __forceinline__ void stage_rc(int b, int& R, int& C) { const int st = b / 1024, sb = b % 1024, swz = sb ^ (((sb >> 9) & 1) << 5); R = (st >> 1) * 16 + swz / 64; C = (st & 1) * 32 + (swz % 64) / 2; }
__host__ __device__ __forceinline__ int perm32(int rho) { const int n = rho >> 4, i = rho & 15; return 8 * (i >> 2) + 4 * n + (i & 3); }

struct Unit { int pm, pn, e, j; };
struct Gemm { const bf16_t* A; const bf16_t* Bt; int M, N, K; };

struct StaticOrder {
    static constexpr bool GATHER = false;
    int nM, nN, nwg, G, c;
    __host__ __device__ void init(int M, int N, int G_, int c_) { nM = M / BM; nN = N / BM; nwg = nM * nN; G = G_; c = c_; }
    __device__ __forceinline__ bool next(int i, Unit& u) const {
        const long L = (long)i * G + c; if (L >= nwg) return false;
        int wgid = (int)L; { const int q = nwg / NXCD, r = nwg % NXCD, xcd = wgid % NXCD, off = wgid / NXCD; wgid = (xcd < r ? xcd * (q + 1) : r * (q + 1) + (xcd - r) * q) + off; }
        const int nig = WGM * nN, gid = wgid / nig, fm = gid * WGM, gsz = (nM - fm) < WGM ? (nM - fm) : WGM;
        u.pm = fm + ((wgid % nig) % gsz); u.pn = (wgid % nig) / gsz; u.e = 0; u.j = 0; return true;
    }
    __device__ __forceinline__ const char* a_tile(const Gemm& g, const Unit& u) const { return (const char*)g.A + (size_t)u.pm * (size_t)BM * g.K * 2; }
    __device__ __forceinline__ const char* b_tile(const Gemm& g, const Unit& u) const { return (const char*)g.Bt + (size_t)u.pn * (size_t)BM * g.K * 2; }
    __device__ __forceinline__ int row_of(const Unit&, int) const { return 0; }
};

__device__ __forceinline__ unsigned cvt_pk_bf16(float lo, float hi) { unsigned r; asm volatile("v_cvt_pk_bf16_f32 %0, %1, %2" : "=v"(r) : "v"(lo), "v"(hi)); return r; }

struct EpiBf16 {
    static constexpr bool PERM = true, FP8 = false;
    static constexpr int NF8T = -1;
    static constexpr bool HALFN = false;
    static constexpr int NVM = 16;
    __device__ __forceinline__ void pre(PG8_LAS unsigned char*, const Unit&, int, int, int) const {}
    bf16_t* O; int ldc;
    __device__ __forceinline__ void operator()(const f32x4 (&acc)[2][2][4][2], const Unit& u, int wr, int wc, int fr, int fq, PG8_LAS unsigned char* lds, int ui) const {
        const int row0 = u.pm * BM + wr * 64 + fr, col0 = u.pn * BM + wc * 32 + 8 * fq;
#pragma unroll
        for (int ai = 0; ai < 2; ++ai)
#pragma unroll
            for (int m = 0; m < 4; ++m) { bf16_t* rowp = O + (size_t)(row0 + ai * HALF + m * 16) * ldc + col0;
#pragma unroll
                for (int bj = 0; bj < 2; ++bj) { const f32x4 v0 = acc[ai][bj][m][0], v1 = acc[ai][bj][m][1];
                    u32x4 w; w.x = cvt_pk_bf16(v0[0], v0[1]); w.y = cvt_pk_bf16(v0[2], v0[3]); w.z = cvt_pk_bf16(v1[0], v1[1]); w.w = cvt_pk_bf16(v1[2], v1[3]);
                    *(u32x4*)(rowp + bj * HALF) = w; } }
    }
};
struct EpiProjBlocked {
    static constexpr bool PERM = true, FP8 = false;
    static constexpr int NF8T = -1;
    static constexpr bool HALFN = false;
    static constexpr int NVM = 16;
    __device__ __forceinline__ void pre(PG8_LAS unsigned char*, const Unit&, int, int, int) const {}
    bf16_t* O;
    __device__ __forceinline__ void operator()(const f32x4 (&acc)[2][2][4][2], const Unit& u, int wr, int wc, int fr, int fq, PG8_LAS unsigned char* lds, int ui) const {
        const bool gate = (u.pn & 6) == 6;
#pragma unroll
        for (int ai = 0; ai < 2; ++ai)
#pragma unroll
            for (int m = 0; m < 4; ++m) { const int chunk = u.pm * 4 + ai * 2 + wr;
#pragma unroll
                for (int bj = 0; bj < 2; ++bj) { f32x4 v0 = acc[ai][bj][m][0], v1 = acc[ai][bj][m][1];
                    if (gate) {
#pragma unroll
                        for (int e = 0; e < 4; ++e) { v0[e] = v0[e] * __builtin_amdgcn_rcpf(1.f + __expf(-v0[e])); v1[e] = v1[e] * __builtin_amdgcn_rcpf(1.f + __expf(-v1[e])); } }
                    u32x4 w; w.x = cvt_pk_bf16(v0[0], v0[1]); w.y = cvt_pk_bf16(v0[2], v0[3]); w.z = cvt_pk_bf16(v1[0], v1[1]); w.w = cvt_pk_bf16(v1[2], v1[3]);
                    __builtin_nontemporal_store(w, (u32x4*)(O + (((size_t)chunk * 32 + u.pn * 2 + bj) * 64 + m * 16 + fr) * 128 + wc * 32 + 8 * fq)); } }
    }
};
struct EpiF32 {
    static constexpr bool PERM = false, FP8 = false;
    static constexpr int NF8T = -1;
    static constexpr bool HALFN = true;
    static constexpr int NVM = 32;
    __device__ __forceinline__ void pre(PG8_LAS unsigned char*, const Unit&, int, int, int) const {}
    float* C; int ldc; const float* R;
    __device__ __forceinline__ void operator()(const f32x4 (&acc)[2][2][4][2], const Unit& u, int wr, int wc, int fr, int fq, PG8_LAS unsigned char* lds, int ui) const {
        const int row0 = u.pm * BM + wr * 64 + fr, col0 = u.pn * BM + wc * 32 + 4 * fq;
#pragma unroll
        for (int ai = 0; ai < 2; ++ai)
#pragma unroll
            for (int m = 0; m < 4; ++m) { const size_t ro = (size_t)(row0 + ai * HALF + m * 16) * ldc + col0;
#pragma unroll
                for (int bj = 0; bj < 1; ++bj)
#pragma unroll
                    for (int n = 0; n < 2; ++n) { f32x4 v = acc[ai][bj][m][n]; if (R) v = v + *(const f32x4*)(R + ro + bj * HALF + n * 16); *(f32x4*)(C + ro + bj * HALF + n * 16) = v; } }
    }
};
struct EpiResBf16 {
    static constexpr bool PERM = true, FP8 = false;
    static constexpr int NF8T = -1;
    static constexpr bool HALFN = false;
    static constexpr int NVM = 16;
    __device__ __forceinline__ void pre(PG8_LAS unsigned char*, const Unit&, int, int, int) const {}
    bf16_t* O; int ldc; const float* R;
    __device__ __forceinline__ void operator()(const f32x4 (&acc)[2][2][4][2], const Unit& u, int wr, int wc, int fr, int fq, PG8_LAS unsigned char* lds, int ui) const {
        const int row0 = u.pm * BM + wr * 64 + fr, col0 = u.pn * BM + wc * 32 + 8 * fq;
#pragma unroll
        for (int ai = 0; ai < 2; ++ai)
#pragma unroll
            for (int m = 0; m < 4; ++m) { const size_t ro = (size_t)(row0 + ai * HALF + m * 16) * ldc + col0;
#pragma unroll
                for (int bj = 0; bj < 2; ++bj) { const f32x4 v0 = acc[ai][bj][m][0] + *(const f32x4*)(R + ro + bj * HALF), v1 = acc[ai][bj][m][1] + *(const f32x4*)(R + ro + bj * HALF + 4);
                    u32x4 w; w.x = cvt_pk_bf16(v0[0], v0[1]); w.y = cvt_pk_bf16(v0[2], v0[3]); w.z = cvt_pk_bf16(v1[0], v1[1]); w.w = cvt_pk_bf16(v1[2], v1[3]);
                    *(u32x4*)(O + ro + bj * HALF) = w; } }
    }
};
template <int NF8T_>
struct EpiRes3 {
    static constexpr bool HALFN = false;
    static constexpr bool PERM = true, FP8 = false; static constexpr int NF8T = NF8T_;
    static constexpr int NVM = 32;
    __device__ __forceinline__ void pre(PG8_LAS unsigned char*, const Unit&, int, int, int) const {}
    bf16_t* O; unsigned char* O8; float* SSQ; const bf16_t* HN; const float* RXI; const float* W;
    __device__ __forceinline__ void operator()(const f32x4 (&acc)[2][2][4][2], const Unit& u, int wr, int wc, int fr, int fq, PG8_LAS unsigned char* lds, int ui) const {
        const int row0 = u.pm * BM + wr * 64 + fr, col0 = u.pn * BM + wc * 32 + 8 * fq;
        constexpr float as = 0.03125f;
        float wi[2][8];
#pragma unroll
        for (int bj = 0; bj < 2; ++bj) { const f32x4 a = *(const f32x4*)(W + col0 + bj * HALF), b = *(const f32x4*)(W + col0 + bj * HALF + 4);
            wi[bj][0] = __builtin_amdgcn_rcpf(a.x); wi[bj][1] = __builtin_amdgcn_rcpf(a.y); wi[bj][2] = __builtin_amdgcn_rcpf(a.z); wi[bj][3] = __builtin_amdgcn_rcpf(a.w);
            wi[bj][4] = __builtin_amdgcn_rcpf(b.x); wi[bj][5] = __builtin_amdgcn_rcpf(b.y); wi[bj][6] = __builtin_amdgcn_rcpf(b.z); wi[bj][7] = __builtin_amdgcn_rcpf(b.w); }
#pragma unroll
        for (int ai = 0; ai < 2; ++ai) {
            u32x4 rv[4][2]; float rx[4];
#pragma unroll
            for (int m = 0; m < 4; ++m) { const int row = row0 + ai * HALF + m * 16; rx[m] = RXI[row];
#pragma unroll
                for (int bj = 0; bj < 2; ++bj) rv[m][bj] = *(const u32x4*)(HN + (size_t)row * 1024 + col0 + bj * HALF); }
            __builtin_amdgcn_sched_barrier(0);
#pragma unroll
            for (int m = 0; m < 4; ++m) { const int row = row0 + ai * HALF + m * 16; const size_t ro = (size_t)row * 1024 + col0; float ss = 0.f;
#pragma unroll
                for (int bj = 0; bj < 2; ++bj) { const u32x4 q = rv[m][bj]; f32x4 v0, v1;
                    v0[0] = acc[ai][bj][m][0][0] * as + __uint_as_float(q.x << 16) * rx[m] * wi[bj][0]; v0[1] = acc[ai][bj][m][0][1] * as + __uint_as_float(q.x & 0xffff0000u) * rx[m] * wi[bj][1];
                    v0[2] = acc[ai][bj][m][0][2] * as + __uint_as_float(q.y << 16) * rx[m] * wi[bj][2]; v0[3] = acc[ai][bj][m][0][3] * as + __uint_as_float(q.y & 0xffff0000u) * rx[m] * wi[bj][3];
                    v1[0] = acc[ai][bj][m][1][0] * as + __uint_as_float(q.z << 16) * rx[m] * wi[bj][4]; v1[1] = acc[ai][bj][m][1][1] * as + __uint_as_float(q.z & 0xffff0000u) * rx[m] * wi[bj][5];
                    v1[2] = acc[ai][bj][m][1][2] * as + __uint_as_float(q.w << 16) * rx[m] * wi[bj][6]; v1[3] = acc[ai][bj][m][1][3] * as + __uint_as_float(q.w & 0xffff0000u) * rx[m] * wi[bj][7];
                    u32x4 w; w.x = cvt_pk_bf16(v0[0], v0[1]); w.y = cvt_pk_bf16(v0[2], v0[3]); w.z = cvt_pk_bf16(v1[0], v1[1]); w.w = cvt_pk_bf16(v1[2], v1[3]);
                    *(u32x4*)(O + ro + bj * HALF) = w;
                    int w0 = 0, w1 = 0; w0 = __builtin_amdgcn_cvt_pk_fp8_f32(v0[0], v0[1], w0, false); w0 = __builtin_amdgcn_cvt_pk_fp8_f32(v0[2], v0[3], w0, true); w1 = __builtin_amdgcn_cvt_pk_fp8_f32(v1[0], v1[1], w1, false); w1 = __builtin_amdgcn_cvt_pk_fp8_f32(v1[2], v1[3], w1, true);
                    *(unsigned long long*)(O8 + ro + bj * HALF) = (unsigned long long)(unsigned)w0 | ((unsigned long long)(unsigned)w1 << 32);
                    ss += v0[0] * v0[0] + v0[1] * v0[1] + v0[2] * v0[2] + v0[3] * v0[3] + v1[0] * v1[0] + v1[1] * v1[1] + v1[2] * v1[2] + v1[3] * v1[3]; }
                ss += __shfl_xor(ss, 16); ss += __shfl_xor(ss, 32);
                if (fq == 0) SSQ[(size_t)row * 16 + u.pn * 4 + wc] = ss; }
            __builtin_amdgcn_sched_barrier(0);
        }
    }
};
struct EpiSwiGLU {
    static constexpr bool PERM = true, FP8 = false;
    static constexpr int NF8T = -1;
    static constexpr bool HALFN = false;
    static constexpr int NVM = 0;
    __device__ __forceinline__ void pre(PG8_LAS unsigned char*, const Unit&, int, int, int) const {}
    bf16_t* H;
    __device__ __forceinline__ void operator()(const f32x4 (&acc)[2][2][4][2], const Unit& u, int wr, int wc, int fr, int fq, PG8_LAS unsigned char* lds, int ui) const {
        const int row0 = u.pm * BM + wr * 64 + fr, col0 = u.pn * HALF + wc * 32 + 8 * fq;
#pragma unroll
        for (int ai = 0; ai < 2; ++ai)
#pragma unroll
            for (int m = 0; m < 4; ++m) { bf16_t* rowp = H + (size_t)(row0 + ai * HALF + m * 16) * 256 + col0;
                float h[8];
#pragma unroll
                for (int n = 0; n < 2; ++n)
#pragma unroll
                    for (int j = 0; j < 4; ++j) { const float g = acc[ai][0][m][n][j], up = acc[ai][1][m][n][j]; h[n * 4 + j] = g * __builtin_amdgcn_rcpf(1.f + __expf(-g)) * up; }
                u32x4 w; w.x = cvt_pk_bf16(h[0], h[1]); w.y = cvt_pk_bf16(h[2], h[3]); w.z = cvt_pk_bf16(h[4], h[5]); w.w = cvt_pk_bf16(h[6], h[7]);
                *(u32x4*)rowp = w; }
    }
};
struct EpiScatter {
    static constexpr bool PERM = true, FP8 = false;
    static constexpr int NF8T = -1;
    static constexpr bool HALFN = false;
    static constexpr int NVM = 0;
    __device__ __forceinline__ void pre(PG8_LAS unsigned char*, const Unit&, int, int, int) const {}
    bf16_t* Y; const int* rowtok; const float* rowgate; const PG8_LAS int* cnt;
    __device__ __forceinline__ void operator()(const f32x4 (&acc)[2][2][4][2], const Unit& u, int wr, int wc, int fr, int fq, PG8_LAS unsigned char* lds, int ui) const {
        const int col0 = u.pn * BM + wc * 32 + 8 * fq, n_e = cnt[u.e];
        int tk[8]; float gt[8];
#pragma unroll
        for (int i = 0; i < 8; ++i) { int slot = u.j * BM + (i >> 2) * HALF + wr * 64 + (i & 3) * 16 + fr; const bool ok = slot < n_e; slot = ok ? slot : 0;
            tk[i] = rowtok[u.e * 65536 + slot]; gt[i] = rowgate[u.e * 65536 + slot]; tk[i] = ok ? tk[i] : -1; }
#pragma unroll
        for (int ai = 0; ai < 2; ++ai)
#pragma unroll
            for (int m = 0; m < 4; ++m) { const int i = ai * 4 + m;
                if (tk[i] >= 0) { bf16_t* rowp = Y + (size_t)tk[i] * 1024 + col0;
#pragma unroll
                    for (int bj = 0; bj < 2; ++bj) { const f32x4 v0 = acc[ai][bj][m][0] * gt[i], v1 = acc[ai][bj][m][1] * gt[i];
                        u32x4 w; w.x = cvt_pk_bf16(v0[0], v0[1]); w.y = cvt_pk_bf16(v0[2], v0[3]); w.z = cvt_pk_bf16(v1[0], v1[1]); w.w = cvt_pk_bf16(v1[2], v1[3]);
                        *(u32x4*)(rowp + bj * HALF) = w; } } }
    }
};

struct EpiSwiGLU8 {
    static constexpr bool PERM = true, FP8 = true;
    static constexpr int NF8T = -1;
    static constexpr bool HALFN = false;
    static constexpr int NVM = 8;
    static constexpr int LOOK_OFF = 131072 + 4096;
    unsigned char* H; const float* rowscale;
    __device__ __forceinline__ void pre(PG8_LAS unsigned char* lds, const Unit& u, int ui, int wid, int lane) const {
        if (wid < 4) __builtin_amdgcn_global_load_lds((const unsigned*)rowscale + u.e * 65536 + u.j * BM + 64 * wid + lane, (PG8_LAS unsigned*)(lds + LOOK_OFF + (ui & 1) * 1024 + wid * 256), 4, 0, 0);
    }
    __device__ __forceinline__ void operator()(const f32x4 (&acc)[2][2][4][2], const Unit& u, int wr, int wc, int fr, int fq, PG8_LAS unsigned char* lds, int ui) const {
        const int row0 = u.pm * BM + wr * 64 + fr, col0 = u.pn * HALF + wc * 32 + 8 * fq;
        const PG8_LAS float* ls = (const PG8_LAS float*)(lds + LOOK_OFF + (ui & 1) * 1024);
#pragma unroll
        for (int ai = 0; ai < 2; ++ai)
#pragma unroll
            for (int m = 0; m < 4; ++m) { unsigned char* rowp = H + (size_t)(row0 + ai * HALF + m * 16) * 256 + col0;
                const float sc = ls[ai * HALF + wr * 64 + m * 16 + fr] * 0.03125f;
                float h[8];
#pragma unroll
                for (int n = 0; n < 2; ++n)
#pragma unroll
                    for (int j = 0; j < 4; ++j) { const float g = acc[ai][0][m][n][j] * sc, up = acc[ai][1][m][n][j] * sc; h[n * 4 + j] = g * __builtin_amdgcn_rcpf(1.f + __expf(-g)) * up; }
                int w0 = 0, w1 = 0; w0 = __builtin_amdgcn_cvt_pk_fp8_f32(h[0], h[1], w0, false); w0 = __builtin_amdgcn_cvt_pk_fp8_f32(h[2], h[3], w0, true); w1 = __builtin_amdgcn_cvt_pk_fp8_f32(h[4], h[5], w1, false); w1 = __builtin_amdgcn_cvt_pk_fp8_f32(h[6], h[7], w1, true);
                *(unsigned long long*)rowp = (unsigned long long)(unsigned)w0 | ((unsigned long long)(unsigned)w1 << 32); }
    }
};
struct EpiScatter8 {
    static constexpr bool PERM = true, FP8 = true;
    static constexpr int NF8T = -1;
    static constexpr bool HALFN = false;
    static constexpr int NVM = 16;
    static constexpr int LOOK_OFF = 131072 + 4096;
    unsigned char* Y; const int* rowtok; const float* rowgate; const PG8_LAS int* cnt;
    __device__ __forceinline__ void pre(PG8_LAS unsigned char* lds, const Unit& u, int ui, int wid, int lane) const {
        const unsigned* src = (wid < 4 ? (const unsigned*)rowtok : (const unsigned*)rowgate) + u.e * 65536 + u.j * BM + 64 * (wid & 3) + lane;
        __builtin_amdgcn_global_load_lds(src, (PG8_LAS unsigned*)(lds + LOOK_OFF + (ui & 1) * 2048 + wid * 256), 4, 0, 0);
    }
    __device__ __forceinline__ void operator()(const f32x4 (&acc)[2][2][4][2], const Unit& u, int wr, int wc, int fr, int fq, PG8_LAS unsigned char* lds, int ui) const {
        const int col0 = u.pn * BM + wc * 32 + 8 * fq, n_e = cnt[u.e];
        const PG8_LAS int* ltok = (const PG8_LAS int*)(lds + LOOK_OFF + (ui & 1) * 2048); const PG8_LAS float* lgate = (const PG8_LAS float*)(lds + LOOK_OFF + (ui & 1) * 2048 + 1024);
        int tk[8]; float gt[8];
#pragma unroll
        for (int i = 0; i < 8; ++i) { const int r = (i >> 2) * HALF + wr * 64 + (i & 3) * 16 + fr; const bool ok = u.j * BM + r < n_e;
            tk[i] = ok ? ltok[r] : 2 * 65536; gt[i] = lgate[r] * 2.f; }
#pragma unroll
        for (int ai = 0; ai < 2; ++ai)
#pragma unroll
            for (int m = 0; m < 4; ++m) { const int i = ai * 4 + m;
                unsigned char* rowp = Y + (size_t)tk[i] * 1024 + col0;
#pragma unroll
                for (int bj = 0; bj < 2; ++bj) { const f32x4 v0 = acc[ai][bj][m][0] * gt[i], v1 = acc[ai][bj][m][1] * gt[i];
                    int w0 = 0, w1 = 0; w0 = __builtin_amdgcn_cvt_pk_fp8_f32(v0[0], v0[1], w0, false); w0 = __builtin_amdgcn_cvt_pk_fp8_f32(v0[2], v0[3], w0, true); w1 = __builtin_amdgcn_cvt_pk_fp8_f32(v1[0], v1[1], w1, false); w1 = __builtin_amdgcn_cvt_pk_fp8_f32(v1[2], v1[3], w1, true);
                    *(unsigned long long*)(rowp + bj * HALF) = (unsigned long long)(unsigned)w0 | ((unsigned long long)(unsigned)w1 << 32); } }
    }
};

template <class Epi, class Sched>
__device__ __forceinline__ void gemm_phase(PG8_LAS unsigned char* lds, const Gemm g, const Sched& S, const Epi& E) {
    constexpr bool GA = Sched::GATHER;
    const int tid = threadIdx.x, wid = __builtin_amdgcn_readfirstlane(tid >> 6), lane = tid & 63, wr = wid >> 2, wc = wid & 3, fr = lane & 15, fq = lane >> 4;
    int Kq = g.K; asm volatile("" : "+s"(Kq));
    const int K = Kq, nt = K / BK;
    unsigned voffA[2], voffB[2]; int RA[2], CA[2];
#pragma unroll
    for (int i = 0; i < 2; ++i) { int R, C; stage_rc(tid * 16 + i * 8192, R, C); const int Rb = Epi::PERM ? ((R & ~31) + perm32(R & 31)) : R;
        voffA[i] = (unsigned)(R * K + C) * 2u; voffB[i] = (unsigned)(Rb * K + C) * 2u; RA[i] = R; CA[i] = C; }
    const size_t kstep = (size_t)(BK * 2);
    const size_t hstep = (size_t)HALF * K * 2;
    const size_t hstepA = GA ? 0 : hstep;
    const unsigned ldsw = (unsigned)wid * 1024u;
    const int aoff = lds_byte(wr * 64 + fr, fq * 8), boff = lds_byte(wc * 32 + fr, fq * 8);
    constexpr bool HN = Epi::HALFN; constexpr int WVS = HN ? 6 : 8;
    constexpr bool MIXED = Epi::NF8T >= 0;
    constexpr bool F8 = Epi::FP8;
#define PG8_SA(b, h) (((b) * 2 + (h)) * HTB)
#define PG8_SB(b, h) ((4 + (b) * 2 + (h)) * HTB)
#define PG8_STAGE(bufoff, gbase, voff) do { _Pragma("unroll") for (int _i = 0; _i < 2; ++_i) \
        __builtin_amdgcn_global_load_lds((const unsigned*)((const char*)(gbase) + (voff)[_i]), (PG8_LAS unsigned*)(lds + (bufoff) + ldsw + _i * 8192), 16, 0, 0); } while (0)
#define PG8_LD2(p) __builtin_shufflevector(*(const PG8_LAS v4i*)(p), *(const PG8_LAS v4i*)((p) + 1024), 0, 1, 2, 3, 4, 5, 6, 7)
#define PG8_LDA(dst, b, h) do { _Pragma("unroll") for (int m = 0; m < 4; ++m) dst[m] = PG8_LD2(lds + PG8_SA(b, h) + aoff + m * 2048); } while (0)
#define PG8_LDB(dst, b, h) do { _Pragma("unroll") for (int n = 0; n < 2; ++n) dst[n] = PG8_LD2(lds + PG8_SB(b, h) + boff + n * 2048); } while (0)
#define PG8_LO(x) __builtin_shufflevector(x, x, 0, 1, 2, 3)
#define PG8_HI(x) __builtin_shufflevector(x, x, 4, 5, 6, 7)
#define PG8_MMA8(ai, bj, At, Bt) do { _Pragma("unroll") for (int m = 0; m < 4; ++m) _Pragma("unroll") for (int n = 0; n < 2; ++n) \
            asm volatile("v_mfma_f32_16x16x128_f8f6f4 %0, %1, %2, %0" : "+v"(acc[ai][bj][m][n]) : "v"(Bt[n]), "v"(At[m])); } while (0)
#define PG8_MMA16(ai, bj, At, Bt) do { _Pragma("unroll") for (int m = 0; m < 4; ++m) _Pragma("unroll") for (int n = 0; n < 2; ++n) { \
            asm volatile("v_mfma_f32_16x16x32_bf16 %0, %1, %2, %0" : "+v"(acc[ai][bj][m][n]) : "v"(PG8_LO(Bt[n])), "v"(PG8_LO(At[m]))); \
            asm volatile("v_mfma_f32_16x16x32_bf16 %0, %1, %2, %0" : "+v"(acc[ai][bj][m][n]) : "v"(PG8_HI(Bt[n])), "v"(PG8_HI(At[m]))); } } while (0)
#define PG8_MMA8P(ai, bj, At, Bt) do { __builtin_amdgcn_s_setprio(1); PG8_MMA8(ai, bj, At, Bt); __builtin_amdgcn_s_setprio(0); } while (0)
#define PG8_MMA16P(ai, bj, At, Bt) do { __builtin_amdgcn_s_setprio(1); PG8_MMA16(ai, bj, At, Bt); __builtin_amdgcn_s_setprio(0); } while (0)
#define PG8_MMA(ai, bj, At, Bt) do { __builtin_amdgcn_s_setprio(1); \
        if constexpr (F8) PG8_MMA8(ai, bj, At, Bt); else PG8_MMA16(ai, bj, At, Bt); \
        __builtin_amdgcn_s_setprio(0); } while (0)
#define PG8_WAIT_V(n) asm volatile("s_waitcnt vmcnt(" #n ")" ::: "memory")
#define PG8_WAIT_VN(n) asm volatile("s_waitcnt vmcnt(%0)" :: "n"(n) : "memory")
#define PG8_WAIT_L(n) asm volatile("s_waitcnt lgkmcnt(" #n ")" ::: "memory")
#define PG8_BAR __builtin_amdgcn_s_barrier()
#define PG8_SCHED __builtin_amdgcn_sched_barrier(0)
    Unit cur, nxt; int ui = 0;
    if (!S.next(0, cur)) return;
    f32x4 acc[2][2][4][2];
#pragma unroll
    for (int a = 0; a < 2; ++a)
#pragma unroll
        for (int b = 0; b < 2; ++b)
#pragma unroll
            for (int m = 0; m < 4; ++m)
#pragma unroll
                for (int n = 0; n < 2; ++n) { acc[a][b][m][n] = (f32x4){0.f, 0.f, 0.f, 0.f}; asm volatile("" : "+v"(acc[a][b][m][n])); }
    v8i At[4], B0[2], B1[2];
    const char* cA = S.a_tile(g, cur); const char* cB = S.b_tile(g, cur);
    unsigned cg0[2], cg1[2], ng0[2], ng1[2];
#pragma unroll
    for (int i = 0; i < 2; ++i) { cg0[i] = voffA[i]; cg1[i] = voffA[i]; ng0[i] = voffA[i]; ng1[i] = voffA[i]; }
    if constexpr (GA) {
#pragma unroll
        for (int i = 0; i < 2; ++i) { cg0[i] = (unsigned)(S.row_of(cur, RA[i]) * K + CA[i]) * 2u; cg1[i] = (unsigned)(S.row_of(cur, HALF + RA[i]) * K + CA[i]) * 2u; }
    }
    E.pre(lds, cur, 0, wid, lane);
    PG8_STAGE(PG8_SB(0, 0), cB, voffB); if constexpr (!HN) PG8_STAGE(PG8_SB(0, 1), cB + hstep, voffB); PG8_STAGE(PG8_SA(0, 0), cA, cg0); PG8_STAGE(PG8_SA(0, 1), cA + hstepA, cg1);
    if (wr == 1) PG8_BAR;
    PG8_WAIT_V(2); PG8_BAR;
    PG8_STAGE(PG8_SB(1, 0), cB + kstep, voffB); PG8_STAGE(PG8_SA(1, 0), cA + kstep, cg0); if constexpr (!HN) PG8_STAGE(PG8_SB(1, 1), cB + hstep + kstep, voffB);
    if constexpr (HN) PG8_WAIT_V(4); else PG8_WAIT_V(6);
    PG8_BAR;
    for (;;) {
        const bool has_next = S.next(ui + 1, nxt);
        const char* nA = has_next ? S.a_tile(g, nxt) : cA; const char* nB = has_next ? S.b_tile(g, nxt) : cB;
        if constexpr (GA) {
            if (has_next) {
#pragma unroll
                for (int i = 0; i < 2; ++i) { ng0[i] = (unsigned)(S.row_of(nxt, RA[i]) * K + CA[i]) * 2u; ng1[i] = (unsigned)(S.row_of(nxt, HALF + RA[i]) * K + CA[i]) * 2u; }
            } else {
#pragma unroll
                for (int i = 0; i < 2; ++i) { ng0[i] = cg0[i]; ng1[i] = cg1[i]; }
            }
        }
#define PG8_BODY(MM) { \
            const bool last = (t == nt - 2); \
            const char* a1 = cA + (size_t)(t + 1) * kstep; \
            const char* a2 = last ? nA : cA + (size_t)(t + 2) * kstep; const char* b2 = last ? nB : cB + (size_t)(t + 2) * kstep; \
            const char* a3 = a2 + kstep; const char* b3 = b2 + kstep; \
            unsigned x0[2], x1[2]; \
            _Pragma("unroll") for (int i = 0; i < 2; ++i) { x0[i] = (GA && last) ? ng0[i] : cg0[i]; x1[i] = (GA && last) ? ng1[i] : cg1[i]; } \
              \
            const bool relaxed = Epi::NVM > 0 && t == 0 && ui > 0; \
              \
            PG8_LDB(B0, 0, 0); if constexpr (!HN) PG8_LDB(B1, 0, 1); PG8_SCHED; PG8_LDA(At, 0, 0); if (!(t == 0 && ui > 0)) PG8_STAGE(PG8_SA(1, 1), a1 + hstepA, cg1);     \
            PG8_WAIT_FIRST; PG8_WAIT_L(0); PG8_BAR; MM(0, 0, At, B0); if constexpr (!HN) MM(0, 1, At, B1); PG8_BAR; PG8_SCHED; \
              \
            PG8_LDA(At, 0, 1); PG8_STAGE(PG8_SB(0, 0), b2, voffB); if constexpr (!HN) PG8_STAGE(PG8_SB(0, 1), b2 + hstep, voffB); PG8_STAGE(PG8_SA(0, 0), a2, x0); \
            PG8_WAIT_FIRST; PG8_WAIT_L(0); PG8_BAR; MM(1, 0, At, B0); if constexpr (!HN) MM(1, 1, At, B1); PG8_BAR; PG8_SCHED; \
              \
            PG8_LDB(B0, 1, 0); if constexpr (!HN) PG8_LDB(B1, 1, 1); PG8_SCHED; PG8_LDA(At, 1, 0); PG8_STAGE(PG8_SA(0, 1), a2 + hstepA, x1); \
            PG8_WAIT_FIRST; PG8_WAIT_L(0); PG8_BAR; MM(0, 0, At, B0); if constexpr (!HN) MM(0, 1, At, B1); PG8_BAR; PG8_SCHED; \
              \
            PG8_LDA(At, 1, 1); PG8_STAGE(PG8_SB(1, 0), b3, voffB); if constexpr (!HN) PG8_STAGE(PG8_SB(1, 1), b3 + hstep, voffB); PG8_STAGE(PG8_SA(1, 0), a3, x0); \
            PG8_WAIT_VN(WVS); PG8_WAIT_L(0); PG8_BAR; MM(1, 0, At, B0); if constexpr (!HN) MM(1, 1, At, B1); PG8_BAR; PG8_SCHED; }
#define PG8_WAIT_FIRST do { if (relaxed) PG8_WAIT_VN(WVS + Epi::NVM); else PG8_WAIT_VN(WVS); } while (0)
        if constexpr (MIXED) {
            int t = 0;
            for (; t < Epi::NF8T; t += 2) PG8_BODY(PG8_MMA8P)
            for (; t < nt; t += 2) PG8_BODY(PG8_MMA16P)
        } else {
            for (int t = 0; t < nt; t += 2) PG8_BODY(PG8_MMA)
        }
#undef PG8_WAIT_FIRST
#undef PG8_BODY
        if (has_next) PG8_STAGE(PG8_SA(1, 1), nA + kstep + hstepA, ng1);
        asm volatile("s_nop 15");
        if (wr == 0) PG8_BAR;
        E(acc, cur, wr, wc, fr, fq, lds, ui);
        if (!has_next) break;
#pragma unroll
        for (int a = 0; a < 2; ++a)
#pragma unroll
            for (int b = 0; b < 2; ++b)
#pragma unroll
                for (int m = 0; m < 4; ++m)
#pragma unroll
                    for (int n = 0; n < 2; ++n) { acc[a][b][m][n] = (f32x4){0.f, 0.f, 0.f, 0.f}; asm volatile("" : "+v"(acc[a][b][m][n])); }
        cur = nxt; cA = nA; cB = nB; ++ui;
        E.pre(lds, cur, ui, wid, lane);
        if constexpr (GA) {
#pragma unroll
            for (int i = 0; i < 2; ++i) { cg0[i] = ng0[i]; cg1[i] = ng1[i]; }
        }
        if (wr == 1) PG8_BAR;
    }
    PG8_WAIT_V(0);
    PG8_BAR;
#undef PG8_SA
#undef PG8_SB
#undef PG8_STAGE
#undef PG8_LDA
#undef PG8_LDB
#undef PG8_MMA
#undef PG8_MMA8
#undef PG8_MMA16
#undef PG8_MMA8P
#undef PG8_MMA16P
#undef PG8_LD2
#undef PG8_LO
#undef PG8_HI
#undef PG8_WAIT_V
#undef PG8_WAIT_VN
#undef PG8_WAIT_L
#undef PG8_BAR
#undef PG8_SCHED
}
}

#define XB_TMO      128
#define XB_XCNT(j)  (256  + 64 * (j))
#define XB_XSUB(j)  (1280 + 64 * (j))
#define XB_XGEN(j)  (2304 + 64 * (j))
#define XB_TOP      3328
#define XB_TOPGEN   3392
#define XCD_BAR_WORDS 3456
#define XB_SPIN_CAP (1u << 20)

__device__ __forceinline__ unsigned xb_ld(unsigned* p)              { return __hip_atomic_load(p, __ATOMIC_RELAXED, __HIP_MEMORY_SCOPE_AGENT); }
__device__ __forceinline__ unsigned xb_add(unsigned* p, unsigned v) { return __hip_atomic_fetch_add(p, v, __ATOMIC_RELAXED, __HIP_MEMORY_SCOPE_AGENT); }
__device__ __forceinline__ unsigned xb_xcc_id() { return (unsigned)__builtin_amdgcn_s_getreg((3 << 11) | 20) & 0xFu; }
#define XB_SPIN(cond, bar) do { unsigned _sp = 0; while (cond) { __builtin_amdgcn_s_sleep(1); \
    if ((++_sp & 255u) == 0u) { if (xb_ld(&(bar)[XB_TMO])) break; if (_sp > XB_SPIN_CAP) { atomicAdd(&(bar)[XB_TMO], 1u); break; } } } } while (0)

struct XcdBarrier { unsigned* bar; unsigned x; volatile LAS unsigned* st; };

__device__ __forceinline__ XcdBarrier xcd_barrier_post(unsigned* bar, volatile LAS unsigned* st) {
    XcdBarrier b; b.bar = bar; b.x = xb_xcc_id(); b.st = st;
    if (threadIdx.x == 0) (void)xb_add(&bar[XB_XCNT(b.x)], 1u);
    return b;
}
__device__ __forceinline__ void xcd_barrier_complete(unsigned* bar, unsigned x, unsigned& nloc, unsigned& nx) {
    const unsigned G = gridDim.x * gridDim.y * gridDim.z;
    unsigned sum, cnt, mine, sp = 0u;
    for (;;) {
        sum = 0u; cnt = 0u; mine = 0u;
#pragma unroll
        for (unsigned j = 0; j < 16; ++j) { const unsigned c = xb_ld(&bar[XB_XCNT(j)]); sum += c; cnt += (c > 0u) ? 1u : 0u; mine = (j == x) ? c : mine; }
        if (sum == G) break;
        __builtin_amdgcn_s_sleep(1);
        if ((++sp & 255u) == 0u) { if (xb_ld(&bar[XB_TMO])) break; if (sp > XB_SPIN_CAP) { atomicAdd(&bar[XB_TMO], 1u); break; } }
    }
    nloc = mine > 0u ? mine : 1u; nx = cnt > 0u ? cnt : 1u;
}
__device__ __forceinline__ void xcd_barrier(const XcdBarrier& b) {
    asm volatile("s_waitcnt vmcnt(0)" ::: "memory");
    __syncthreads();
    if (threadIdx.x == 0) {
        unsigned* bar = b.bar;
        __builtin_amdgcn_s_waitcnt(0);
        unsigned nloc = b.st[0], nx = b.st[1];
        if (nloc == 0u) { xcd_barrier_complete(bar, b.x, nloc, nx); b.st[0] = nloc; b.st[1] = nx; }
        const unsigned old = xb_add(&bar[XB_XSUB(b.x)], 1u);
        const unsigned gen = old / nloc;
        if (old + 1u == (gen + 1u) * nloc) {
            __builtin_amdgcn_fence(__ATOMIC_RELEASE, "agent");
            asm volatile("s_waitcnt vmcnt(0)" ::: "memory");
            const unsigned og = xb_add(&bar[XB_TOP], 1u);
            const unsigned tg = og / nx;
            if (og + 1u == (tg + 1u) * nx) xb_add(&bar[XB_TOPGEN], 1u);
            else XB_SPIN(xb_ld(&bar[XB_TOPGEN]) == tg, bar);
            __builtin_amdgcn_fence(__ATOMIC_ACQUIRE, "agent");
            xb_add(&bar[XB_XGEN(b.x)], 1u);
            asm volatile("s_waitcnt vmcnt(0)" ::: "memory");
        } else {
            XB_SPIN(xb_ld(&bar[XB_XGEN(b.x)]) == gen, bar);
            __builtin_amdgcn_fence(__ATOMIC_ACQUIRE, "agent");
            asm volatile("s_waitcnt vmcnt(0)" ::: "memory");
        }
    }
    __syncthreads();
}

struct Frame {
    LAS unsigned char* lds;
    unsigned* ctl;
    int tid, lane, wave, G, vcu;
    const float *x, *norm_mix_w, *w_in, *lb_logits, *hg_onorm_w, *conv_w, *a_log, *dt_bias, *gd_onorm_w, *w_out, *norm_moe_w, *wr_group, *wr_expert, *w_gate, *w_up, *w_down, *final_w;
    float* out;
    unsigned char* ws;
};

DI void transpose_item(const float* W, int K, int ldw, int nblk, bf16* WT, int row_off, LAS float* scr, int item, int lane) {
    const int kb = item / nblk, nb = item % nblk, k0 = 64 * kb, n0 = 32 * nb;
    f32x4 v[8];
#pragma unroll
    for (int i = 0; i < 8; ++i) v[i] = *(const f32x4*)(W + (size_t)(k0 + 8 * i + (lane >> 3)) * ldw + n0 + 4 * (lane & 7));
#pragma unroll
    for (int i = 0; i < 8; ++i) { LAS float* d = scr + (8 * i + (lane >> 3)) * 33 + 4 * (lane & 7); d[0] = v[i].x; d[1] = v[i].y; d[2] = v[i].z; d[3] = v[i].w; }
    LDS_WAIT(); asm volatile("" ::: "memory");
    const int c = lane & 7;
#pragma unroll
    for (int j = 0; j < 4; ++j) { const int n = (lane >> 3) + 8 * j; const LAS float* s = scr + (8 * c) * 33 + n;
        v4u o; o.x = pk2(s[0 * 33], s[1 * 33]); o.y = pk2(s[2 * 33], s[3 * 33]); o.z = pk2(s[4 * 33], s[5 * 33]); o.w = pk2(s[6 * 33], s[7 * 33]);
        *(v4u*)(WT + (size_t)(row_off + n0 + n) * K + k0 + 8 * c) = o; }
    LDS_WAIT(); asm volatile("" ::: "memory");
}

DI void transpose_item8(const float* W, int K, int ldw, int nblk, unsigned char* WT, int row_off, float scale, const float* kscale, LAS float* scr, int item, int lane) {
    const int kb = item / nblk, nb = item % nblk, k0 = 64 * kb, n0 = 32 * nb;
    f32x4 v[8];
#pragma unroll
    for (int i = 0; i < 8; ++i) v[i] = __builtin_nontemporal_load((const f32x4*)(W + (size_t)(k0 + 8 * i + (lane >> 3)) * ldw + n0 + 4 * (lane & 7)));
#pragma unroll
    for (int i = 0; i < 8; ++i) { LAS float* d = scr + (8 * i + (lane >> 3)) * 33 + 4 * (lane & 7); d[0] = v[i].x; d[1] = v[i].y; d[2] = v[i].z; d[3] = v[i].w; }
    LDS_WAIT(); asm volatile("" ::: "memory");
    const int c = lane & 7;
    float ks[8];
    if (kscale) { const f32x4 a = *(const f32x4*)(kscale + k0 + 8 * c), b = *(const f32x4*)(kscale + k0 + 8 * c + 4); ks[0] = a.x * scale; ks[1] = a.y * scale; ks[2] = a.z * scale; ks[3] = a.w * scale; ks[4] = b.x * scale; ks[5] = b.y * scale; ks[6] = b.z * scale; ks[7] = b.w * scale; }
    else {
#pragma unroll
        for (int i = 0; i < 8; ++i) ks[i] = scale; }
#pragma unroll
    for (int j = 0; j < 4; ++j) { const int n = (lane >> 3) + 8 * j; const LAS float* sp = scr + (8 * c) * 33 + n;
        const unsigned lo = pk4_fp8(sp[0 * 33] * ks[0], sp[1 * 33] * ks[1], sp[2 * 33] * ks[2], sp[3 * 33] * ks[3]), hi = pk4_fp8(sp[4 * 33] * ks[4], sp[5 * 33] * ks[5], sp[6 * 33] * ks[6], sp[7 * 33] * ks[7]);
        __builtin_nontemporal_store((v2u){lo, hi}, (v2u*)(WT + (size_t)(row_off + n0 + n) * K + k0 + 8 * c)); }
    LDS_WAIT(); asm volatile("" ::: "memory");
}

DI void transpose_wout(const float* W, unsigned char* WT, LAS float* scr, int item, int lane) {
    const int kb = item / 32, nb = item % 32, k0 = 64 * kb, n0 = 32 * nb, hh = kb >> 1;
    f32x4 v[8];
#pragma unroll
    for (int i = 0; i < 8; ++i) v[i] = *(const f32x4*)(W + (size_t)(k0 + 8 * i + (lane >> 3)) * D + n0 + 4 * (lane & 7));
#pragma unroll
    for (int i = 0; i < 8; ++i) { LAS float* d = scr + (8 * i + (lane >> 3)) * 33 + 4 * (lane & 7); d[0] = v[i].x; d[1] = v[i].y; d[2] = v[i].z; d[3] = v[i].w; }
    LDS_WAIT(); asm volatile("" ::: "memory");
    const int c = lane & 7;
#pragma unroll
    for (int j = 0; j < 4; ++j) { const int n = (lane >> 3) + 8 * j; const LAS float* sp = scr + (8 * c) * 33 + n;
        unsigned char* row = WT + (size_t)(n0 + n) * OG_PITCH;
        if (hh < OG_NF) { const unsigned lo = pk4_fp8(sp[0 * 33] * 32.f, sp[1 * 33] * 32.f, sp[2 * 33] * 32.f, sp[3 * 33] * 32.f), hi = pk4_fp8(sp[4 * 33] * 32.f, sp[5 * 33] * 32.f, sp[6 * 33] * 32.f, sp[7 * 33] * 32.f);
            *(v2u*)(row + k0 + 8 * c) = (v2u){lo, hi}; }
        else { v4u o; o.x = pk2(sp[0 * 33] * 32.f, sp[1 * 33] * 32.f); o.y = pk2(sp[2 * 33] * 32.f, sp[3 * 33] * 32.f); o.z = pk2(sp[4 * 33] * 32.f, sp[5 * 33] * 32.f); o.w = pk2(sp[6 * 33] * 32.f, sp[7 * 33] * 32.f);
            *(v4u*)(row + OG_NF * 128 + (k0 - OG_NF * 128 + 8 * c) * 2) = o; }
    }
    LDS_WAIT(); asm volatile("" ::: "memory");
}

DI void p0_prologue(Frame& F) {
    LAS float* scr = (LAS float*)(F.lds + F.wave * 16384);
    const int gw = F.vcu * NWAVES + F.wave, NGW = F.G * NWAVES;
    constexpr int I_IN = (D / 64) * (NP / 32), I_OUT = (D / 64) * (D / 32);
    for (int it = gw; it < I_IN + I_OUT; it += NGW) {
        if (it < I_IN) transpose_item(F.w_in, D, INC, NP / 32, (bf16*)(F.ws + WS_WIN), 0, scr, it, F.lane);
        else transpose_wout(F.w_out, F.ws + WS_WOUT, scr, it - I_IN, F.lane);
    }
    {
        bf16* WR = (bf16*)(F.ws + WS_WR);
        const int gt = F.vcu * NTHR + F.tid, NGT = F.G * NTHR;
        for (int i = gt; i < 256 * D; i += NGT) { const int n = i >> 10, k = i & 1023;
            const float v = n < 8 ? F.wr_group[k * 8 + n] : (n < 72 ? F.wr_expert[k * 64 + (n - 8)] : 0.f);
            WR[i] = (bf16)f2bf(v * F.norm_moe_w[k]); }
        float* LB = (float*)(F.ws + WS_LB);
        if (gt < 512) { const float l0 = F.lb_logits[gt], l1 = F.lb_logits[512 + gt]; LB[gt] = 1.f / (1.f + __expf(l1 - l0)); }
    }
    float wn[16]; f32x4 wab[16][2];
#pragma unroll
    for (int j = 0; j < 4; ++j) { const f32x4 t = *(const f32x4*)(F.norm_mix_w + 4 * F.lane + 256 * j); wn[4 * j] = t.x; wn[4 * j + 1] = t.y; wn[4 * j + 2] = t.z; wn[4 * j + 3] = t.w; }
#pragma unroll
    for (int j = 0; j < 4; ++j)
#pragma unroll
        for (int e = 0; e < 4; ++e) { const int k = 4 * F.lane + 256 * j + e; const float* p = F.w_in + (size_t)k * INC + NP; wab[4 * j + e][0] = *(const f32x4*)p; wab[4 * j + e][1] = *(const f32x4*)(p + 4); }
    bf16* HN = (bf16*)F.out; float* AB = (float*)(F.ws + WS_AB); float* RXI = (float*)(F.ws + WS_RXI);
    f32x4 nx[4], nx2[4];
    if (gw < T) {
#pragma unroll
        for (int j = 0; j < 4; ++j) nx[j] = __builtin_nontemporal_load((const f32x4*)(F.x + (size_t)gw * D) + F.lane + 64 * j); }
    if (gw + NGW < T) {
#pragma unroll
        for (int j = 0; j < 4; ++j) nx2[j] = __builtin_nontemporal_load((const f32x4*)(F.x + (size_t)(gw + NGW) * D) + F.lane + 64 * j); }
    for (int m = gw; m < T; m += NGW) {
        f32x4 cx[4];
#pragma unroll
        for (int j = 0; j < 4; ++j) { cx[j] = nx[j]; nx[j] = nx2[j]; }
        if (m + 2 * NGW < T) {
#pragma unroll
            for (int j = 0; j < 4; ++j) nx2[j] = __builtin_nontemporal_load((const f32x4*)(F.x + (size_t)(m + 2 * NGW) * D) + F.lane + 64 * j); }
        float v[16]; float s = 0.f;
#pragma unroll
        for (int j = 0; j < 4; ++j) { const f32x4 t = cx[j]; v[4 * j] = t.x; v[4 * j + 1] = t.y; v[4 * j + 2] = t.z; v[4 * j + 3] = t.w; s += (t.x * t.x + t.y * t.y) + (t.z * t.z + t.w * t.w); }
        const float ms = wave_sum(s) * (1.f / D) + EPS; const float r = frsq(ms);
        if (F.lane == 0) RXI[m] = ms * r;
        float p[8];
#pragma unroll
        for (int c = 0; c < 8; ++c) p[c] = 0.f;
#pragma unroll
        for (int i = 0; i < 16; ++i) { v[i] = v[i] * r * wn[i];
#pragma unroll
            for (int c = 0; c < 4; ++c) { p[c] += v[i] * wab[i][0][c]; p[4 + c] += v[i] * wab[i][1][c]; } }
        unsigned long long* o8 = (unsigned long long*)(HN + (size_t)m * D) + F.lane;
#pragma unroll
        for (int j = 0; j < 4; ++j) o8[64 * j] = (unsigned long long)pk2(v[4 * j], v[4 * j + 1]) | ((unsigned long long)pk2(v[4 * j + 2], v[4 * j + 3]) << 32);
        float mine = 0.f;
#pragma unroll
        for (int c = 0; c < 8; ++c) { const float t = wave_sum(p[c]); mine = (F.lane == c) ? t : mine; }
        if (F.lane < 8) AB[(size_t)m * 8 + F.lane] = mine;
    }
}

DI bf16x8 ldfrag(const LAS bf16* base, int ld, int lane) { return *(const LAS bf16x8*)(base + (lane & 15) * ld + 8 * (lane >> 4)); }
#define MFMA16(a, b, c) __builtin_amdgcn_mfma_f32_16x16x32_bf16((a), (b), (c), 0, 0, 0)
constexpr float QSCALE = 0.08838834764831845f;
DI size_t prb(int bn, int cb) { return ((size_t)bn * 32 + cb) * 8192; }

DI void hg_raw_load(Frame& F, int item, unsigned (&nq)[16], unsigned (&nf)[16], unsigned (&ni)[16], float& nlb) {
    const int h = item & 3, bn = item >> 2, ch = F.tid & 127, tg = F.tid >> 7;
    const bf16* pbase = (const bf16*)(F.ws + WS_R2) + prb(bn, h) + (tg * 16) * 128 + ch;
#pragma unroll
    for (int i = 0; i < 16; ++i) { const bf16* p = pbase + i * 128; nq[i] = p[0]; nf[i] = p[4 * 8192]; ni[i] = p[8 * 8192]; }
    nlb = ((const float*)(F.ws + WS_LB))[h * 128 + ch];
}
DI void hg_pre_item(Frame& F, int item, bf16* PRo, int ldo, bf16* OGo, float* DL, unsigned (&nq)[16], unsigned (&nf)[16], unsigned (&ni)[16], float& nlb, int next_item) {
    const int h = item & 3, bn = item >> 2, tok0 = bn * 64;
    LAS bf16* Aq = (LAS bf16*)F.lds; LAS bf16* Ak = Aq + 64 * 136; LAS bf16* Vt = Ak + 64 * 136; LAS bf16* Att = Vt + 128 * 72; LAS float* part = (LAS float*)(Att + 64 * 72);
    bf16* PR = (bf16*)(F.ws + WS_R2); bf16* R1 = (bf16*)(F.ws + WS_R1);
    const float* LB = (const float*)(F.ws + WS_LB);
    const int ch = F.tid & 127, tg = F.tid >> 7, lane = F.lane, wave = F.wave;
    const float lbv = nlb, olb = 1.f - lbv;
    float qv[16], kk[16], cum[16]; unsigned iv[16], cq[16], cf[16];
#pragma unroll
    for (int i = 0; i < 16; ++i) { cq[i] = nq[i]; cf[i] = nf[i]; iv[i] = ni[i]; }
    if (next_item >= 0) hg_raw_load(F, next_item, nq, nf, ni, nlb);
    float run = 0.f;
    bf16* pbase = PR + prb(bn, h) + (tg * 16) * 128 + ch; bf16* pobase = PRo + prb(bn, h) + (tg * 16) * 128 + ch;
#pragma unroll
    for (int i = 0; i < 16; ++i) {
        const float q = bf2f(cq[i]), fl = bf2f(cf[i]);
        const float e = __expf(-fl), sg = frcp(1.f + e);
        const float f = lbv + olb * sg; run += __logf(f); cum[i] = run; kk[i] = olb * (e * sg); qv[i] = silu(q) * QSCALE; }
    part[tg * 128 + ch] = run;
    LSYNC();
    const float p0 = part[ch], p1 = part[128 + ch], p2 = part[256 + ch], p3 = part[384 + ch];
    const float prefix = (tg > 0 ? p0 : 0.f) + (tg > 1 ? p1 : 0.f) + (tg > 2 ? p2 : 0.f), last = ((p0 + p1) + p2) + p3, cref = p0 + p1;
    unsigned kd[8], ivp[8];
    const float ecref = __expf(cref), elc = __expf(last - cref);
#pragma unroll
    for (int i = 0; i < 16; i += 2) {
        const float c0 = cum[i] + prefix, c1 = cum[i + 1] + prefix; const int t = tg * 16 + i;
        const float e0 = __expf(c0 - cref), e1 = __expf(c1 - cref), r0 = __expf(cref - c0), r1 = __expf(cref - c1);
        Aq[t * 136 + ch] = (bf16)f2bf(qv[i] * e0); Aq[(t + 1) * 136 + ch] = (bf16)f2bf(qv[i + 1] * e1);
        Ak[t * 136 + ch] = (bf16)f2bf(kk[i] * r0); Ak[(t + 1) * 136 + ch] = (bf16)f2bf(kk[i + 1] * r1);
        pobase[i * 128] = (bf16)f2bf(qv[i] * e0 * ecref); pobase[(i + 1) * 128] = (bf16)f2bf(qv[i + 1] * e1 * ecref);
        kd[i >> 1] = pk2(kk[i] * r0 * elc, kk[i + 1] * r1 * elc); ivp[i >> 1] = iv[i] | (iv[i + 1] << 16); }
    {
        bf16* kp = PRo + prb(bn, 4 + h) + ch * 64 + tg * 16;
        *(v4u*)kp = (v4u){kd[0], kd[1], kd[2], kd[3]}; *(v4u*)(kp + 8) = (v4u){kd[4], kd[5], kd[6], kd[7]};
        *(v4u*)(kp + 4 * 8192) = (v4u){ivp[0], ivp[1], ivp[2], ivp[3]}; *(v4u*)(kp + 4 * 8192 + 8) = (v4u){ivp[4], ivp[5], ivp[6], ivp[7]};
        LAS bf16* vp = Vt + ch * 72 + tg * 16;
        *(LAS v4u*)vp = (v4u){ivp[0], ivp[1], ivp[2], ivp[3]}; *(LAS v4u*)(vp + 8) = (v4u){ivp[4], ivp[5], ivp[6], ivp[7]};
        if (tg == 0) DL[(size_t)item * 128 + ch] = __expf(last);
    }
    LSYNC();
#pragma unroll
    for (int j = 0; j < 2; ++j) { const int id = wave * 2 + j, tt = id >> 2, st = id & 3; const int c = lane & 15, q = lane >> 4;
        f32x4 acc = (f32x4){0.f, 0.f, 0.f, 0.f};
        if (st <= tt) {
#pragma unroll
            for (int kc = 0; kc < 4; ++kc) acc = MFMA16(ldfrag(Ak + st * 16 * 136 + kc * 32, 136, lane), ldfrag(Aq + tt * 16 * 136 + kc * 32, 136, lane), acc);
        }
        const int t = tt * 16 + c, s0 = st * 16 + 4 * q;
        const float a0 = (s0 <= t) ? acc[0] : 0.f, a1 = (s0 + 1 <= t) ? acc[1] : 0.f, a2 = (s0 + 2 <= t) ? acc[2] : 0.f, a3 = (s0 + 3 <= t) ? acc[3] : 0.f;
        *(LAS v2u*)(Att + t * 72 + s0) = (v2u){pk2(a0, a1), pk2(a2, a3)}; }
    LSYNC();
#pragma unroll
    for (int j = 0; j < 4; ++j) { const int id = wave * 4 + j, tt = id >> 3, vt = id & 7; const int c = lane & 15, q = lane >> 4;
        f32x4 acc = (f32x4){0.f, 0.f, 0.f, 0.f};
#pragma unroll
        for (int sc = 0; sc < 2; ++sc) acc = MFMA16(ldfrag(Vt + vt * 16 * 72 + sc * 32, 72, lane), ldfrag(Att + tt * 16 * 72 + sc * 32, 72, lane), acc);
        *(v2u*)(OGo + (size_t)(tok0 + tt * 16 + c) * D + h * 128 + vt * 16 + 4 * q) = (v2u){pk2(acc[0], acc[1]), pk2(acc[2], acc[3])}; }
    LSYNC();
}

#define DPP_ADD(v, ctrl) (v) += __builtin_bit_cast(float, __builtin_amdgcn_mov_dpp(__builtin_bit_cast(int, (v)), (ctrl), 0xF, 0xF, true))
DI float row16_sum(float v) { DPP_ADD(v, 0xB1); DPP_ADD(v, 0x4E); DPP_ADD(v, 0x141); DPP_ADD(v, 0x140); return v; }
DI v4u pack8(const float (&y)[8]) { return (v4u){pk2(y[0], y[1]), pk2(y[2], y[3]), pk2(y[4], y[5]), pk2(y[6], y[7])}; }
DI void gd_raw_load(Frame& F, int item, v4u (&raw)[11], f32x4 (&cw)[4][2]) {
    const int h = item & 3, bn = item >> 2, n = bn & 63; const int X = F.wave >> 1, rg = (F.tid >> 4) & 7, c16 = F.tid & 15;
    const bf16* p = (const bf16*)(F.ws + WS_R2) + prb(bn, 16 + 4 * X + h) + 8 * c16;
#pragma unroll
    for (int i = 0; i < 11; ++i) { const int rr = 8 * rg - 3 + i; raw[i] = (v4u){0u, 0u, 0u, 0u};
        if (rr >= 0) raw[i] = *(const v4u*)(p + rr * 128); else if (n > 0) raw[i] = *(const v4u*)(p - (long)32 * 8192 + (64 + rr) * 128); }
#pragma unroll
    for (int j = 0; j < 4; ++j) { const float* wp = F.conv_w + j * 1536 + 512 * X + h * 128 + 8 * c16; cw[j][0] = *(const f32x4*)wp; cw[j][1] = *(const f32x4*)(wp + 4); }
}
DI void gd_pre_item(Frame& F, int item, v4u (&raw)[11], f32x4 (&cw)[4][2], float (&pab)[2], int next_item) {
    const int h = item & 3, bn = item >> 2, n = bn & 63, tok0 = bn * 64;
    LAS bf16* Qs = (LAS bf16*)F.lds; LAS bf16* Ks = Qs + 64 * 136; LAS bf16* Ab = Ks + 64 * 136; LAS bf16* Tm = Ab + 64 * 72; LAS bf16* TT = Tm + 64 * 72; LAS bf16* RHST = TT + 64 * 72;
    LAS float* A16 = (LAS float*)(RHST + 256 * 72); LAS bf16* MT16 = (LAS bf16*)(A16 + 1024); LAS float* gcS = (LAS float*)(MT16 + 3 * 16 * 24); LAS float* egcS = gcS + 64; LAS float* betaS = gcS + 128;
    const bf16* PR = (const bf16*)(F.ws + WS_R2); bf16* R1 = (bf16*)(F.ws + WS_R1); const float* AB = (const float*)(F.ws + WS_AB);
    bf16* GW = (bf16*)(F.ws + WS_GW) + (size_t)item * 8192; bf16* GU = (bf16*)(F.ws + WS_GU) + (size_t)item * 8192;
    bf16* GQG = (bf16*)(F.ws + WS_GQG) + (size_t)item * 8192; bf16* GKD = (bf16*)(F.ws + WS_GKD) + (size_t)item * 8192;
    int tidv = F.tid; asm volatile("" : "+v"(tidv));
    const int lane = tidv & 63, wave = F.wave, c = lane & 15, q = lane >> 4;
    float y[8][8];
    const int X = wave >> 1, rg = (tidv >> 4) & 7, c16 = tidv & 15;
    if (wave < 6) {
        const int ccol = 512 * X + h * 128 + 8 * c16;
#pragma unroll
        for (int ep = 0; ep < 4; ++ep) {
            float w0[4], w1[4];
#pragma unroll
            for (int j = 0; j < 4; ++j) { w0[j] = cw[j][ep >> 1][(2 * ep) & 3]; w1[j] = cw[j][ep >> 1][((2 * ep) & 3) + 1]; }
            float u0[11], u1[11];
#pragma unroll
            for (int i = 0; i < 11; ++i) { u0[i] = bflo(raw[i][ep]); u1[i] = bfhi(raw[i][ep]); }
#pragma unroll
            for (int t = 0; t < 8; ++t) { float a = u0[t] * w0[0]; a += u0[t + 1] * w0[1]; a += u0[t + 2] * w0[2]; a += u0[t + 3] * w0[3];
                float b = u1[t] * w1[0]; b += u1[t + 1] * w1[1]; b += u1[t + 2] * w1[2]; b += u1[t + 3] * w1[3];
                y[t][2 * ep] = silu(a); y[t][2 * ep + 1] = silu(b); }
        }
        if (next_item >= 0) gd_raw_load(F, next_item, raw, cw);
        if (X < 2) {
#pragma unroll
            for (int t = 0; t < 8; ++t) { float s = 0.f;
#pragma unroll
                for (int e = 0; e < 8; ++e) s += y[t][e] * y[t][e];
                s = row16_sum(s); const float r = (X == 0 ? QSCALE : 1.f) * frsq(s + 1e-6f);
#pragma unroll
                for (int e = 0; e < 8; ++e) y[t][e] *= r; }
        }
    } else if (wave == 6) {
        const float a = pab[0], b = pab[1];
        if (next_item >= 0) { const int nh = next_item & 3, ntok = (next_item >> 2) * 64 + lane; pab[0] = AB[(size_t)ntok * 8 + nh]; pab[1] = AB[(size_t)ntok * 8 + 4 + nh]; }
        const float xx = a + F.dt_bias[h]; const float sp = xx > 20.f ? xx : __logf(1.f + __expf(xx));
        float gc = -__expf(F.a_log[h]) * sp;
#pragma unroll
        for (int o = 1; o < 64; o <<= 1) { const float t = __shfl_up(gc, o); if (lane >= o) gc += t; }
        gcS[lane] = gc; egcS[lane] = __expf(gc); betaS[lane] = frcp(1.f + __expf(-b));
        if (lane == 63) ((float*)(F.ws + WS_GEND))[item] = __expf(gc);
    } else {
        for (int i = lane; i < 3 * 64 * 72 / 8; i += 64) ((LAS v4u*)Ab)[i] = (v4u){0u, 0u, 0u, 0u};
    }
    LSYNC();
    if (wave < 6) {
        const float glast = gcS[63];
        float bt[8], eg[8], kdx[8];
#pragma unroll
        for (int t = 0; t < 8; ++t) { bt[t] = betaS[8 * rg + t]; eg[t] = egcS[8 * rg + t]; kdx[t] = __expf(glast - gcS[8 * rg + t]); }
        if (X == 0) {
#pragma unroll
            for (int t = 0; t < 8; ++t) { *(LAS v4u*)(Qs + (8 * rg + t) * 136 + 8 * c16) = pack8(y[t]);
                float z[8];
#pragma unroll
                for (int e = 0; e < 8; ++e) z[e] = y[t][e] * eg[t];
                *(v4u*)(GQG + (8 * rg + t) * 128 + 8 * c16) = pack8(z); }
        } else if (X == 1) {
#pragma unroll
            for (int t = 0; t < 8; ++t) *(LAS v4u*)(Ks + (8 * rg + t) * 136 + 8 * c16) = pack8(y[t]);
#pragma unroll
            for (int e = 0; e < 8; ++e) { float z[8], z2[8];
#pragma unroll
                for (int t = 0; t < 8; ++t) { z[t] = y[t][e] * bt[t] * eg[t]; z2[t] = y[t][e] * kdx[t]; }
                *(LAS v4u*)(RHST + (8 * c16 + e) * 72 + 8 * rg) = pack8(z); *(v4u*)(GKD + (8 * c16 + e) * 64 + 8 * rg) = pack8(z2); }
        } else {
#pragma unroll
            for (int e = 0; e < 8; ++e) { float z[8];
#pragma unroll
                for (int t = 0; t < 8; ++t) z[t] = y[t][e] * bt[t];
                *(LAS v4u*)(RHST + (128 + 8 * c16 + e) * 72 + 8 * rg) = pack8(z); }
        }
    }
    LSYNC();
    for (int id = wave; id < 26; id += 8) {
        if (id >= 20) { const int ui = id - 20; const int tt = ui < 3 ? 0 : (ui < 5 ? 1 : 2), st = ui < 3 ? ui + 1 : (ui < 5 ? ui - 1 : 3);
            *(v2u*)(R1 + (size_t)(tok0 + tt * 16 + c) * D + 512 + h * 128 + st * 16 + 4 * q) = (v2u){0u, 0u}; continue; }
        const int which = id >= 10, li = which ? id - 10 : id; const int tt = li >= 6 ? 3 : (li >= 3 ? 2 : (li >= 1 ? 1 : 0)), st = li - tt * (tt + 1) / 2;
        f32x4 acc = (f32x4){0.f, 0.f, 0.f, 0.f};
        const LAS bf16* Fb = (which ? Qs : Ks) + tt * 16 * 136;
        const int t = tt * 16 + c, s0 = st * 16 + 4 * q;
        bf16x8 fa[4], fb[4];
#pragma unroll
        for (int kc = 0; kc < 4; ++kc) { fa[kc] = ldfrag(Ks + st * 16 * 136 + kc * 32, 136, lane); fb[kc] = ldfrag(Fb + kc * 32, 136, lane); }
        const f32x4 gs4 = *(const LAS f32x4*)(gcS + s0); const float gt = gcS[t]; const float b2 = betaS[t];
        __builtin_amdgcn_sched_barrier(0);
#pragma unroll
        for (int kc = 0; kc < 4; ++kc) acc = MFMA16(fa[kc], fb[kc], acc);
        float vals[4];
#pragma unroll
        for (int r = 0; r < 4; ++r) { const int s = s0 + r; const bool keep = which ? (s <= t) : (s < t); const float e = __expf(fminf(gt - gs4[r], 0.f)); vals[r] = keep ? acc[r] * e : 0.f; }
        if (which == 0) {
#pragma unroll
            for (int r = 0; r < 4; ++r) vals[r] *= b2;
            *(LAS v2u*)(Ab + t * 72 + s0) = (v2u){pk2(vals[0], vals[1]), pk2(vals[2], vals[3])};
            if (tt == st) *(LAS f32x4*)(A16 + tt * 256 + c * 16 + 4 * q) = (f32x4){vals[0], vals[1], vals[2], vals[3]}; }
        else *(v2u*)(R1 + (size_t)(tok0 + t) * D + 512 + h * 128 + s0) = (v2u){pk2(vals[0], vals[1]), pk2(vals[2], vals[3])};
    }
    LSYNC();
    if (wave == 0) {
        { const int bi = q, j = c; float x[16];
          f32x4 ar[16][4];
#pragma unroll
          for (int r = 1; r < 16; ++r)
#pragma unroll
              for (int s4 = 0; s4 < (r + 3) / 4; ++s4) ar[r][s4] = *(const LAS f32x4*)(A16 + bi * 256 + r * 16 + 4 * s4);
#pragma unroll
          for (int r = 0; r < 16; ++r) { float a = (r == j) ? 1.f : 0.f;
#pragma unroll
              for (int s = 0; s < r; ++s) a -= ar[r][s >> 2][s & 3] * x[s];
              x[r] = a; }
          unsigned pk[8];
#pragma unroll
          for (int r = 0; r < 16; r += 2) { pk[r >> 1] = pk2(x[r], x[r + 1]); Tm[(16 * bi + r) * 72 + 16 * bi + j] = (bf16)(pk[r >> 1] & 0xffffu); Tm[(16 * bi + r + 1) * 72 + 16 * bi + j] = (bf16)(pk[r >> 1] >> 16); }
          *(LAS v4u*)(TT + (16 * bi + j) * 72 + 16 * bi) = (v4u){pk[0], pk[1], pk[2], pk[3]}; *(LAS v4u*)(TT + (16 * bi + j) * 72 + 16 * bi + 8) = (v4u){pk[4], pk[5], pk[6], pk[7]}; }
    }
    LSYNC();
#pragma unroll
    for (int d = 1; d < 4; ++d) {
        if (wave < 4 - d) { const int j = wave, i = wave + d; LAS bf16* MTw = MT16 + wave * 16 * 24;
                f32x4 m = (f32x4){0.f, 0.f, 0.f, 0.f};
#pragma unroll
                for (int kc = 0; kc < 2; ++kc) m = MFMA16(ldfrag(Ab + 16 * i * 72 + kc * 32, 72, lane), ldfrag(TT + 16 * j * 72 + kc * 32, 72, lane), m);
                *(LAS v2u*)(MTw + c * 24 + 4 * q) = (v2u){pk2(m[0], m[1]), pk2(m[2], m[3])};
                const bool on = (q >> 1) == (i & 1);
                bf16x8 fa = ldfrag(Tm + 16 * i * 72 + ((16 * i) & ~31), 72, lane); bf16x8 fb = *(const LAS bf16x8*)(MTw + c * 24 + 8 * (q & 1));
                if (!on) { fa = (bf16x8){0, 0, 0, 0, 0, 0, 0, 0}; fb = fa; }
                const f32x4 t2 = MFMA16(fa, fb, ((f32x4){0.f, 0.f, 0.f, 0.f}));
                const unsigned p0 = pk2(-t2[0], -t2[1]), p1 = pk2(-t2[2], -t2[3]);
                *(LAS v2u*)(TT + (16 * j + c) * 72 + 16 * i + 4 * q) = (v2u){p0, p1};
                Tm[(16 * i + 4 * q) * 72 + 16 * j + c] = (bf16)(p0 & 0xffffu); Tm[(16 * i + 4 * q + 1) * 72 + 16 * j + c] = (bf16)(p0 >> 16);
                Tm[(16 * i + 4 * q + 2) * 72 + 16 * j + c] = (bf16)(p1 & 0xffffu); Tm[(16 * i + 4 * q + 3) * 72 + 16 * j + c] = (bf16)(p1 >> 16); }
    }
    LSYNC();
#pragma unroll
    for (int jj = 0; jj < 8; ++jj) { const int id = wave * 8 + jj, isu = id >> 5, tt = (id >> 3) & 3, ct = id & 7;
        f32x4 acc = (f32x4){0.f, 0.f, 0.f, 0.f};
        const LAS bf16* Rr = RHST + (isu * 128 + ct * 16) * 72; const LAS bf16* Tr = Tm + tt * 16 * 72;
        if (!isu) {
#pragma unroll
            for (int kc = 0; kc < 2; ++kc) acc = MFMA16(ldfrag(Rr + kc * 32, 72, lane), ldfrag(Tr + kc * 32, 72, lane), acc);
            *(v2u*)(GW + (tt * 16 + c) * 128 + ct * 16 + 4 * q) = (v2u){pk2(acc[0], acc[1]), pk2(acc[2], acc[3])};
        } else {
#pragma unroll
            for (int kc = 0; kc < 2; ++kc) acc = MFMA16(ldfrag(Tr + kc * 32, 72, lane), ldfrag(Rr + kc * 32, 72, lane), acc);
            *(v2u*)(GU + (ct * 16 + c) * 64 + tt * 16 + 4 * q) = (v2u){pk2(acc[0], acc[1]), pk2(acc[2], acc[3])};
        }
    }
    LSYNC();
}

constexpr int CWS_OFF = MISC_OFF + 4096;
DI void gd_cw_fill(Frame& F, int item) {
    const int h = item & 3; LAS float* cwS = (LAS float*)(F.lds + CWS_OFF);
    for (int i = F.tid; i < 1536; i += NTHR) { const int j = i / 384, r = i % 384; cwS[i] = F.conv_w[j * 1536 + 512 * (r >> 7) + h * 128 + (r & 127)]; }
    if (F.tid == 0) { cwS[1536] = F.dt_bias[h]; cwS[1537] = -__expf(F.a_log[h]); }
    __syncthreads();
}
DI void gd_raw_load_rows(Frame& F, int item, v4u (&raw)[11]) {
    const int h = item & 3, bn = item >> 2, n = bn & 63; const int X = F.wave >> 1, rg = (F.tid >> 4) & 7, c16 = F.tid & 15;
    const bf16* p = (const bf16*)(F.ws + WS_R2) + prb(bn, 16 + 4 * X + h) + 8 * c16;
#pragma unroll
    for (int i = 0; i < 11; ++i) { const int rr = 8 * rg - 3 + i; raw[i] = (v4u){0u, 0u, 0u, 0u};
        if (rr >= 0) raw[i] = *(const v4u*)(p + rr * 128); else if (n > 0) raw[i] = *(const v4u*)(p - (long)32 * 8192 + (64 + rr) * 128); }
}
DI void gd_pre_loop(Frame& F) {
    LAS bf16* Qs = (LAS bf16*)F.lds; LAS bf16* Ks = Qs + 64 * 136; LAS bf16* Ab = Ks + 64 * 136; LAS bf16* Tm = Ab + 64 * 72; LAS bf16* TT = Tm + 64 * 72; LAS bf16* RHST = TT + 64 * 72;
    LAS float* A16 = (LAS float*)(RHST + 256 * 72); LAS bf16* MT16 = (LAS bf16*)(A16 + 1024); LAS float* gcS = (LAS float*)(MT16 + 3 * 16 * 24); LAS float* egcS = gcS + 64; LAS float* betaS = gcS + 128;
    const bf16* PR = (const bf16*)(F.ws + WS_R2); bf16* R1 = (bf16*)(F.ws + WS_R1); const float* AB = (const float*)(F.ws + WS_AB);
    int tidv = F.tid; asm volatile("" : "+v"(tidv));
    const int lane = tidv & 63, wave = F.wave, c = lane & 15, q = lane >> 4;
    const int X = wave >> 1, rg = (tidv >> 4) & 7, c16 = tidv & 15;
    unsigned yp[8][4];
    v4u raw[11]; float pab[2] = {0.f, 0.f};
    int it = F.vcu; if (it >= 4096) return;
    gd_cw_fill(F, it);
    if (wave < 6) gd_raw_load_rows(F, it, raw);
    if (wave == 6) { const int tok = (it >> 2) * 64 + lane; pab[0] = AB[(size_t)tok * 8 + (it & 3)]; pab[1] = AB[(size_t)tok * 8 + 4 + (it & 3)]; }
    { const int item = it; const int h = item & 3, bn = item >> 2, n = bn & 63, tok0 = bn * 64;
      bf16* GW = (bf16*)(F.ws + WS_GW) + (size_t)item * 8192; bf16* GU = (bf16*)(F.ws + WS_GU) + (size_t)item * 8192;
      bf16* GQG = (bf16*)(F.ws + WS_GQG) + (size_t)item * 8192; bf16* GKD = (bf16*)(F.ws + WS_GKD) + (size_t)item * 8192;
      (void)h; (void)n; (void)tok0; (void)GW; (void)GU; (void)GQG; (void)GKD;
      int tv_ = tidv; asm volatile("" : "+v"(tv_)); const int lane = tv_ & 63, c = lane & 15, q = lane >> 4, rg = (tv_ >> 4) & 7, c16 = tv_ & 15; (void)c; (void)q; (void)rg; (void)c16;
      const int next_item = it + F.G < 4096 ? it + F.G : -1;
      float y[8][8];
    if (wave < 6) {
        f32x4 cw[4][2];
#pragma unroll
        for (int j = 0; j < 4; ++j) { const LAS float* wp = (const LAS float*)(F.lds + CWS_OFF) + j * 384 + X * 128 + 8 * c16; cw[j][0] = *(const LAS f32x4*)wp; cw[j][1] = *(const LAS f32x4*)(wp + 4); }
        const int ccol = 512 * X + h * 128 + 8 * c16;
#pragma unroll
        for (int ep = 0; ep < 4; ++ep) {
            float w0[4], w1[4];
#pragma unroll
            for (int j = 0; j < 4; ++j) { w0[j] = cw[j][ep >> 1][(2 * ep) & 3]; w1[j] = cw[j][ep >> 1][((2 * ep) & 3) + 1]; }
            float u0[11], u1[11];
#pragma unroll
            for (int i = 0; i < 11; ++i) { u0[i] = bflo(raw[i][ep]); u1[i] = bfhi(raw[i][ep]); }
#pragma unroll
            for (int t = 0; t < 8; ++t) { float a = u0[t] * w0[0]; a += u0[t + 1] * w0[1]; a += u0[t + 2] * w0[2]; a += u0[t + 3] * w0[3];
                float b = u1[t] * w1[0]; b += u1[t + 1] * w1[1]; b += u1[t + 2] * w1[2]; b += u1[t + 3] * w1[3];
                y[t][2 * ep] = silu(a); y[t][2 * ep + 1] = silu(b); }
        }
#pragma unroll
        for (int t = 0; t < 8; ++t) asm volatile("" :: "v"(y[t][0]), "v"(y[t][1]), "v"(y[t][2]), "v"(y[t][3]), "v"(y[t][4]), "v"(y[t][5]), "v"(y[t][6]), "v"(y[t][7]));
        asm volatile("" ::: "memory");
        if (next_item >= 0) gd_raw_load_rows(F, next_item, raw);
        if (X < 2) {
#pragma unroll
            for (int t = 0; t < 8; ++t) { float s = 0.f;
#pragma unroll
                for (int e = 0; e < 8; ++e) s += y[t][e] * y[t][e];
                s = row16_sum(s); const float r = (X == 0 ? QSCALE : 1.f) * frsq(s + 1e-6f);
#pragma unroll
                for (int e = 0; e < 8; ++e) y[t][e] *= r; }
        }
#pragma unroll
        for (int t = 0; t < 8; ++t)
#pragma unroll
            for (int k = 0; k < 4; ++k) yp[t][k] = pk2(y[t][2 * k], y[t][2 * k + 1]);
    } else if (wave == 6) {
        const float a = pab[0], b = pab[1];
        if (next_item >= 0) { const int nh = next_item & 3, ntok = (next_item >> 2) * 64 + lane; pab[0] = AB[(size_t)ntok * 8 + nh]; pab[1] = AB[(size_t)ntok * 8 + 4 + nh]; }
        const LAS float* hc = (const LAS float*)(F.lds + CWS_OFF) + 1536;
        const float xx = a + hc[0]; const float sp = xx > 20.f ? xx : __logf(1.f + __expf(xx));
        float gc = hc[1] * sp;
#pragma unroll
        for (int o = 1; o < 64; o <<= 1) { const float t = __shfl_up(gc, o); if (lane >= o) gc += t; }
        gcS[lane] = gc; egcS[lane] = __expf(gc); betaS[lane] = frcp(1.f + __expf(-b));
        if (lane == 63) ((float*)(F.ws + WS_GEND))[item] = __expf(gc);
    }
    }
    LSYNC();
    { const int item = it; const int h = item & 3, bn = item >> 2, n = bn & 63, tok0 = bn * 64;
      bf16* GW = (bf16*)(F.ws + WS_GW) + (size_t)item * 8192; bf16* GU = (bf16*)(F.ws + WS_GU) + (size_t)item * 8192;
      bf16* GQG = (bf16*)(F.ws + WS_GQG) + (size_t)item * 8192; bf16* GKD = (bf16*)(F.ws + WS_GKD) + (size_t)item * 8192;
      (void)h; (void)n; (void)tok0; (void)GW; (void)GU; (void)GQG; (void)GKD;
      int tv_ = tidv; asm volatile("" : "+v"(tv_)); const int lane = tv_ & 63, c = lane & 15, q = lane >> 4, rg = (tv_ >> 4) & 7, c16 = tv_ & 15; (void)c; (void)q; (void)rg; (void)c16;
    if (wave < 6) {
        float y[8][8];
#pragma unroll
        for (int t = 0; t < 8; ++t)
#pragma unroll
            for (int k = 0; k < 4; ++k) { y[t][2 * k] = bflo(yp[t][k]); y[t][2 * k + 1] = bfhi(yp[t][k]); }
        const float glast = gcS[63];
        float bt[8], eg[8], kdx[8];
#pragma unroll
        for (int t = 0; t < 8; ++t) { bt[t] = betaS[8 * rg + t]; eg[t] = egcS[8 * rg + t]; kdx[t] = __expf(glast - gcS[8 * rg + t]); }
        if (X == 0) {
#pragma unroll
            for (int t = 0; t < 8; ++t) { *(LAS v4u*)(Qs + (8 * rg + t) * 136 + 8 * c16) = pack8(y[t]);
                float z[8];
#pragma unroll
                for (int e = 0; e < 8; ++e) z[e] = y[t][e] * eg[t];
                *(v4u*)(GQG + (8 * rg + t) * 128 + 8 * c16) = pack8(z); }
        } else if (X == 1) {
#pragma unroll
            for (int t = 0; t < 8; ++t) *(LAS v4u*)(Ks + (8 * rg + t) * 136 + 8 * c16) = pack8(y[t]);
#pragma unroll
            for (int e = 0; e < 8; ++e) { float z[8], z2[8];
#pragma unroll
                for (int t = 0; t < 8; ++t) { z[t] = y[t][e] * bt[t] * eg[t]; z2[t] = y[t][e] * kdx[t]; }
                *(LAS v4u*)(RHST + (8 * c16 + e) * 72 + 8 * rg) = pack8(z); *(v4u*)(GKD + (8 * c16 + e) * 64 + 8 * rg) = pack8(z2); }
        } else {
#pragma unroll
            for (int e = 0; e < 8; ++e) { float z[8];
#pragma unroll
                for (int t = 0; t < 8; ++t) z[t] = y[t][e] * bt[t];
                *(LAS v4u*)(RHST + (128 + 8 * c16 + e) * 72 + 8 * rg) = pack8(z); }
        }
    }
    if (wave == 7) { for (int i = lane; i < 3 * 64 * 72 / 8; i += 64) ((LAS v4u*)Ab)[i] = (v4u){0u, 0u, 0u, 0u}; }
    }
    LSYNC();
    { const int item = it; const int h = item & 3, bn = item >> 2, n = bn & 63, tok0 = bn * 64;
      bf16* GW = (bf16*)(F.ws + WS_GW) + (size_t)item * 8192; bf16* GU = (bf16*)(F.ws + WS_GU) + (size_t)item * 8192;
      bf16* GQG = (bf16*)(F.ws + WS_GQG) + (size_t)item * 8192; bf16* GKD = (bf16*)(F.ws + WS_GKD) + (size_t)item * 8192;
      (void)h; (void)n; (void)tok0; (void)GW; (void)GU; (void)GQG; (void)GKD;
      int tv_ = tidv; asm volatile("" : "+v"(tv_)); const int lane = tv_ & 63, c = lane & 15, q = lane >> 4, rg = (tv_ >> 4) & 7, c16 = tv_ & 15; (void)c; (void)q; (void)rg; (void)c16;
    for (int id = wave; id < 26; id += 8) {
        if (id >= 20) { const int ui = id - 20; const int tt = ui < 3 ? 0 : (ui < 5 ? 1 : 2), st = ui < 3 ? ui + 1 : (ui < 5 ? ui - 1 : 3);
            *(v2u*)(R1 + (size_t)(tok0 + tt * 16 + c) * D + 512 + h * 128 + st * 16 + 4 * q) = (v2u){0u, 0u}; continue; }
        const int which = id >= 10, li = which ? id - 10 : id; const int tt = li >= 6 ? 3 : (li >= 3 ? 2 : (li >= 1 ? 1 : 0)), st = li - tt * (tt + 1) / 2;
        f32x4 acc = (f32x4){0.f, 0.f, 0.f, 0.f};
        const LAS bf16* Fb = (which ? Qs : Ks) + tt * 16 * 136;
        const int t = tt * 16 + c, s0 = st * 16 + 4 * q;
        bf16x8 fa[4], fb[4];
#pragma unroll
        for (int kc = 0; kc < 4; ++kc) { fa[kc] = ldfrag(Ks + st * 16 * 136 + kc * 32, 136, lane); fb[kc] = ldfrag(Fb + kc * 32, 136, lane); }
        const f32x4 gs4 = *(const LAS f32x4*)(gcS + s0); const float gt = gcS[t]; const float b2 = betaS[t];
        __builtin_amdgcn_sched_barrier(0);
#pragma unroll
        for (int kc = 0; kc < 4; ++kc) acc = MFMA16(fa[kc], fb[kc], acc);
        float vals[4];
#pragma unroll
        for (int r = 0; r < 4; ++r) { const int s = s0 + r; const bool keep = which ? (s <= t) : (s < t); const float e = __expf(fminf(gt - gs4[r], 0.f)); vals[r] = keep ? acc[r] * e : 0.f; }
        if (which == 0) {
#pragma unroll
            for (int r = 0; r < 4; ++r) vals[r] *= b2;
            *(LAS v2u*)(Ab + t * 72 + s0) = (v2u){pk2(vals[0], vals[1]), pk2(vals[2], vals[3])};
            if (tt == st) *(LAS f32x4*)(A16 + tt * 256 + c * 16 + 4 * q) = (f32x4){vals[0], vals[1], vals[2], vals[3]}; }
        else *(v2u*)(R1 + (size_t)(tok0 + t) * D + 512 + h * 128 + s0) = (v2u){pk2(vals[0], vals[1]), pk2(vals[2], vals[3])};
    }
    }
    LSYNC();
    for (;;) {
        const int nx = it + F.G < 4096 ? it + F.G : -1;
        if (nx >= 0) {
    { const int item = nx; const int h = item & 3, bn = item >> 2, n = bn & 63, tok0 = bn * 64;
      bf16* GW = (bf16*)(F.ws + WS_GW) + (size_t)item * 8192; bf16* GU = (bf16*)(F.ws + WS_GU) + (size_t)item * 8192;
      bf16* GQG = (bf16*)(F.ws + WS_GQG) + (size_t)item * 8192; bf16* GKD = (bf16*)(F.ws + WS_GKD) + (size_t)item * 8192;
      (void)h; (void)n; (void)tok0; (void)GW; (void)GU; (void)GQG; (void)GKD;
      int tv_ = tidv; asm volatile("" : "+v"(tv_)); const int lane = tv_ & 63, c = lane & 15, q = lane >> 4, rg = (tv_ >> 4) & 7, c16 = tv_ & 15; (void)c; (void)q; (void)rg; (void)c16;
      const int next_item = nx + F.G < 4096 ? nx + F.G : -1;
      float y[8][8];
    if (wave < 6) {
        f32x4 cw[4][2];
#pragma unroll
        for (int j = 0; j < 4; ++j) { const LAS float* wp = (const LAS float*)(F.lds + CWS_OFF) + j * 384 + X * 128 + 8 * c16; cw[j][0] = *(const LAS f32x4*)wp; cw[j][1] = *(const LAS f32x4*)(wp + 4); }
        const int ccol = 512 * X + h * 128 + 8 * c16;
#pragma unroll
        for (int ep = 0; ep < 4; ++ep) {
            float w0[4], w1[4];
#pragma unroll
            for (int j = 0; j < 4; ++j) { w0[j] = cw[j][ep >> 1][(2 * ep) & 3]; w1[j] = cw[j][ep >> 1][((2 * ep) & 3) + 1]; }
            float u0[11], u1[11];
#pragma unroll
            for (int i = 0; i < 11; ++i) { u0[i] = bflo(raw[i][ep]); u1[i] = bfhi(raw[i][ep]); }
#pragma unroll
            for (int t = 0; t < 8; ++t) { float a = u0[t] * w0[0]; a += u0[t + 1] * w0[1]; a += u0[t + 2] * w0[2]; a += u0[t + 3] * w0[3];
                float b = u1[t] * w1[0]; b += u1[t + 1] * w1[1]; b += u1[t + 2] * w1[2]; b += u1[t + 3] * w1[3];
                y[t][2 * ep] = silu(a); y[t][2 * ep + 1] = silu(b); }
        }
#pragma unroll
        for (int t = 0; t < 8; ++t) asm volatile("" :: "v"(y[t][0]), "v"(y[t][1]), "v"(y[t][2]), "v"(y[t][3]), "v"(y[t][4]), "v"(y[t][5]), "v"(y[t][6]), "v"(y[t][7]));
        asm volatile("" ::: "memory");
        if (next_item >= 0) gd_raw_load_rows(F, next_item, raw);
        if (X < 2) {
#pragma unroll
            for (int t = 0; t < 8; ++t) { float s = 0.f;
#pragma unroll
                for (int e = 0; e < 8; ++e) s += y[t][e] * y[t][e];
                s = row16_sum(s); const float r = (X == 0 ? QSCALE : 1.f) * frsq(s + 1e-6f);
#pragma unroll
                for (int e = 0; e < 8; ++e) y[t][e] *= r; }
        }
#pragma unroll
        for (int t = 0; t < 8; ++t)
#pragma unroll
            for (int k = 0; k < 4; ++k) yp[t][k] = pk2(y[t][2 * k], y[t][2 * k + 1]);
    } else if (wave == 6) {
        const float a = pab[0], b = pab[1];
        if (next_item >= 0) { const int nh = next_item & 3, ntok = (next_item >> 2) * 64 + lane; pab[0] = AB[(size_t)ntok * 8 + nh]; pab[1] = AB[(size_t)ntok * 8 + 4 + nh]; }
        const LAS float* hc = (const LAS float*)(F.lds + CWS_OFF) + 1536;
        const float xx = a + hc[0]; const float sp = xx > 20.f ? xx : __logf(1.f + __expf(xx));
        float gc = hc[1] * sp;
#pragma unroll
        for (int o = 1; o < 64; o <<= 1) { const float t = __shfl_up(gc, o); if (lane >= o) gc += t; }
        gcS[lane] = gc; egcS[lane] = __expf(gc); betaS[lane] = frcp(1.f + __expf(-b));
        if (lane == 63) ((float*)(F.ws + WS_GEND))[item] = __expf(gc);
    }
    }
        } else {
#pragma unroll
            for (int t = 0; t < 8; ++t)
#pragma unroll
                for (int e = 0; e < 4; ++e) yp[t][e] = 0u;
        }
    { int tv_ = tidv; asm volatile("" : "+v"(tv_)); const int lane = tv_ & 63, c = lane & 15, q = lane >> 4;
    if (wave >= 6) {
        { const int bi = q, j = c; float x[16];
          f32x4 ar[16][4];
#pragma unroll
          for (int r = 1; r < 16; ++r)
#pragma unroll
              for (int s4 = 0; s4 < (r + 3) / 4; ++s4) ar[r][s4] = *(const LAS f32x4*)(A16 + bi * 256 + r * 16 + 4 * s4);
#pragma unroll
          for (int r = 0; r < 16; ++r) { float a = (r == j) ? 1.f : 0.f;
#pragma unroll
              for (int s = 0; s < r; ++s) a -= ar[r][s >> 2][s & 3] * x[s];
              x[r] = a; }
          unsigned pk[8];
#pragma unroll
          for (int r = 0; r < 16; r += 2) { pk[r >> 1] = pk2(x[r], x[r + 1]); Tm[(16 * bi + r) * 72 + 16 * bi + j] = (bf16)(pk[r >> 1] & 0xffffu); Tm[(16 * bi + r + 1) * 72 + 16 * bi + j] = (bf16)(pk[r >> 1] >> 16); }
          *(LAS v4u*)(TT + (16 * bi + j) * 72 + 16 * bi) = (v4u){pk[0], pk[1], pk[2], pk[3]}; *(LAS v4u*)(TT + (16 * bi + j) * 72 + 16 * bi + 8) = (v4u){pk[4], pk[5], pk[6], pk[7]}; }
    }
    for (int st_ = 0; st_ < 4; ++st_) {
        if (wave >= 6 && (wave == 7 || st_ < 2)) { const int j = wave == 7 ? (st_ < 3 ? 0 : 2) : 1, i = wave == 7 ? (st_ < 3 ? st_ + 1 : 3) : st_ + 2; LAS bf16* MTw = MT16 + (wave - 6) * 16 * 24;
                f32x4 m = (f32x4){0.f, 0.f, 0.f, 0.f};
#pragma unroll
                for (int kc = 0; kc < 2; ++kc) m = MFMA16(ldfrag(Ab + 16 * i * 72 + kc * 32, 72, lane), ldfrag(TT + 16 * j * 72 + kc * 32, 72, lane), m);
                *(LAS v2u*)(MTw + c * 24 + 4 * q) = (v2u){pk2(m[0], m[1]), pk2(m[2], m[3])};
                const bool on = (q >> 1) == (i & 1);
                bf16x8 fa = ldfrag(Tm + 16 * i * 72 + ((16 * i) & ~31), 72, lane); bf16x8 fb = *(const LAS bf16x8*)(MTw + c * 24 + 8 * (q & 1));
                if (!on) { fa = (bf16x8){0, 0, 0, 0, 0, 0, 0, 0}; fb = fa; }
                const f32x4 t2 = MFMA16(fa, fb, ((f32x4){0.f, 0.f, 0.f, 0.f}));
                const unsigned p0 = pk2(-t2[0], -t2[1]), p1 = pk2(-t2[2], -t2[3]);
                *(LAS v2u*)(TT + (16 * j + c) * 72 + 16 * i + 4 * q) = (v2u){p0, p1};
                Tm[(16 * i + 4 * q) * 72 + 16 * j + c] = (bf16)(p0 & 0xffffu); Tm[(16 * i + 4 * q + 1) * 72 + 16 * j + c] = (bf16)(p0 >> 16);
                Tm[(16 * i + 4 * q + 2) * 72 + 16 * j + c] = (bf16)(p1 & 0xffffu); Tm[(16 * i + 4 * q + 3) * 72 + 16 * j + c] = (bf16)(p1 >> 16); }
    }
    }
    LSYNC();
    { const int item = it; const int h = item & 3, bn = item >> 2, n = bn & 63, tok0 = bn * 64;
      bf16* GW = (bf16*)(F.ws + WS_GW) + (size_t)item * 8192; bf16* GU = (bf16*)(F.ws + WS_GU) + (size_t)item * 8192;
      bf16* GQG = (bf16*)(F.ws + WS_GQG) + (size_t)item * 8192; bf16* GKD = (bf16*)(F.ws + WS_GKD) + (size_t)item * 8192;
      (void)h; (void)n; (void)tok0; (void)GW; (void)GU; (void)GQG; (void)GKD;
      int tv_ = tidv; asm volatile("" : "+v"(tv_)); const int lane = tv_ & 63, c = lane & 15, q = lane >> 4, rg = (tv_ >> 4) & 7, c16 = tv_ & 15; (void)c; (void)q; (void)rg; (void)c16;
#pragma unroll
    for (int jj = 0; jj < 8; ++jj) { const int id = wave * 8 + jj, isu = id >> 5, tt = (id >> 3) & 3, ct = id & 7;
        f32x4 acc = (f32x4){0.f, 0.f, 0.f, 0.f};
        const LAS bf16* Rr = RHST + (isu * 128 + ct * 16) * 72; const LAS bf16* Tr = Tm + tt * 16 * 72;
        if (!isu) {
#pragma unroll
            for (int kc = 0; kc < 2; ++kc) acc = MFMA16(ldfrag(Rr + kc * 32, 72, lane), ldfrag(Tr + kc * 32, 72, lane), acc);
            *(v2u*)(GW + (tt * 16 + c) * 128 + ct * 16 + 4 * q) = (v2u){pk2(acc[0], acc[1]), pk2(acc[2], acc[3])};
        } else {
#pragma unroll
            for (int kc = 0; kc < 2; ++kc) acc = MFMA16(ldfrag(Tr + kc * 32, 72, lane), ldfrag(Rr + kc * 32, 72, lane), acc);
            *(v2u*)(GU + (ct * 16 + c) * 64 + tt * 16 + 4 * q) = (v2u){pk2(acc[0], acc[1]), pk2(acc[2], acc[3])};
        }
    }
    }
    LSYNC();
        if (nx < 0) break;
    { const int item = nx; const int h = item & 3, bn = item >> 2, n = bn & 63, tok0 = bn * 64;
      bf16* GW = (bf16*)(F.ws + WS_GW) + (size_t)item * 8192; bf16* GU = (bf16*)(F.ws + WS_GU) + (size_t)item * 8192;
      bf16* GQG = (bf16*)(F.ws + WS_GQG) + (size_t)item * 8192; bf16* GKD = (bf16*)(F.ws + WS_GKD) + (size_t)item * 8192;
      (void)h; (void)n; (void)tok0; (void)GW; (void)GU; (void)GQG; (void)GKD;
      int tv_ = tidv; asm volatile("" : "+v"(tv_)); const int lane = tv_ & 63, c = lane & 15, q = lane >> 4, rg = (tv_ >> 4) & 7, c16 = tv_ & 15; (void)c; (void)q; (void)rg; (void)c16;
    if (wave < 6) {
        float y[8][8];
#pragma unroll
        for (int t = 0; t < 8; ++t)
#pragma unroll
            for (int k = 0; k < 4; ++k) { y[t][2 * k] = bflo(yp[t][k]); y[t][2 * k + 1] = bfhi(yp[t][k]); }
        const float glast = gcS[63];
        float bt[8], eg[8], kdx[8];
#pragma unroll
        for (int t = 0; t < 8; ++t) { bt[t] = betaS[8 * rg + t]; eg[t] = egcS[8 * rg + t]; kdx[t] = __expf(glast - gcS[8 * rg + t]); }
        if (X == 0) {
#pragma unroll
            for (int t = 0; t < 8; ++t) { *(LAS v4u*)(Qs + (8 * rg + t) * 136 + 8 * c16) = pack8(y[t]);
                float z[8];
#pragma unroll
                for (int e = 0; e < 8; ++e) z[e] = y[t][e] * eg[t];
                *(v4u*)(GQG + (8 * rg + t) * 128 + 8 * c16) = pack8(z); }
        } else if (X == 1) {
#pragma unroll
            for (int t = 0; t < 8; ++t) *(LAS v4u*)(Ks + (8 * rg + t) * 136 + 8 * c16) = pack8(y[t]);
#pragma unroll
            for (int e = 0; e < 8; ++e) { float z[8], z2[8];
#pragma unroll
                for (int t = 0; t < 8; ++t) { z[t] = y[t][e] * bt[t] * eg[t]; z2[t] = y[t][e] * kdx[t]; }
                *(LAS v4u*)(RHST + (8 * c16 + e) * 72 + 8 * rg) = pack8(z); *(v4u*)(GKD + (8 * c16 + e) * 64 + 8 * rg) = pack8(z2); }
        } else {
#pragma unroll
            for (int e = 0; e < 8; ++e) { float z[8];
#pragma unroll
                for (int t = 0; t < 8; ++t) z[t] = y[t][e] * bt[t];
                *(LAS v4u*)(RHST + (128 + 8 * c16 + e) * 72 + 8 * rg) = pack8(z); }
        }
    }
    if (wave == 7) { for (int i = lane; i < 3 * 64 * 72 / 8; i += 64) ((LAS v4u*)Ab)[i] = (v4u){0u, 0u, 0u, 0u}; }
    }
    LSYNC();
    { const int item = nx; const int h = item & 3, bn = item >> 2, n = bn & 63, tok0 = bn * 64;
      bf16* GW = (bf16*)(F.ws + WS_GW) + (size_t)item * 8192; bf16* GU = (bf16*)(F.ws + WS_GU) + (size_t)item * 8192;
      bf16* GQG = (bf16*)(F.ws + WS_GQG) + (size_t)item * 8192; bf16* GKD = (bf16*)(F.ws + WS_GKD) + (size_t)item * 8192;
      (void)h; (void)n; (void)tok0; (void)GW; (void)GU; (void)GQG; (void)GKD;
      int tv_ = tidv; asm volatile("" : "+v"(tv_)); const int lane = tv_ & 63, c = lane & 15, q = lane >> 4, rg = (tv_ >> 4) & 7, c16 = tv_ & 15; (void)c; (void)q; (void)rg; (void)c16;
    for (int id = wave; id < 26; id += 8) {
        if (id >= 20) { const int ui = id - 20; const int tt = ui < 3 ? 0 : (ui < 5 ? 1 : 2), st = ui < 3 ? ui + 1 : (ui < 5 ? ui - 1 : 3);
            *(v2u*)(R1 + (size_t)(tok0 + tt * 16 + c) * D + 512 + h * 128 + st * 16 + 4 * q) = (v2u){0u, 0u}; continue; }
        const int which = id >= 10, li = which ? id - 10 : id; const int tt = li >= 6 ? 3 : (li >= 3 ? 2 : (li >= 1 ? 1 : 0)), st = li - tt * (tt + 1) / 2;
        f32x4 acc = (f32x4){0.f, 0.f, 0.f, 0.f};
        const LAS bf16* Fb = (which ? Qs : Ks) + tt * 16 * 136;
        const int t = tt * 16 + c, s0 = st * 16 + 4 * q;
        bf16x8 fa[4], fb[4];
#pragma unroll
        for (int kc = 0; kc < 4; ++kc) { fa[kc] = ldfrag(Ks + st * 16 * 136 + kc * 32, 136, lane); fb[kc] = ldfrag(Fb + kc * 32, 136, lane); }
        const f32x4 gs4 = *(const LAS f32x4*)(gcS + s0); const float gt = gcS[t]; const float b2 = betaS[t];
        __builtin_amdgcn_sched_barrier(0);
#pragma unroll
        for (int kc = 0; kc < 4; ++kc) acc = MFMA16(fa[kc], fb[kc], acc);
        float vals[4];
#pragma unroll
        for (int r = 0; r < 4; ++r) { const int s = s0 + r; const bool keep = which ? (s <= t) : (s < t); const float e = __expf(fminf(gt - gs4[r], 0.f)); vals[r] = keep ? acc[r] * e : 0.f; }
        if (which == 0) {
#pragma unroll
            for (int r = 0; r < 4; ++r) vals[r] *= b2;
            *(LAS v2u*)(Ab + t * 72 + s0) = (v2u){pk2(vals[0], vals[1]), pk2(vals[2], vals[3])};
            if (tt == st) *(LAS f32x4*)(A16 + tt * 256 + c * 16 + 4 * q) = (f32x4){vals[0], vals[1], vals[2], vals[3]}; }
        else *(v2u*)(R1 + (size_t)(tok0 + t) * D + 512 + h * 128 + s0) = (v2u){pk2(vals[0], vals[1]), pk2(vals[2], vals[3])};
    }
    }
    LSYNC();
        it = nx;
    }
}

#define MKRSRC(ptr) __builtin_amdgcn_make_buffer_rsrc((void*)(ptr), 0, 0x7fffffff, 0x00020000)
#define BLD128(rs, vo, so) __builtin_bit_cast(v4u, __builtin_amdgcn_raw_buffer_load_b128((rs), (int)(vo), (int)(so), 0))
DI float qsum(float p) { p += __shfl_xor(p, 16); p += __shfl_xor(p, 32); return p; }
DI bf16x8 ldfragP(const LAS bf16* base, int ld, int lane) {
    const LAS bf16* p = base + (lane & 15) * ld + 4 * (lane >> 4); const v2u lo = *(const LAS v2u*)p, hi = *(const LAS v2u*)(p + 16);
    return __builtin_bit_cast(bf16x8, (v4u){lo.x, lo.y, hi.x, hi.y}); }
DI bf16x8 accpair(const f32x4 a, const f32x4 b) { return __builtin_bit_cast(bf16x8, (v4u){pk2(a[0], a[1]), pk2(a[2], a[3]), pk2(b[0], b[1]), pk2(b[2], b[3])}); }
DI bf16x8 accpair_neg(const f32x4 a, const f32x4 b) { return __builtin_bit_cast(bf16x8, (v4u){pk2(-a[0], -a[1]), pk2(-a[2], -a[3]), pk2(-b[0], -b[1]), pk2(-b[2], -b[3])}); }
DI f32x4 ld4bf(const LAS bf16* p) { const v2u x = *(const LAS v2u*)p; return (f32x4){bflo(x.x), bfhi(x.x), bflo(x.y), bfhi(x.y)}; }

template <int NOLOAD>
DI void hg_chain(Frame& F, int b, int h, unsigned char* OGo, unsigned* prog) {
    LAS bf16* A1 = (LAS bf16*)F.lds; LAS bf16* A2 = A1 + 64 * 136; LAS bf16* B2 = A2 + 128 * 72; LAS bf16* Gs = B2 + 128 * 72; LAS bf16* Is = Gs + 64 * 136; LAS bf16* OGs = Is + 64 * 136;
    LAS float* dl = (LAS float*)(OGs + 64 * 136); LAS float* PS = dl + 128;
    const bf16* PR = (const bf16*)(F.ws + WS_R2); const bf16* R1 = (const bf16*)(F.ws + WS_R1); const float* DL = (const float*)(F.ws + WS_DLAST);
    const int tid = F.tid, lane0 = F.lane, w = F.wave;
    if (w >= 4) {
        int lt_ = tid - 256; asm volatile("" : "+v"(lt_));
        const int lt = lt_, r1 = lt >> 2, s1 = lt & 3, k2 = lt >> 1, s2 = lt & 1;
        const unsigned oA1 = (unsigned)(r1 * 128 + s1 * 32), oA2 = (unsigned)(4 * 8192 + k2 * 64 + s2 * 32), oB2 = oA2 + 4u * 8192u, oG = oA1 + 12u * 8192u;
        const unsigned oI = (unsigned)(r1 * D + h * 128 + s1 * 32);
        const __amdgpu_buffer_rsrc_t rsP = MKRSRC(PR), rsI = MKRSRC(R1);
        v4u paA[4], pbA[4], pcA[4], pgA[4], piA[4]; float pdlA = 0.f;
        v4u paB[4], pbB[4], pcB[4], pgB[4], piB[4]; float pdlB = 0.f;
#define HG_LOAD(X, n_) do { const int bn_ = b * 64 + (n_); const unsigned so_ = (unsigned)(prb(bn_, h) * 2), si_ = (unsigned)(bn_ * 64 * D * 2); \
            _Pragma("unroll") for (int i_ = 0; i_ < 4; ++i_) { pa##X[i_] = BLD128(rsP, 2u * oA1 + 16u * i_, so_); pb##X[i_] = BLD128(rsP, 2u * oA2 + 16u * i_, so_); pc##X[i_] = BLD128(rsP, 2u * oB2 + 16u * i_, so_); \
                pg##X[i_] = BLD128(rsP, 2u * oG + 16u * i_, so_); pi##X[i_] = BLD128(rsI, 2u * oI + 16u * i_, si_); } \
            if (lt < 128) pdl##X = DL[(size_t)(bn_ * 4 + h) * 128 + lt]; } while (0)
#define HG_ITER(X, n_) do { \
            if ((n_) < NCH) { \
_Pragma("unroll") \
                for (int i = 0; i < 4; ++i) { *(LAS v4u*)(A1 + r1 * 136 + s1 * 32 + 8 * i) = pa##X[i]; *(LAS v4u*)(A2 + k2 * 72 + s2 * 32 + 8 * i) = pb##X[i]; *(LAS v4u*)(B2 + k2 * 72 + s2 * 32 + 8 * i) = pc##X[i]; \
                    *(LAS v4u*)(Gs + r1 * 136 + s1 * 32 + 8 * i) = pg##X[i]; *(LAS v4u*)(Is + r1 * 136 + s1 * 32 + 8 * i) = pi##X[i]; } \
                if (lt < 128) dl[lt] = pdl##X; \
            } \
            LSYNC(); \
            if (lt == 0) __hip_atomic_store(prog, (unsigned)((n_) + 1), __ATOMIC_RELAXED, __HIP_MEMORY_SCOPE_AGENT); \
            if ((n_) + 2 < NCH) HG_LOAD(X, (n_) + 2); \
            if ((n_) > 0) { \
                unsigned char* orow = OGo + (size_t)((b * 64 + (n_) - 1) * 64 + r1) * OG_PITCH; \
                if ((h) < OG_NF) { \
                    unsigned char* og = orow + (h) * 128 + s1 * 32; \
                    unsigned o8[8]; \
_Pragma("unroll") \
                    for (int i = 0; i < 4; ++i) { const v4u t = *(const LAS v4u*)(OGs + r1 * 136 + s1 * 32 + 8 * i); \
                        o8[2 * i] = pk4_fp8(bflo(t.x), bfhi(t.x), bflo(t.y), bfhi(t.y)); o8[2 * i + 1] = pk4_fp8(bflo(t.z), bfhi(t.z), bflo(t.w), bfhi(t.w)); } \
                    __builtin_nontemporal_store((v4u){o8[0], o8[1], o8[2], o8[3]}, (v4u*)og); __builtin_nontemporal_store((v4u){o8[4], o8[5], o8[6], o8[7]}, (v4u*)(og + 16)); \
                } else { \
                    unsigned char* og = orow + OG_NF * 128 + ((h) - OG_NF) * 256 + s1 * 64; \
_Pragma("unroll") \
                    for (int i = 0; i < 4; ++i) *(v4u*)(og + 16 * i) = *(const LAS v4u*)(OGs + r1 * 136 + s1 * 32 + 8 * i); \
                } \
            } \
            LSYNC(); } while (0)
        HG_LOAD(A, 0); HG_LOAD(B, 1);
        for (int n = 0; n < NCH; n += 2) { HG_ITER(A, n); HG_ITER(B, n + 1); }
        HG_ITER(A, NCH);
#undef HG_ITER
#undef HG_LOAD
    } else {
        int ln_ = lane0; asm volatile("" : "+v"(ln_)); const int lane = ln_, c = lane & 15, q = lane >> 4;
        f32x4 onw4[2];
#pragma unroll
        for (int j = 0; j < 2; ++j) onw4[j] = *(const f32x4*)(F.hg_onorm_w + 32 * w + 16 * j + 4 * q);
        f32x4 S[2][8];
#pragma unroll
        for (int j = 0; j < 2; ++j)
#pragma unroll
            for (int kt = 0; kt < 8; ++kt) S[j][kt] = (f32x4){0.f, 0.f, 0.f, 0.f};
        for (int n = 0; n <= NCH; ++n) {
            LSYNC();
            if (n == NCH) { LSYNC(); break; }
            f32x4 oacc[2][4];
            bf16x8 fr[3][4], bb[2][2];
#define HG_LD(buf, g) do { if ((g) < 4) { _Pragma("unroll") for (int i_ = 0; i_ < 4; ++i_) buf[i_] = ldfragP(A1 + i_ * 16 * 136 + (g) * 32, 136, lane); } \
                else { const int tc_ = ((g) - 4) >> 1, hf_ = ((g) - 4) & 1; _Pragma("unroll") for (int i_ = 0; i_ < 4; ++i_) buf[i_] = ldfrag(A2 + (hf_ * 4 + i_) * 16 * 72 + tc_ * 32, 72, lane); \
                    if (hf_ == 0) { bb[tc_][0] = ldfrag(B2 + (32 * w) * 72 + tc_ * 32, 72, lane); bb[tc_][1] = ldfrag(B2 + (32 * w + 16) * 72 + tc_ * 32, 72, lane); } } } while (0)
#define HG_MM(buf, g) do { if ((g) < 4) { const bf16x8 s0_ = accpair(S[0][2 * (g)], S[0][2 * (g) + 1]), s1_ = accpair(S[1][2 * (g)], S[1][2 * (g) + 1]); \
                    _Pragma("unroll") for (int i_ = 0; i_ < 4; ++i_) { oacc[0][i_] = MFMA16(s0_, buf[i_], oacc[0][i_]); oacc[1][i_] = MFMA16(s1_, buf[i_], oacc[1][i_]); } } \
                else { const int tc_ = ((g) - 4) >> 1, hf_ = ((g) - 4) & 1; _Pragma("unroll") for (int i_ = 0; i_ < 4; ++i_) { S[0][hf_ * 4 + i_] = MFMA16(buf[i_], bb[tc_][0], S[0][hf_ * 4 + i_]); S[1][hf_ * 4 + i_] = MFMA16(buf[i_], bb[tc_][1], S[1][hf_ * 4 + i_]); } } } while (0)
#define HG_STEP(g) do { if ((g) + 2 < 8) HG_LD(fr[((g) + 2) % 3], (g) + 2); __builtin_amdgcn_sched_barrier(0); HG_MM(fr[(g) % 3], g); __builtin_amdgcn_sched_barrier(0); } while (0)
            HG_LD(fr[0], 0); HG_LD(fr[1], 1);
#pragma unroll
            for (int j = 0; j < 2; ++j)
#pragma unroll
                for (int tt = 0; tt < 4; ++tt) oacc[j][tt] = ld4bf(Is + (tt * 16 + c) * 136 + 32 * w + 16 * j + 4 * q);
            HG_STEP(0); HG_STEP(1); HG_STEP(2);
            { f32x4 d4[8];
#pragma unroll
              for (int kt = 0; kt < 8; ++kt) d4[kt] = *(const LAS f32x4*)(dl + kt * 16 + 4 * q);
              HG_STEP(3);
#pragma unroll
              for (int kt = 0; kt < 8; ++kt) { S[0][kt] = S[0][kt] * d4[kt]; S[1][kt] = S[1][kt] * d4[kt]; } }
            HG_STEP(4); HG_STEP(5); HG_STEP(6); HG_STEP(7);
#undef HG_LD
#undef HG_MM
#undef HG_STEP
            f32x4 g4[2][4];
#pragma unroll
            for (int j = 0; j < 2; ++j)
#pragma unroll
                for (int tt = 0; tt < 4; ++tt) g4[j][tt] = ld4bf(Gs + (tt * 16 + c) * 136 + 32 * w + 16 * j + 4 * q);
#pragma unroll
            for (int tt = 0; tt < 4; ++tt) { const f32x4 o0 = oacc[0][tt], o1 = oacc[1][tt];
                const float p = qsum(((o0[0] * o0[0] + o0[1] * o0[1]) + (o0[2] * o0[2] + o0[3] * o0[3])) + ((o1[0] * o1[0] + o1[1] * o1[1]) + (o1[2] * o1[2] + o1[3] * o1[3])));
                if (q == 0) PS[(tt * 16 + c) * 4 + w] = p; }
            LSYNC();
#pragma unroll
            for (int tt = 0; tt < 4; ++tt) { const f32x4 pa4 = *(const LAS f32x4*)(PS + (tt * 16 + c) * 4);
                const float rstd = frsq(((pa4.x + pa4.y) + (pa4.z + pa4.w)) * (1.f / 128.f) + EPS);
#pragma unroll
                for (int j = 0; j < 2; ++j) { const f32x4 o = oacc[j][tt] * onw4[j] * rstd; const f32x4 g = g4[j][tt];
                    *(LAS v2u*)(OGs + (tt * 16 + c) * 136 + 32 * w + 16 * j + 4 * q) = (v2u){pk2(o[0] * g[0], o[1] * g[1]), pk2(o[2] * g[2], o[3] * g[3])}; } }
        }
    }
    LSYNC();
}

template <int NOLOAD>
DI void gd_chain(Frame& F, int b, int h, unsigned char* OGo, unsigned* prog) {
    LAS bf16* W = (LAS bf16*)F.lds; LAS bf16* QG = W + 64 * 136; LAS bf16* QK = QG + 64 * 136; LAS bf16* KD = QK + 64 * 72; LAS bf16* UT = KD + 128 * 72; LAS bf16* Gs = UT + 128 * 72; LAS bf16* OGs = Gs + 64 * 136;
    LAS float* PS = (LAS float*)(OGs + 64 * 136);
    const bf16* PR = (const bf16*)(F.ws + WS_R2); const bf16* R1 = (const bf16*)(F.ws + WS_R1); const float* GEND = (const float*)(F.ws + WS_GEND);
    const int tid = F.tid, lane0 = F.lane, w = F.wave;
    if (w >= 4) {
        int lt_ = tid - 256; asm volatile("" : "+v"(lt_));
        const int lt = lt_, r1 = lt >> 2, s1 = lt & 3, k2 = lt >> 1, s2 = lt & 1;
        const unsigned oQk = (unsigned)(r1 * D + 512 + h * 128 + s1 * 16), oW = (unsigned)(r1 * 128 + s1 * 32), oK = (unsigned)(k2 * 64 + s2 * 32);
        const __amdgpu_buffer_rsrc_t rsW = MKRSRC(F.ws + WS_GW), rsQ = MKRSRC(F.ws + WS_GQG), rsK = MKRSRC(F.ws + WS_GKD), rsU = MKRSRC(F.ws + WS_GU), rsI = MKRSRC(R1), rsP = MKRSRC(PR);
        v4u pwA[4], pqA[4], pkA[2], pdA[4], puA[4], pgA[4]; float pgeA = 0.f;
        v4u pwB[4], pqB[4], pkB[2], pdB[4], puB[4], pgB[4]; float pgeB = 0.f;
#define GD_LOAD(X, n_) do { const int bn_ = b * 64 + (n_); const unsigned so_ = (unsigned)((bn_ * 4 + h) * 16384), sg_ = (unsigned)(prb(bn_, 28 + h) * 2); \
            _Pragma("unroll") for (int i_ = 0; i_ < 4; ++i_) { pw##X[i_] = BLD128(rsW, 2u * oW + 16u * i_, so_); pq##X[i_] = BLD128(rsQ, 2u * oW + 16u * i_, so_); pd##X[i_] = BLD128(rsK, 2u * oK + 16u * i_, so_); \
                pu##X[i_] = BLD128(rsU, 2u * oK + 16u * i_, so_); pg##X[i_] = BLD128(rsP, 2u * oW + 16u * i_, sg_); } \
            pk##X[0] = BLD128(rsI, 2u * oQk, (unsigned)(bn_ * 64 * D * 2)); pk##X[1] = BLD128(rsI, 2u * oQk + 16u, (unsigned)(bn_ * 64 * D * 2)); pge##X = GEND[bn_ * 4 + h]; } while (0)
#define GD_ITER(X, n_) do { \
            if ((n_) < NCH) { \
_Pragma("unroll") \
                for (int i = 0; i < 4; ++i) { *(LAS v4u*)(W + r1 * 136 + s1 * 32 + 8 * i) = pw##X[i]; *(LAS v4u*)(QG + r1 * 136 + s1 * 32 + 8 * i) = pq##X[i]; *(LAS v4u*)(KD + k2 * 72 + s2 * 32 + 8 * i) = pd##X[i]; \
                    *(LAS v4u*)(UT + k2 * 72 + s2 * 32 + 8 * i) = pu##X[i]; *(LAS v4u*)(Gs + r1 * 136 + s1 * 32 + 8 * i) = pg##X[i]; } \
                *(LAS v4u*)(QK + r1 * 72 + s1 * 16) = pk##X[0]; *(LAS v4u*)(QK + r1 * 72 + s1 * 16 + 8) = pk##X[1]; if (lt == 0) PS[1024] = pge##X; \
            } \
            LSYNC(); \
            if (lt == 0) __hip_atomic_store(prog, (unsigned)((n_) + 1), __ATOMIC_RELAXED, __HIP_MEMORY_SCOPE_AGENT); \
            if ((n_) + 2 < NCH) GD_LOAD(X, (n_) + 2); \
            if ((n_) > 0) { \
                unsigned char* orow = OGo + (size_t)((b * 64 + (n_) - 1) * 64 + r1) * OG_PITCH; \
                if ((4 + h) < OG_NF) { \
                    unsigned char* og = orow + (4 + h) * 128 + s1 * 32; \
                    unsigned o8[8]; \
_Pragma("unroll") \
                    for (int i = 0; i < 4; ++i) { const v4u t = *(const LAS v4u*)(OGs + r1 * 136 + s1 * 32 + 8 * i); \
                        o8[2 * i] = pk4_fp8(bflo(t.x), bfhi(t.x), bflo(t.y), bfhi(t.y)); o8[2 * i + 1] = pk4_fp8(bflo(t.z), bfhi(t.z), bflo(t.w), bfhi(t.w)); } \
                    __builtin_nontemporal_store((v4u){o8[0], o8[1], o8[2], o8[3]}, (v4u*)og); __builtin_nontemporal_store((v4u){o8[4], o8[5], o8[6], o8[7]}, (v4u*)(og + 16)); \
                } else { \
                    unsigned char* og = orow + OG_NF * 128 + ((4 + h) - OG_NF) * 256 + s1 * 64; \
_Pragma("unroll") \
                    for (int i = 0; i < 4; ++i) *(v4u*)(og + 16 * i) = *(const LAS v4u*)(OGs + r1 * 136 + s1 * 32 + 8 * i); \
                } \
            } \
            LSYNC(); } while (0)
        GD_LOAD(A, 0); GD_LOAD(B, 1);
        for (int n = 0; n < NCH; n += 2) { GD_ITER(A, n); GD_ITER(B, n + 1); }
        GD_ITER(A, NCH);
#undef GD_ITER
#undef GD_LOAD
    } else {
        int ln_ = lane0; asm volatile("" : "+v"(ln_)); const int lane = ln_, c = lane & 15, q = lane >> 4;
        f32x4 onw4[2];
#pragma unroll
        for (int j = 0; j < 2; ++j) onw4[j] = *(const f32x4*)(F.gd_onorm_w + 32 * w + 16 * j + 4 * q);
        f32x4 S[2][8];
#pragma unroll
        for (int j = 0; j < 2; ++j)
#pragma unroll
            for (int kt = 0; kt < 8; ++kt) S[j][kt] = (f32x4){0.f, 0.f, 0.f, 0.f};
        for (int n = 0; n <= NCH; ++n) {
            LSYNC();
            if (n == NCH) { LSYNC(); break; }
            const float gend = PS[1024];
            f32x4 vacc[2][4], oacc[2][4];
            bf16x8 fr[3][4], p0, p1;
#define GD_LD(buf, g) do { if ((g) < 8) { const LAS bf16* bs_ = (((g) & 1) ? QG : W) + ((g) >> 1) * 32; _Pragma("unroll") for (int i_ = 0; i_ < 4; ++i_) buf[i_] = ldfragP(bs_ + i_ * 16 * 136, 136, lane); } \
                else { const int sc_ = ((g) - 8) / 3, sub_ = ((g) - 8) % 3; const LAS bf16* bs_ = (sub_ == 0 ? QK : KD + (sub_ - 1) * 4 * 16 * 72) + sc_ * 32; \
                    _Pragma("unroll") for (int i_ = 0; i_ < 4; ++i_) buf[i_] = ldfragP(bs_ + i_ * 16 * 72, 72, lane); } } while (0)
#define GD_MM(buf, g) do { if ((g) < 8) { if (((g) & 1) == 0) { p0 = accpair(S[0][(g)], S[0][(g) + 1]); p1 = accpair(S[1][(g)], S[1][(g) + 1]); \
                        _Pragma("unroll") for (int i_ = 0; i_ < 4; ++i_) { vacc[0][i_] = MFMA16(buf[i_], p0, vacc[0][i_]); vacc[1][i_] = MFMA16(buf[i_], p1, vacc[1][i_]); } } \
                    else { _Pragma("unroll") for (int i_ = 0; i_ < 4; ++i_) { oacc[0][i_] = MFMA16(p0, buf[i_], oacc[0][i_]); oacc[1][i_] = MFMA16(p1, buf[i_], oacc[1][i_]); } } } \
                else { const int sc_ = ((g) - 8) / 3, sub_ = ((g) - 8) % 3; \
                    if (sub_ == 0) { p0 = accpair_neg(vacc[0][2 * sc_], vacc[0][2 * sc_ + 1]); p1 = accpair_neg(vacc[1][2 * sc_], vacc[1][2 * sc_ + 1]); \
                        _Pragma("unroll") for (int i_ = 0; i_ < 4; ++i_) { oacc[0][i_] = MFMA16(p0, buf[i_], oacc[0][i_]); oacc[1][i_] = MFMA16(p1, buf[i_], oacc[1][i_]); } } \
                    else { _Pragma("unroll") for (int i_ = 0; i_ < 4; ++i_) { S[0][(sub_ - 1) * 4 + i_] = MFMA16(buf[i_], p0, S[0][(sub_ - 1) * 4 + i_]); S[1][(sub_ - 1) * 4 + i_] = MFMA16(buf[i_], p1, S[1][(sub_ - 1) * 4 + i_]); } } } } while (0)
#define GD_STEP(g) do { if ((g) + 2 < 14) GD_LD(fr[((g) + 2) % 3], (g) + 2); __builtin_amdgcn_sched_barrier(0); GD_MM(fr[(g) % 3], g); __builtin_amdgcn_sched_barrier(0); } while (0)
            GD_LD(fr[0], 0); GD_LD(fr[1], 1);
#pragma unroll
            for (int j = 0; j < 2; ++j)
#pragma unroll
                for (int tt = 0; tt < 4; ++tt) { vacc[j][tt] = -ld4bf(UT + (32 * w + 16 * j + c) * 72 + tt * 16 + 4 * q); oacc[j][tt] = (f32x4){0.f, 0.f, 0.f, 0.f}; }
            GD_STEP(0); GD_STEP(1); GD_STEP(2); GD_STEP(3); GD_STEP(4); GD_STEP(5); GD_STEP(6); GD_STEP(7);
#pragma unroll
            for (int j = 0; j < 2; ++j)
#pragma unroll
                for (int kt = 0; kt < 8; ++kt) S[j][kt] = S[j][kt] * gend;
            GD_STEP(8); GD_STEP(9); GD_STEP(10); GD_STEP(11); GD_STEP(12); GD_STEP(13);
#undef GD_LD
#undef GD_MM
#undef GD_STEP
            f32x4 g4[2][4];
#pragma unroll
            for (int j = 0; j < 2; ++j)
#pragma unroll
                for (int tt = 0; tt < 4; ++tt) g4[j][tt] = ld4bf(Gs + (tt * 16 + c) * 136 + 32 * w + 16 * j + 4 * q);
#pragma unroll
            for (int tt = 0; tt < 4; ++tt) { const f32x4 o0 = oacc[0][tt], o1 = oacc[1][tt];
                const float p = qsum(((o0[0] * o0[0] + o0[1] * o0[1]) + (o0[2] * o0[2] + o0[3] * o0[3])) + ((o1[0] * o1[0] + o1[1] * o1[1]) + (o1[2] * o1[2] + o1[3] * o1[3])));
                if (q == 0) PS[(tt * 16 + c) * 4 + w] = p; }
            LSYNC();
#pragma unroll
            for (int tt = 0; tt < 4; ++tt) { const f32x4 pa4 = *(const LAS f32x4*)(PS + (tt * 16 + c) * 4);
                const float rstd = frsq(((pa4.x + pa4.y) + (pa4.z + pa4.w)) * (1.f / 128.f) + EPS);
#pragma unroll
                for (int j = 0; j < 2; ++j) { const f32x4 o = oacc[j][tt] * onw4[j] * rstd; const f32x4 g = g4[j][tt];
                    *(LAS v2u*)(OGs + (tt * 16 + c) * 136 + 32 * w + 16 * j + 4 * q) = (v2u){pk2(o[0] * g[0], o[1] * g[1]), pk2(o[2] * g[2], o[3] * g[3])}; } }
        }
    }
    LSYNC();
}

DI void convert_experts(Frame& F) {
    LAS float* scr = (LAS float*)(F.lds + F.wave * 16384);
    unsigned char* WGU = F.ws + WS_WGU; unsigned char* WD = F.ws + WS_WD;
    for (;;) {
        int base = 0;
        if (F.lane == 0) base = (int)__hip_atomic_fetch_add(F.ctl + CW_WORK, 4u, __ATOMIC_RELAXED, __HIP_MEMORY_SCOPE_AGENT);
        base = __builtin_amdgcn_readfirstlane(base);
        if (base >= NE * 384) break;
        for (int it = base; it < base + 4; ++it) { const int e = it / 384, r = it % 384;
            if (r < 256) { const int up = r >> 7, sub = r & 127, nb = sub & 7, n0 = 32 * nb; const int row_off = 256 * (n0 >> 7) + (n0 & 127) - n0 + 128 * up;
                transpose_item8((up ? F.w_up : F.w_gate) + (size_t)e * 1024 * 256, 1024, 256, 8, WGU + (size_t)e * 512 * 1024, row_off, 32.f, F.norm_moe_w, scr, sub, F.lane); }
            else transpose_item8(F.w_down + (size_t)e * 256 * 1024, 256, 1024, 32, WD + (size_t)e * 1024 * 256, 0, 16.f, nullptr, scr, r - 256, F.lane);
        }
    }
}

DI void warm_and_convert(Frame& F, int cid) {
    LAS float* scr = (LAS float*)(F.lds + F.wave * 16384);
    unsigned char* WGU = F.ws + WS_WGU; unsigned char* WD = F.ws + WS_WD;
    const bool gd = cid >= 64; const int bh = gd ? cid - 64 : cid, b = bh >> 2, h = bh & 3;
    unsigned* prog = F.ctl + CW_PROG + 64 * cid;
    int n = 0; bool convleft = true; unsigned spins = 0;
    while (n < NCH || convleft) {
        const int pr = __builtin_amdgcn_readfirstlane((int)__hip_atomic_load(prog, __ATOMIC_RELAXED, __HIP_MEMORY_SCOPE_AGENT));
        if (n < NCH && n <= pr + 2) {
            const int bn = b * 64 + n, item = bn * 4 + h;
#pragma unroll
            for (int pass = 0; pass < 2; ++pass) { const int L = pass * 512 + F.wave * 64 + F.lane; size_t addr = 0; bool ok = true;
                if (gd) { if (L < 512) addr = WS_R3 + (size_t)(L >> 7) * 64 * MiB + (size_t)item * 16384 + (L & 127) * 128;
                          else if (L < 640) addr = WS_R2 + prb(bn, 28 + h) * 2 + (size_t)(L - 512) * 128;
                          else if (L < 704) addr = WS_R1 + ((size_t)(bn * 64 + (L - 640)) * D + 512 + h * 128) * 2;
                          else ok = false; }
                else    { if (L < 512) addr = WS_R2 + prb(bn, h + 4 * (L >> 7)) * 2 + (size_t)(L & 127) * 128;
                          else if (L < 640) addr = WS_R1 + ((size_t)(bn * 64 + ((L - 512) >> 1)) * D + h * 128) * 2 + ((L - 512) & 1) * 128;
                          else if (L < 644) addr = WS_DLAST + (size_t)item * 512 + (size_t)(L - 640) * 128;
                          else ok = false; }
                if (ok) { const unsigned v = *(const unsigned*)(F.ws + addr); asm volatile("" :: "v"(v)); } }
            ++n; spins = 0; continue;
        }
        if (convleft) {
            int base = 0;
            if (F.lane == 0) base = (int)__hip_atomic_fetch_add(F.ctl + CW_WORK, 4u, __ATOMIC_RELAXED, __HIP_MEMORY_SCOPE_AGENT);
            base = __builtin_amdgcn_readfirstlane(base);
            if (base >= NE * 384) { convleft = false; continue; }
            for (int it = base; it < base + 4; ++it) { const int e = it / 384, r = it % 384;
                if (r < 256) { const int up = r >> 7, sub = r & 127, nb = sub & 7, n0 = 32 * nb; const int row_off = 256 * (n0 >> 7) + (n0 & 127) - n0 + 128 * up;
                    transpose_item8((up ? F.w_up : F.w_gate) + (size_t)e * 1024 * 256, 1024, 256, 8, WGU + (size_t)e * 512 * 1024, row_off, 32.f, F.norm_moe_w, scr, sub, F.lane); }
                else transpose_item8(F.w_down + (size_t)e * 256 * 1024, 256, 1024, 32, WD + (size_t)e * 1024 * 256, 0, 16.f, nullptr, scr, r - 256, F.lane); }
            continue;
        }
        __builtin_amdgcn_s_sleep(8); if (++spins > (1u << 16)) n = NCH;
    }
}

struct MoeOrder {
    static constexpr bool GATHER = true;
    const LAS int* tab; const LAS int* cnt; const int* rowtok; int ntiles, nN, G, c; size_t bstride;
    DI bool next(int i, pg8::Unit& u) const {
        const long L = (long)i * G + c; if (L >= (long)ntiles * nN) return false;
        const int tile = (int)(L / nN); const int v = tab[tile];
        u.pm = tile; u.pn = (int)(L % nN); u.e = v & 255; u.j = v >> 8; return true;
    }
    DI const char* a_tile(const pg8::Gemm& g, const pg8::Unit&) const { return (const char*)g.A; }
    DI const char* b_tile(const pg8::Gemm& g, const pg8::Unit& u) const { return (const char*)g.Bt + (size_t)u.e * bstride + (size_t)u.pn * (size_t)pg8::BM * g.K * 2; }
    DI int row_of(const pg8::Unit& u, int r) const { int slot = u.j * 256 + r; const int m = cnt[u.e] - 1; slot = slot < m ? slot : m; return rowtok[u.e * 65536 + slot] >> 1; }
};
struct MoeOrder2 : MoeOrder {
    static constexpr bool GATHER = false;
    DI const char* a_tile(const pg8::Gemm& g, const pg8::Unit& u) const { return (const char*)g.A + (size_t)u.pm * (size_t)pg8::BM * g.K * 2; }
};
DI int moe_build_table(Frame& F) {
    LAS int* tab = (LAS int*)(F.lds + TILETAB_OFF); LAS int* cnt = (LAS int*)(F.lds + CNT_OFF); volatile LAS int* misc = (volatile LAS int*)(F.lds + MISC_OFF);
    if (F.wave == 0) {
        const int e = F.lane; const int cn = (int)__hip_atomic_load(F.ctl + CW_CNT + e, __ATOMIC_RELAXED, __HIP_MEMORY_SCOPE_AGENT); cnt[e] = cn;
        const int k = (cn + 255) >> 8; int pre = k;
#pragma unroll
        for (int o = 1; o < 64; o <<= 1) { const int t = __shfl_up(pre, o); if (F.lane >= o) pre += t; }
        const int base = pre - k;
        for (int j = 0; j < k; ++j) tab[base + j] = e | (j << 8);
        if (F.lane == 63) misc[16] = pre;
    }
    __syncthreads();
    return misc[16];
}

struct OneUnit : pg8::StaticOrder {
    int pm1;
    DI bool next(int i, pg8::Unit& u) const { if (i > 0) return false; u.pm = pm1; u.pn = 0; u.e = 0; u.j = 0; return true; }
};
DI void route_panel(Frame& F, int t0) {
    LAS int* hist = (LAS int*)F.lds; LAS int* base = hist + 64;
    const float* LOG = (const float*)(F.ws + WS_LOGITS); int* ROWTOK = (int*)(F.ws + WS_ROWTOK); float* ROWGATE = (float*)(F.ws + WS_ROWGATE);
    {
        const bool act = F.tid < 256;
        if (F.tid < 64) hist[F.tid] = 0;
        __syncthreads();
        const int tok = t0 + (F.tid & 255); const float* L = LOG + (size_t)tok * 256;
        const f32x4 ga = *(const f32x4*)L, gb = *(const f32x4*)(L + 4);
        float rr; { const f32x4* sp = (const f32x4*)((const float*)(F.ws + WS_SSQ) + (size_t)tok * 16); const f32x4 a = sp[0], b = sp[1], c = sp[2], d = sp[3];
            rr = frsq(((a.x + a.y + a.z + a.w) + (b.x + b.y + b.z + b.w) + (c.x + c.y + c.z + c.w) + (d.x + d.y + d.z + d.w)) * (1.f / D) + EPS); }
        const float g[8] = {ga.x * rr, ga.y * rr, ga.z * rr, ga.w * rr, gb.x * rr, gb.y * rr, gb.z * rr, gb.w * rr};
        int gi = 0; float gm = g[0];
#pragma unroll
        for (int j = 1; j < 8; ++j) if (g[j] > gm) { gm = g[j]; gi = j; }
        float den = 0.f;
#pragma unroll
        for (int j = 0; j < 8; ++j) den += expf(g[j] - gm);
        const float pg = 1.f / den;
        const f32x4 ea = *(const f32x4*)(L + 8 + gi * 8), eb = *(const f32x4*)(L + 12 + gi * 8);
        const float e[8] = {ea.x * rr, ea.y * rr, ea.z * rr, ea.w * rr, eb.x * rr, eb.y * rr, eb.z * rr, eb.w * rr};
        int i1 = 0; float v1 = e[0];
#pragma unroll
        for (int j = 1; j < 8; ++j) if (e[j] > v1) { v1 = e[j]; i1 = j; }
        int i2 = -1; float v2 = -3.0e38f;
#pragma unroll
        for (int j = 0; j < 8; ++j) if (j != i1 && e[j] > v2) { v2 = e[j]; i2 = j; }
        const float ex = expf(v2 - v1), p1 = 1.f / (1.f + ex), p2 = ex / (1.f + ex);
        const int e1 = gi * 8 + i1, e2 = gi * 8 + i2;
        int l1 = 0, l2 = 0;
        if (act) { l1 = __hip_atomic_fetch_add(&hist[e1], 1, __ATOMIC_RELAXED, __HIP_MEMORY_SCOPE_WORKGROUP); l2 = __hip_atomic_fetch_add(&hist[e2], 1, __ATOMIC_RELAXED, __HIP_MEMORY_SCOPE_WORKGROUP); }
        __syncthreads();
        if (F.tid < 64) base[F.tid] = (int)__hip_atomic_fetch_add(F.ctl + CW_CNT + F.tid, (unsigned)hist[F.tid], __ATOMIC_RELAXED, __HIP_MEMORY_SCOPE_AGENT);
        __syncthreads();
        const int s1 = base[e1] + l1, s2 = base[e2] + l2;
        float* ROWSCALE = (float*)(F.ws + WS_ROWSCALE);
        if (act) { ROWTOK[e1 * 65536 + s1] = tok * 2; ROWGATE[e1 * 65536 + s1] = p1 * pg; ROWSCALE[e1 * 65536 + s1] = rr;
            ROWTOK[e2 * 65536 + s2] = tok * 2 + 1; ROWGATE[e2 * 65536 + s2] = p2 * pg; ROWSCALE[e2 * 65536 + s2] = rr; }
        __syncthreads();
    }
}

constexpr int NPHASE = 11;
struct Args { const float* in[17]; float* out; unsigned char* ws; int ph_lo, ph_hi; };
__global__ void __launch_bounds__(NTHR, 2) fwd_kernel(Args args) {
    extern __shared__ __attribute__((aligned(16))) unsigned char lds_raw[];
    Frame F;
    F.lds = (LAS unsigned char*)lds_raw;
    F.tid = threadIdx.x; F.lane = F.tid & 63; F.wave = __builtin_amdgcn_readfirstlane(F.tid >> 6);
    F.G = gridDim.x; { const int bx = blockIdx.x; F.vcu = (F.G % 8 == 0) ? (bx % 8) * (F.G / 8) + bx / 8 : bx; }
    F.ws = args.ws; F.ctl = (unsigned*)(args.ws + WS_CTL); F.out = args.out;
    F.x = args.in[0]; F.norm_mix_w = args.in[1]; F.w_in = args.in[2]; F.lb_logits = args.in[3]; F.hg_onorm_w = args.in[4]; F.conv_w = args.in[5]; F.a_log = args.in[6];
    F.dt_bias = args.in[7]; F.gd_onorm_w = args.in[8]; F.w_out = args.in[9]; F.norm_moe_w = args.in[10]; F.wr_group = args.in[11]; F.wr_expert = args.in[12];
    F.w_gate = args.in[13]; F.w_up = args.in[14]; F.w_down = args.in[15]; F.final_w = args.in[16];
    volatile LAS unsigned* MISC = (volatile LAS unsigned*)(F.lds + MISC_OFF);
    if (F.tid < 64) MISC[F.tid] = 0u;
    __syncthreads();
    const int lo = args.ph_lo, hi = args.ph_hi;
    const bool one = (hi - lo) > 1;
    XcdBarrier bar; bar.bar = F.ctl + CW_BAR; bar.x = 0; bar.st = nullptr;
    if (one) bar = xcd_barrier_post(F.ctl + CW_BAR, MISC + 8);
#ifdef ONLY_PHASE
#define IN(k) ((k) == ONLY_PHASE && lo <= (k) && (k) < hi)
#else
#define IN(k) (lo <= (k) && (k) < hi)
#endif
#define SEAM(k) do { if (IN(k) && IN((k) + 1)) xcd_barrier(bar); } while (0)
    const int gw = F.vcu * NWAVES + F.wave, NGW = F.G * NWAVES;

    if (IN(0)) { for (int rep = 0; rep < REPS(0); ++rep) p0_prologue(F); }
    SEAM(0);
    if (IN(1)) {
        pg8::Gemm g{(const bf16*)F.out, (const bf16*)(F.ws + WS_WIN), T, NP, D}; pg8::StaticOrder S; S.init(T, NP, F.G, (int)blockIdx.x);
        pg8::EpiProjBlocked E{(bf16*)(F.ws + WS_R2)};
        for (int rep = 0; rep < REPS(1); ++rep) pg8::gemm_phase(F.lds, g, S, E);
    }
    SEAM(1);
    if (IN(2)) {
        if ((F.G & 3) == 0) gd_pre_loop(F);
        else { v4u raw[11]; f32x4 cw[4][2]; float pab[2] = {0.f, 0.f};
            if (F.wave < 6 && F.vcu < 4096) gd_raw_load(F, F.vcu, raw, cw);
            if (F.wave == 6 && F.vcu < 4096) { const int tok = (F.vcu >> 2) * 64 + F.lane; pab[0] = ((const float*)(F.ws + WS_AB))[(size_t)tok * 8 + (F.vcu & 3)]; pab[1] = ((const float*)(F.ws + WS_AB))[(size_t)tok * 8 + 4 + (F.vcu & 3)]; }
            for (int it = F.vcu; it < 4096; it += F.G) gd_pre_item(F, it, raw, cw, pab, it + F.G < 4096 ? it + F.G : -1); }
        { unsigned nq[16], nf[16], ni[16]; float nlb = 0.f;
          if (F.vcu < 4096) hg_raw_load(F, F.vcu, nq, nf, ni, nlb);
          for (int it = F.vcu; it < 4096; it += F.G) hg_pre_item(F, it, (bf16*)(F.ws + WS_R2), NP, (bf16*)(F.ws + WS_R1), (float*)(F.ws + WS_DLAST), nq, nf, ni, nlb, it + F.G < 4096 ? it + F.G : -1); }
    }
    SEAM(2);
    if (IN(3)) {
        const int bx = blockIdx.x;
        unsigned char* OG8 = (unsigned char*)F.out + 128 * MiB;
        if (F.G == 256) {
            const int idx = (bx >> 4) * 8 + (bx & 7);
            if (((bx >> 3) & 1) == 0) {
                if (PROBE_PH == 22) { if (idx < 64) hg_chain<0>(F, idx >> 2, idx & 3, (unsigned char*)F.out + 192 * MiB, F.ctl + CW_PROG + 64 * 200); else gd_chain<0>(F, (idx - 64) >> 2, idx & 3, (unsigned char*)F.out + 192 * MiB, F.ctl + CW_PROG + 64 * 200); }
                if (PROBE_PH == 25) { if (idx < 64) hg_chain<0>(F, idx >> 2, idx & 3, (unsigned char*)F.out + 192 * MiB, F.ctl + CW_PROG + 64 * 200); }
                if (PROBE_PH == 26) { if (idx >= 64) gd_chain<0>(F, (idx - 64) >> 2, idx & 3, (unsigned char*)F.out + 192 * MiB, F.ctl + CW_PROG + 64 * 200); }
                if (PROBE_PH == 24) { if (idx < 64) hg_chain<2>(F, idx >> 2, idx & 3, (unsigned char*)F.out + 192 * MiB, F.ctl + CW_PROG + 64 * 200); else gd_chain<2>(F, (idx - 64) >> 2, idx & 3, (unsigned char*)F.out + 192 * MiB, F.ctl + CW_PROG + 64 * 200); }
                if (PROBE_PH == 23) { if (idx < 64) hg_chain<1>(F, idx >> 2, idx & 3, (unsigned char*)F.out + 192 * MiB, F.ctl + CW_PROG + 64 * 200); else gd_chain<1>(F, (idx - 64) >> 2, idx & 3, (unsigned char*)F.out + 192 * MiB, F.ctl + CW_PROG + 64 * 200); }
                if (idx < 64) hg_chain<0>(F, idx >> 2, idx & 3, OG8, F.ctl + CW_PROG + 64 * idx); else gd_chain<0>(F, (idx - 64) >> 2, idx & 3, OG8, F.ctl + CW_PROG + 64 * idx); }
            else warm_and_convert(F, idx);
        } else {
            for (int cid = bx; cid < 128; cid += F.G) { if (cid < 64) hg_chain<0>(F, cid >> 2, cid & 3, OG8, F.ctl + CW_PROG + 64 * cid); else gd_chain<0>(F, (cid - 64) >> 2, cid & 3, OG8, F.ctl + CW_PROG + 64 * cid); }
        }
        convert_experts(F);
    }
    SEAM(3);
    if (IN(4)) {
        pg8::Gemm g{(const bf16*)((const unsigned char*)F.out + 128 * MiB), (const bf16*)(F.ws + WS_WOUT), T, D, OG_PITCH / 2}; pg8::StaticOrder S; S.init(T, D, F.G, (int)blockIdx.x);
        pg8::EpiRes3<OG_NF> E{(bf16*)(F.ws + WS_HB), F.ws + WS_XN8, (float*)(F.ws + WS_SSQ), (const bf16*)F.out, (const float*)(F.ws + WS_RXI), F.norm_mix_w};
        for (int rep = 0; rep < REPS(4); ++rep) pg8::gemm_phase(F.lds, g, S, E);
    }
    SEAM(4);
    if (IN(5)) {
        const bf16* HB = (const bf16*)(F.ws + WS_HB);
        for (int panel = F.vcu; panel < T / 256; panel += F.G) {
            { pg8::Gemm g{HB, (const bf16*)(F.ws + WS_WR), T, 256, D}; OneUnit S; S.init(T, 256, F.G, 0); S.pm1 = panel;
              pg8::EpiF32 E{(float*)(F.ws + WS_LOGITS), 256, nullptr};
              for (int rep = 0; rep < REPS(6); ++rep) pg8::gemm_phase(F.lds, g, S, E); }
            VM_WAIT(); __syncthreads();
            route_panel(F, panel * 256);
        }
    }
    SEAM(7);
    if (IN(8)) {
        const int nt = moe_build_table(F);
        MoeOrder S; S.tab = (const LAS int*)(F.lds + TILETAB_OFF); S.cnt = (const LAS int*)(F.lds + CNT_OFF); S.rowtok = (const int*)(F.ws + WS_ROWTOK);
        S.ntiles = nt; S.nN = 2; S.G = F.G; S.c = F.vcu; S.bstride = (size_t)512 * 1024;
        pg8::Gemm g{(const bf16*)(F.ws + WS_XN8), (const bf16*)(F.ws + WS_WGU), T, 512, D / 2};
        pg8::EpiSwiGLU8 E{F.ws + WS_H, (const float*)(F.ws + WS_ROWSCALE)};
        for (int rep = 0; rep < REPS(8); ++rep) pg8::gemm_phase(F.lds, g, S, E);
    }
    SEAM(8);
    if (IN(9)) {
        const int nt = moe_build_table(F);
        MoeOrder2 S; S.tab = (const LAS int*)(F.lds + TILETAB_OFF); S.cnt = (const LAS int*)(F.lds + CNT_OFF); S.rowtok = (const int*)(F.ws + WS_ROWTOK);
        S.ntiles = nt; S.nN = 4; S.G = F.G; S.c = F.vcu; S.bstride = (size_t)1024 * 256;
        pg8::Gemm g{(const bf16*)(F.ws + WS_H), (const bf16*)(F.ws + WS_WD), MAXTILES * 256, 1024, 128};
        pg8::EpiScatter8 E{F.ws + WS_Y2, (const int*)(F.ws + WS_ROWTOK), (const float*)(F.ws + WS_ROWGATE), (const LAS int*)(F.lds + CNT_OFF)};
        for (int rep = 0; rep < REPS(9); ++rep) pg8::gemm_phase(F.lds, g, S, E);
    }
    SEAM(9);
    if (IN(10)) {
        float wn[16];
#pragma unroll
        for (int j = 0; j < 4; ++j) { const f32x4 t = *(const f32x4*)(F.final_w + 4 * F.lane + 256 * j); wn[4 * j] = t.x; wn[4 * j + 1] = t.y; wn[4 * j + 2] = t.z; wn[4 * j + 3] = t.w; }
        const unsigned char* Y2 = F.ws + WS_Y2;
        v2u nh[4], nh2[4]; unsigned na[4], nb[4], na2[4], nb2[4];
#define P7_LOAD(m_) do { const v2u* hr_ = (const v2u*)((const bf16*)(F.ws + WS_HB) + (size_t)(m_) * D) + F.lane; const unsigned* y0_ = (const unsigned*)(Y2 + (size_t)(2 * (m_)) * D) + F.lane; const unsigned* y1_ = (const unsigned*)(Y2 + (size_t)(2 * (m_) + 1) * D) + F.lane; \
            _Pragma("unroll") for (int j_ = 0; j_ < 4; ++j_) { nh2[j_] = __builtin_nontemporal_load(hr_ + 64 * j_); na2[j_] = __builtin_nontemporal_load(y0_ + 64 * j_); nb2[j_] = __builtin_nontemporal_load(y1_ + 64 * j_); } } while (0)
        if (gw < T) P7_LOAD(gw);
#pragma unroll
        for (int j = 0; j < 4; ++j) { nh[j] = nh2[j]; na[j] = na2[j]; nb[j] = nb2[j]; }
        if (gw + NGW < T) P7_LOAD(gw + NGW);
        for (int m = gw; m < T; m += NGW) {
            f32x4* xr = (f32x4*)(F.out + (size_t)m * D) + F.lane;
            v2u ch[4]; unsigned ca[4], cb[4];
#pragma unroll
            for (int j = 0; j < 4; ++j) { ch[j] = nh[j]; ca[j] = na[j]; cb[j] = nb[j]; nh[j] = nh2[j]; na[j] = na2[j]; nb[j] = nb2[j]; }
            if (m + 2 * NGW < T) P7_LOAD(m + 2 * NGW);
            float v[16]; float s = 0.f;
#pragma unroll
            for (int j = 0; j < 4; ++j) { const v2u t = ch[j];
                const auto a0 = __builtin_amdgcn_cvt_pk_f32_fp8((int)ca[j], false), a1 = __builtin_amdgcn_cvt_pk_f32_fp8((int)ca[j], true), b0 = __builtin_amdgcn_cvt_pk_f32_fp8((int)cb[j], false), b1 = __builtin_amdgcn_cvt_pk_f32_fp8((int)cb[j], true);
                v[4 * j] = bflo(t.x) + (a0[0] + b0[0]) * 0.03125f; v[4 * j + 1] = bfhi(t.x) + (a0[1] + b0[1]) * 0.03125f; v[4 * j + 2] = bflo(t.y) + (a1[0] + b1[0]) * 0.03125f; v[4 * j + 3] = bfhi(t.y) + (a1[1] + b1[1]) * 0.03125f; }
#pragma unroll
            for (int i = 0; i < 16; ++i) s += v[i] * v[i];
            const float r = frsq(wave_sum(s) * (1.f / D) + EPS);
#pragma unroll
            for (int j = 0; j < 4; ++j) __builtin_nontemporal_store((f32x4){v[4 * j] * r * wn[4 * j], v[4 * j + 1] * r * wn[4 * j + 1], v[4 * j + 2] * r * wn[4 * j + 2], v[4 * j + 3] * r * wn[4 * j + 3]}, xr + 64 * j);
        }
    }
#undef IN
#undef SEAM
}

extern "C" void kernel_launch(void* const* d_in, const int* in_sizes, int n_in, void* d_out, int out_size, void* d_ws, size_t ws_size, hipStream_t stream) {
    static int grid = 0;
    if (grid == 0) {
        if (n_in != 17 || in_sizes[0] != T * D || out_size != T * D || ws_size < WS_END) {
            fprintf(stderr, "kernel_launch: unexpected shapes: n_in %d in0 %d out %d ws %zu (need %zu)\n", n_in, n_in > 0 ? in_sizes[0] : -1, out_size, ws_size, (size_t)WS_END); grid = -1; return; }
        int dev = 0, cus = 0, per_cu = 0;
        if (hipGetDevice(&dev) != hipSuccess || hipDeviceGetAttribute(&cus, hipDeviceAttributeMultiprocessorCount, dev) != hipSuccess) { grid = -1; return; }
        if (hipFuncSetAttribute((const void*)fwd_kernel, hipFuncAttributeMaxDynamicSharedMemorySize, LDS_BYTES) != hipSuccess) { fprintf(stderr, "kernel_launch: hipFuncSetAttribute failed\n"); grid = -1; return; }
        if (hipOccupancyMaxActiveBlocksPerMultiprocessor(&per_cu, (const void*)fwd_kernel, NTHR, LDS_BYTES) != hipSuccess || per_cu < 1) { fprintf(stderr, "kernel_launch: occupancy query says %d\n", per_cu); }
        (void)hipGetLastError();
        grid = cus;
    }
    if (grid < 0) return;
    if (hipMemsetAsync((char*)d_ws + WS_CTL, 0, CTL_ZERO_BYTES, stream) != hipSuccess) return;
    Args a{};
    for (int i = 0; i < 17; ++i) a.in[i] = (const float*)d_in[i];
    a.out = (float*)d_out; a.ws = (unsigned char*)d_ws;
#if MK_PER_PHASE
    for (int ph = 0; ph < NPHASE; ++ph) { a.ph_lo = ph; a.ph_hi = ph + 1; hipLaunchKernelGGL(fwd_kernel, dim3(grid), dim3(NTHR), LDS_BYTES, stream, a); }
#else
    a.ph_lo = 0; a.ph_hi = NPHASE; hipLaunchKernelGGL(fwd_kernel, dim3(grid), dim3(NTHR), LDS_BYTES, stream, a);
#endif
}
```
